# Optimizing an MI355X kernel written in HIP

```python
import math
import jax
import jax.numpy as jnp
from jax import lax
import numpy as np

D_MODEL = 1024
BATCH = 16
SEQ = 2048
DEPTH = 2

CTX_LEN = 256
GRID_W = 64
NORM_EPS = 1e-6

D_MIX = D_MODEL
RG_WIDTH = D_MIX // 4
SSD_WIDTH = D_MIX // 4
DA_WIDTH = D_MIX - RG_WIDTH - SSD_WIDTH

RG_HEADS = 4
RG_BLOCK = RG_WIDTH // RG_HEADS
RG_CONV = 4
RG_C = 8.0

SSD_HEADDIM = 64
SSD_HEADS = SSD_WIDTH // SSD_HEADDIM
SSD_GROUPS = 2
SSD_STATE = 64
SSD_CONV = 4
SSD_CHUNK = 128
SSD_XBC = SSD_WIDTH + 2 * SSD_GROUPS * SSD_STATE

DA_HEADS = 4
DA_HEAD_DIM = DA_WIDTH // (2 * DA_HEADS)
DA_V_DIM = 2 * DA_HEAD_DIM
ROPE_BASE = 10000.0
Q_BLOCK = 128

D_FF = ((8 * D_MODEL + 3 * 256 - 1) // (3 * 256)) * 256

IN_SIZES = (RG_WIDTH, RG_WIDTH, SSD_WIDTH, SSD_XBC, 2 * SSD_HEADS, DA_WIDTH, DA_WIDTH, DA_HEADS * DA_V_DIM)
D_IN = sum(IN_SIZES)
IN_OFFSETS = tuple(int(v) for v in np.cumsum(IN_SIZES)[:-1])

kernel_name = "hybrid_rglru_ssd_diffattn_dit_block"

F32 = jnp.float32


def rmsnorm(x, g):
    xf = x.astype(F32)
    y = xf * lax.rsqrt(jnp.mean(xf * xf, axis=-1, keepdims=True) + NORM_EPS)
    return (y * g.astype(F32)).astype(x.dtype)


def modulate(x, shift, scale):
    return x * (1 + scale) + shift


def dwconv_centred(x, w, b):
    k = w.shape[0]
    y = lax.conv_general_dilated(x, w[:, None, :], window_strides=(1,),
                                 padding=[(k // 2, k - 1 - k // 2)],
                                 dimension_numbers=("NWC", "WIO", "NWC"),
                                 feature_group_count=x.shape[-1])
    return y + b


def swiglu(x, w_gate, w_up, w_down):
    return (jax.nn.silu(x @ w_gate) * (x @ w_up)) @ w_down


def blockdiag(x, w, b):
    xs = x.reshape(x.shape[:-1] + (RG_HEADS, RG_BLOCK))
    return jnp.einsum("blhi,hij->blhj", xs, w).reshape(x.shape) + b


def rglru_coeffs(xc, w_a, b_a, w_x, b_x, lam):
    r = jax.nn.sigmoid(blockdiag(xc, w_a, b_a).astype(F32))
    i = jax.nn.sigmoid(blockdiag(xc, w_x, b_x).astype(F32))
    log_a = -RG_C * r * jax.nn.softplus(-lam.astype(F32))
    a = jnp.exp(log_a)
    bx = jnp.sqrt(-jnp.expm1(2.0 * log_a)) * (i * xc.astype(F32))
    return a, bx


def linear_scan(a, bx, h0, reverse):
    def combine(left, right):
        a_l, b_l = left
        a_r, b_r = right
        return a_l * a_r, a_r * b_l + b_r
    a_cum, h = lax.associative_scan(combine, (a, bx), axis=1, reverse=reverse)
    return h + a_cum * h0[:, None, :]


def rglru_mixer(x_ctx, g_ctx, x_lat, g_lat, conv_w, conv_b, w_a, b_a, w_x, b_x, lam, need_ctx):
    xc_ctx = dwconv_centred(x_ctx, conv_w, conv_b)
    xc_lat = dwconv_centred(x_lat, conv_w, conv_b)
    h_ctx_sum = 0.0
    h_lat_sum = 0.0
    for direction, rev in enumerate((False, True)):
        a_c, b_c = rglru_coeffs(xc_ctx, w_a[direction], b_a[direction], w_x[direction], b_x[direction], lam[direction])
        h_c = linear_scan(a_c, b_c, jnp.zeros_like(b_c[:, 0]), rev)
        h_end = h_c[:, 0] if rev else h_c[:, -1]
        a_l, b_l = rglru_coeffs(xc_lat, w_a[direction], b_a[direction], w_x[direction], b_x[direction], lam[direction])
        h_lat_sum = h_lat_sum + linear_scan(a_l, b_l, h_end, rev)
        if need_ctx:
            h_ctx_sum = h_ctx_sum + h_c
    y_lat = (h_lat_sum * jax.nn.gelu(g_lat.astype(F32))).astype(x_lat.dtype)
    y_ctx = (h_ctx_sum * jax.nn.gelu(g_ctx.astype(F32))).astype(x_ctx.dtype) if need_ctx else None
    return y_ctx, y_lat


def segsum(a):
    t = a.shape[-1]
    a_rep = jnp.broadcast_to(a[..., :, None], a.shape + (t,))
    strict = jnp.tril(jnp.ones((t, t), dtype=bool), -1)
    cs = jnp.cumsum(jnp.where(strict, a_rep, 0.0), axis=-2)
    return jnp.where(jnp.tril(jnp.ones((t, t), dtype=bool)), cs, -jnp.inf)


def ssd_scan(x, dt, a_neg, bm, cm, h0):
    b, L, H, P = x.shape
    n_state = bm.shape[-1]
    nc = L // SSD_CHUNK
    xd = (x * dt[..., None]).reshape(b, nc, SSD_CHUNK, H, P)
    bc = bm.reshape(b, nc, SSD_CHUNK, H, n_state)
    cc = cm.reshape(b, nc, SSD_CHUNK, H, n_state)
    a_dt = (dt * a_neg).reshape(b, nc, SSD_CHUNK, H).transpose(0, 3, 1, 2)
    a_cs = jnp.cumsum(a_dt, axis=-1)
    decay = jnp.exp(segsum(a_dt))
    scores = jnp.einsum("bclhn,bcshn->bhcls", cc, bc) * decay
    y_diag = jnp.einsum("bhcls,bcshp->bclhp", scores, xd)
    decay_states = jnp.exp(a_cs[..., -1:] - a_cs)
    states = jnp.einsum("bclhn,bhcl,bclhp->bchpn", bc, decay_states, xd)
    states = jnp.concatenate([h0[:, None], states], axis=1)
    chunk_a = jnp.pad(a_cs[..., -1], ((0, 0), (0, 0), (1, 0)))
    decay_chunk = jnp.exp(segsum(chunk_a))
    new_states = jnp.einsum("bhzc,bchpn->bzhpn", decay_chunk, states)
    entry_states, final_state = new_states[:, :-1], new_states[:, -1]
    y_off = jnp.einsum("bclhn,bchpn,bhcl->bclhp", cc, entry_states, jnp.exp(a_cs))
    return (y_diag + y_off).reshape(b, L, H, P), final_state


def gated_group_rmsnorm(y, z, g):
    b, n = z.shape[:2]
    v = y.reshape(b, n, SSD_WIDTH) * jax.nn.silu(z.astype(F32))
    v = v.reshape(b, n, SSD_GROUPS, SSD_WIDTH // SSD_GROUPS)
    v = v * lax.rsqrt(jnp.mean(v * v, axis=-1, keepdims=True) + NORM_EPS)
    return (v.reshape(b, n, SSD_WIDTH) * g.astype(F32)).astype(z.dtype)


def ssd_mixer(z_ctx, xbc_ctx, dt_ctx, z_lat, xbc_lat, dt_lat, conv_w, conv_b, dt_bias, a_log, d_skip, norm_g, need_ctx):
    def prep(xbc, dt_raw):
        xbc = jax.nn.silu(dwconv_centred(xbc, conv_w, conv_b)).astype(F32)
        b, n = xbc.shape[:2]
        xs, bm, cm = jnp.split(xbc, (SSD_WIDTH, SSD_WIDTH + SSD_GROUPS * SSD_STATE), axis=-1)
        xs = xs.reshape(b, n, SSD_HEADS, SSD_HEADDIM)
        rep = SSD_HEADS // SSD_GROUPS
        bm = jnp.repeat(bm.reshape(b, n, SSD_GROUPS, SSD_STATE), rep, axis=2)
        cm = jnp.repeat(cm.reshape(b, n, SSD_GROUPS, SSD_STATE), rep, axis=2)
        dts = jax.nn.softplus(dt_raw.astype(F32).reshape(b, n, 2, SSD_HEADS) + dt_bias.astype(F32))
        return xs, bm, cm, dts

    xs_c, b_c, c_c, dt_c = prep(xbc_ctx, dt_ctx)
    xs_l, b_l, c_l, dt_l = prep(xbc_lat, dt_lat)
    dsk = d_skip.astype(F32)[:, None]
    y_c = xs_c * dsk
    y_l = xs_l * dsk
    bsz = xs_c.shape[0]
    for direction in range(2):
        if direction == 0:
            flip = lambda t: t
        else:
            flip = lambda t: jnp.flip(t, axis=1)
        a_neg = -jnp.exp(a_log[direction].astype(F32))
        h0 = jnp.zeros((bsz, SSD_HEADS, SSD_HEADDIM, SSD_STATE), F32)
        yc_dir, h_ctx_end = ssd_scan(flip(xs_c), flip(dt_c[:, :, direction]), a_neg, flip(b_c), flip(c_c), h0)
        yl_dir, _ = ssd_scan(flip(xs_l), flip(dt_l[:, :, direction]), a_neg, flip(b_l), flip(c_l), h_ctx_end)
        y_l = y_l + flip(yl_dir)
        if need_ctx:
            y_c = y_c + flip(yc_dir)
    out_l = gated_group_rmsnorm(y_l, z_lat, norm_g)
    out_c = gated_group_rmsnorm(y_c, z_ctx, norm_g) if need_ctx else None
    return out_c, out_l


def axial_rope_tables(row, col):
    half = DA_HEAD_DIM // 2
    inv_freq = jnp.power(ROPE_BASE, -jnp.arange(0, half, 2, dtype=F32) / half)
    ang_r = row.astype(F32)[:, None] * inv_freq
    ang_c = col.astype(F32)[:, None] * inv_freq
    return jnp.cos(ang_r), jnp.sin(ang_r), jnp.cos(ang_c), jnp.sin(ang_c)


def rotate(x, cos, sin):
    x1, x2 = jnp.split(x, 2, axis=-1)
    return jnp.concatenate([x1 * cos - x2 * sin, x1 * sin + x2 * cos], axis=-1)


def apply_axial_rope(x, rope):
    cos_r, sin_r, cos_c, sin_c = (t[:, None, None, :] for t in rope)
    xf = x.astype(F32)
    half = DA_HEAD_DIM // 2
    out = jnp.concatenate([rotate(xf[..., :half], cos_r, sin_r), rotate(xf[..., half:], cos_c, sin_c)], axis=-1)
    return out.astype(x.dtype)


def diff_attn_core(q, k, v, lam):
    s = jnp.einsum("bqhcd,bkhcd->bhcqk", q, k).astype(F32)
    p = jax.nn.softmax(s, axis=-1)
    w = (p[:, :, 0] - lam * p[:, :, 1]).astype(v.dtype)
    return jnp.einsum("bhqk,bkhd->bqhd", w, v)


def diff_attn_mixer(q_ctx, k_ctx, v_ctx, q_lat, k_lat, v_lat, rope, lam_vec, subln_g, layer_idx, need_ctx):
    b, n = q_lat.shape[:2]
    m = q_ctx.shape[1]
    scale = DA_HEAD_DIM ** -0.5
    kc = k_ctx.reshape(b, m, DA_HEADS, 2, DA_HEAD_DIM)
    vc = v_ctx.reshape(b, m, DA_HEADS, DA_V_DIM)
    ql = apply_axial_rope(q_lat.reshape(b, n, DA_HEADS, 2, DA_HEAD_DIM), rope) * scale
    kl = apply_axial_rope(k_lat.reshape(b, n, DA_HEADS, 2, DA_HEAD_DIM), rope)
    vl = v_lat.reshape(b, n, DA_HEADS, DA_V_DIM)
    lam_init = 0.8 - 0.6 * math.exp(-0.3 * layer_idx)
    lv = lam_vec.astype(F32)
    lam = jnp.exp(jnp.sum(lv[0] * lv[1])) - jnp.exp(jnp.sum(lv[2] * lv[3])) + lam_init
    k_all = jnp.concatenate([kl, kc], axis=1)
    v_all = jnp.concatenate([vl, vc], axis=1)
    nb = n // Q_BLOCK
    q_blocks = ql.reshape(b, nb, Q_BLOCK, DA_HEADS, 2, DA_HEAD_DIM).swapaxes(0, 1)
    o_blocks = lax.map(lambda qb: diff_attn_core(qb, k_all, v_all, lam), q_blocks)
    o_lat = o_blocks.swapaxes(0, 1).reshape(b, n, DA_HEADS, DA_V_DIM)

    def finish(o):
        return (rmsnorm(o, subln_g) * (1.0 - lam_init)).reshape(o.shape[0], o.shape[1], DA_WIDTH)

    y_lat = finish(o_lat)
    if need_ctx:
        qc = q_ctx.reshape(b, m, DA_HEADS, 2, DA_HEAD_DIM) * scale
        y_ctx = finish(diff_attn_core(qc, kc, vc, lam))
    else:
        y_ctx = None
    return y_ctx, y_lat


def hybrid_layer(h_ctx, h_lat, mod_ctx, mod_lat, rope, layer_idx, need_ctx,
                 norm1_g, w_in, rg_conv_w, rg_conv_b, rg_w_a, rg_b_a, rg_w_x, rg_b_x, rg_lambda,
                 ssd_conv_w, ssd_conv_b, ssd_dt_bias, ssd_a_log, ssd_d, ssd_norm_g,
                 da_lambda, da_subln_g, w_out, norm2_g, w_gate, w_up, w_down):
    csh1, csc1, cg1, csh2, csc2, cg2 = mod_ctx
    sh1, sc1, g1, sh2, sc2, g2 = mod_lat
    u_ctx = modulate(rmsnorm(h_ctx, norm1_g), csh1, csc1) @ w_in
    u_lat = modulate(rmsnorm(h_lat, norm1_g), sh1, sc1) @ w_in
    rgx_c, rgg_c, sz_c, sxbc_c, sdt_c, q_c, k_c, v_c = jnp.split(u_ctx, IN_OFFSETS, axis=-1)
    rgx_l, rgg_l, sz_l, sxbc_l, sdt_l, q_l, k_l, v_l = jnp.split(u_lat, IN_OFFSETS, axis=-1)

    rg_c, rg_l = rglru_mixer(rgx_c, rgg_c, rgx_l, rgg_l, rg_conv_w, rg_conv_b,
                             rg_w_a, rg_b_a, rg_w_x, rg_b_x, rg_lambda, need_ctx)
    ssd_c, ssd_l = ssd_mixer(sz_c, sxbc_c, sdt_c, sz_l, sxbc_l, sdt_l, ssd_conv_w, ssd_conv_b,
                             ssd_dt_bias, ssd_a_log, ssd_d, ssd_norm_g, need_ctx)
    da_c, da_l = diff_attn_mixer(q_c, k_c, v_c, q_l, k_l, v_l, rope, da_lambda, da_subln_g,
                                 layer_idx, need_ctx)

    mix_lat = jnp.concatenate([rg_l, ssd_l, da_l], axis=-1) @ w_out
    h_lat = h_lat + g1 * mix_lat
    h_lat = h_lat + g2 * swiglu(modulate(rmsnorm(h_lat, norm2_g), sh2, sc2), w_gate, w_up, w_down)
    if need_ctx:
        mix_ctx = jnp.concatenate([rg_c, ssd_c, da_c], axis=-1) @ w_out
        h_ctx = h_ctx + cg1 * mix_ctx
        h_ctx = h_ctx + cg2 * swiglu(modulate(rmsnorm(h_ctx, norm2_g), csh2, csc2), w_gate, w_up, w_down)
    return h_ctx, h_lat


def setup_inputs(seed: int = 0) -> dict:
    key = jax.random.key(seed)
    ks = iter(jax.random.split(key, 48))

    def nrm(shape, scale):
        return jax.random.normal(next(ks), shape, F32) * scale

    def gain(shape):
        return 1.0 + nrm(shape, 0.02)

    a0 = jax.random.uniform(next(ks), (DEPTH, 2, RG_WIDTH), F32, 0.9, 0.999)
    s0 = a0 ** (1.0 / RG_C)
    rg_lambda = jnp.log(s0) - jnp.log1p(-s0)
    dt0 = jnp.exp(jax.random.uniform(next(ks), (DEPTH, 2, SSD_HEADS), F32, math.log(1e-3), math.log(1e-1)))
    ssd_dt_bias = dt0 + jnp.log(-jnp.expm1(-dt0))
    ssd_a_log = jnp.log(jax.random.uniform(next(ks), (DEPTH, 2, SSD_HEADS), F32, 1.0, 16.0))

    return {
        "x": nrm((BATCH, SEQ, D_MODEL), 1.0),
        "c": nrm((BATCH, D_MODEL), 1.0),
        "ctx": nrm((BATCH, CTX_LEN, D_MODEL), 1.0),
        "c_ctx": nrm((D_MODEL,), 1.0),
        "w_mod": nrm((DEPTH, D_MODEL, 6 * D_MODEL), 0.3 * D_MODEL ** -0.5),
        "b_mod": nrm((DEPTH, 6 * D_MODEL), 0.02),
        "norm1_g": gain((DEPTH, D_MODEL)),
        "w_in": nrm((DEPTH, D_MODEL, D_IN), D_MODEL ** -0.5),
        "rg_conv_w": nrm((DEPTH, RG_CONV, RG_WIDTH), RG_CONV ** -0.5),
        "rg_conv_b": nrm((DEPTH, RG_WIDTH), 0.02),
        "rg_w_a": nrm((DEPTH, 2, RG_HEADS, RG_BLOCK, RG_BLOCK), RG_BLOCK ** -0.5),
        "rg_b_a": nrm((DEPTH, 2, RG_WIDTH), 0.02),
        "rg_w_x": nrm((DEPTH, 2, RG_HEADS, RG_BLOCK, RG_BLOCK), RG_BLOCK ** -0.5),
        "rg_b_x": nrm((DEPTH, 2, RG_WIDTH), 0.02),
        "rg_lambda": rg_lambda,
        "ssd_conv_w": nrm((DEPTH, SSD_CONV, SSD_XBC), SSD_CONV ** -0.5),
        "ssd_conv_b": nrm((DEPTH, SSD_XBC), 0.02),
        "ssd_dt_bias": ssd_dt_bias,
        "ssd_a_log": ssd_a_log,
        "ssd_d": gain((DEPTH, SSD_HEADS)),
        "ssd_norm_g": gain((DEPTH, SSD_WIDTH)),
        "da_lambda": nrm((DEPTH, 4, DA_HEAD_DIM), 0.1),
        "da_subln_g": gain((DEPTH, DA_V_DIM)),
        "w_out": nrm((DEPTH, D_MIX, D_MODEL), D_MIX ** -0.5),
        "norm2_g": gain((DEPTH, D_MODEL)),
        "w_gate": nrm((DEPTH, D_MODEL, D_FF), D_MODEL ** -0.5),
        "w_up": nrm((DEPTH, D_MODEL, D_FF), D_MODEL ** -0.5),
        "w_down": nrm((DEPTH, D_FF, D_MODEL), D_FF ** -0.5),
        "final_norm_g": gain((D_MODEL,)),
    }


def reference(x, c, ctx, c_ctx, w_mod, b_mod, norm1_g, w_in, rg_conv_w, rg_conv_b, rg_w_a, rg_b_a,
              rg_w_x, rg_b_x, rg_lambda, ssd_conv_w, ssd_conv_b, ssd_dt_bias, ssd_a_log, ssd_d,
              ssd_norm_g, da_lambda, da_subln_g, w_out, norm2_g, w_gate, w_up, w_down, final_norm_g):
    n = x.shape[1]
    rows = n // GRID_W
    row = jnp.repeat(jnp.arange(rows, dtype=jnp.int32), GRID_W)
    col = jnp.tile(jnp.arange(GRID_W, dtype=jnp.int32), rows)
    rope = axial_rope_tables(row, col)
    h_lat, h_ctx = x, ctx
    for l in range(DEPTH):
        need_ctx = l < DEPTH - 1
        mod_lat = jnp.split((jax.nn.silu(c) @ w_mod[l] + b_mod[l])[:, None, :], 6, axis=-1)
        mod_ctx = jnp.split(jax.nn.silu(c_ctx) @ w_mod[l] + b_mod[l], 6, axis=-1)
        h_ctx, h_lat = hybrid_layer(
            h_ctx, h_lat, mod_ctx, mod_lat, rope, l, need_ctx,
            norm1_g[l], w_in[l], rg_conv_w[l], rg_conv_b[l], rg_w_a[l], rg_b_a[l], rg_w_x[l], rg_b_x[l],
            rg_lambda[l], ssd_conv_w[l], ssd_conv_b[l], ssd_dt_bias[l], ssd_a_log[l], ssd_d[l],
            ssd_norm_g[l], da_lambda[l], da_subln_g[l], w_out[l], norm2_g[l], w_gate[l], w_up[l], w_down[l])
    return rmsnorm(h_lat, final_norm_g)
```

```cpp
#include <hip/hip_runtime.h>
#include <hip/hip_cooperative_groups.h>
#include <cstdio>
#include <cstdint>
namespace cg = cooperative_groups;

#define LAS __attribute__((address_space(3)))
#define DI __device__ __forceinline__
typedef unsigned short bf16_t;
typedef short bf16x8 __attribute__((ext_vector_type(8)));
typedef short s16x4 __attribute__((ext_vector_type(4)));
typedef float f32x4 __attribute__((ext_vector_type(4)));
typedef float f32x2 __attribute__((ext_vector_type(2)));
typedef float f32x16 __attribute__((ext_vector_type(16)));
typedef unsigned u32x4 __attribute__((ext_vector_type(4)));
typedef unsigned u32x2 __attribute__((ext_vector_type(2)));

constexpr int DM = 1024, NB = 16, SEQ = 2048, CTXL = 256;
constexpr int M_LAT = NB * SEQ, M_CTX = NB * CTXL, M_ALL = M_LAT + M_CTX;
constexpr int NU = 2816, DFF = 2816, NGU = 5632, DIN = 2824;
constexpr int C_RGX = 0, C_RGG = 256, C_SZ = 512, C_XBC = 768, C_Q = 1280, C_K = 1792, C_V = 2304;
constexpr float EPS = 1e-6f;
constexpr float QSCALE = 0.125f * 1.4426950408889634f;
enum { I_X = 0, I_C, I_CTX, I_CCTX, I_WMOD, I_BMOD, I_N1G, I_WIN, I_RGCW, I_RGCB, I_RGWA, I_RGBA, I_RGWX, I_RGBX, I_RGLAM, I_SCW, I_SCB, I_SDTB, I_SALOG,
       I_SD, I_SNG, I_DALAM, I_DASG, I_WOUT, I_N2G, I_WGATE, I_WUP, I_WDOWN, I_FNG, N_IN };

constexpr size_t MiB = 1u << 20;
constexpr size_t WS_MOD = 1 * MiB;
constexpr size_t WS_BIAS_IN = 2 * MiB;
constexpr size_t WS_BIAS_DT = 2 * MiB + 512 * 1024;
constexpr size_t WS_BIAS_GU = 3 * MiB;
constexpr size_t WS_ROPE = 4 * MiB;
constexpr size_t WS_WDT = 4 * MiB + 64 * 1024;
constexpr size_t WS_DT = 5 * MiB;
constexpr size_t WS_ROWPART = 8 * MiB;
constexpr size_t ROWPART_STRIDE = (size_t)M_ALL * 16;
constexpr size_t WS_W = 20 * MiB;
constexpr size_t W_LAYER = 24 * MiB, W_IN = 0, W_OUT = 5 * MiB + 512 * 1024, W_GU = 7 * MiB + 512 * 1024, W_DOWN = 18 * MiB + 512 * 1024;
constexpr size_t WS_HCTX = 68 * MiB;
constexpr size_t WS_HB = 84 * MiB;
constexpr size_t WS_U = 156 * MiB;
constexpr size_t WS_MIX = 354 * MiB;
constexpr size_t WS_RGS = 426 * MiB;
constexpr size_t WS_END = 462 * MiB;
constexpr int LDS_BYTES = 147456;

struct Args { const float* in[N_IN]; float* out; unsigned char* ws; };
typedef const unsigned char __attribute__((address_space(4)))* kptr_t;
struct KA {
    kptr_t kb;
    __device__ __forceinline__ const float* in(int i) const { return *(const float* const __attribute__((address_space(4)))*)(kb + 8 * i); }
    __device__ __forceinline__ float* out() const { return *(float* const __attribute__((address_space(4)))*)(kb + 8 * N_IN); }
    __device__ __forceinline__ unsigned char* ws() const { return *(unsigned char* const __attribute__((address_space(4)))*)(kb + 8 * (N_IN + 1)); }
};
__device__ __forceinline__ KA ka_fresh() { kptr_t p = (kptr_t)__builtin_amdgcn_kernarg_segment_ptr(); asm volatile("" : "+s"(p)); return KA{p}; }

DI unsigned cvt_pk_bf16(float lo, float hi) { unsigned r; asm volatile("v_cvt_pk_bf16_f32 %0, %1, %2" : "=v"(r) : "v"(lo), "v"(hi)); return r; }
DI unsigned f2bf(float f) { unsigned u = __builtin_bit_cast(unsigned, f); return (u + 0x7fffu + ((u >> 16) & 1u)) >> 16; }
DI float bf2f(unsigned v) { return __builtin_bit_cast(float, v << 16); }
DI float bflo(unsigned w) { return __builtin_bit_cast(float, w << 16); }
DI float bfhi(unsigned w) { return __builtin_bit_cast(float, w & 0xffff0000u); }
DI float sigmoidf_(float x) { return 1.0f / (1.0f + __expf(-x)); }
DI float siluf_(float x) { return x / (1.0f + __expf(-x)); }
DI float log1p_small(float e) { return e < 1e-3f ? e * (1.0f - 0.5f * e) : __logf(1.0f + e); }
DI float softplusf_(float x) { return fmaxf(x, 0.f) + log1p_small(__expf(-fabsf(x))); }
DI float neg_expm1(float x) { return x > -0.02f ? -x * (1.0f + x * (0.5f + x * 0.16666667f)) : 1.0f - __expf(x); }
DI float gelu_tanh(float x) { const float u = 0.7978845608028654f * (x + 0.044715f * x * x * x); return x / (1.0f + __expf(-2.0f * u)); }
DI float uniformf(float v) { return __builtin_bit_cast(float, __builtin_amdgcn_readfirstlane(__builtin_bit_cast(int, v))); }
DI float wave_sum(float v) {
#pragma unroll
    for (int o = 1; o < 64; o <<= 1) v += __shfl_xor(v, o);
    return v;
}
DI int crow(int r, int hi) { return (r & 3) + 8 * (r >> 2) + 4 * hi; }
#define LDS_WAIT() asm volatile("s_waitcnt lgkmcnt(0)" ::: "memory")
DI int lane_fresh() { int r; asm volatile("v_mbcnt_lo_u32_b32 %0, -1, 0\n\tv_mbcnt_hi_u32_b32 %0, -1, %0" : "=v"(r)); return r; }
DI int launder_s(int x) { asm volatile("" : "+s"(x)); return x; }
DI int launder(int x) { asm volatile("" : "+v"(x)); return x; }

namespace pg8 {
#define PG8_LAS __attribute__((address_space(3)))
constexpr int BM = 256, BK = 64, HALF = 128, HTB = HALF * BK * 2, STAGE_BYTES = 8 * HTB, NXCD = 8, WGM = 8;
__host__ __device__ __forceinline__ int lds_byte(int r, int c) { const int st = (r >> 4) * 2 + (c >> 5), rr = r & 15, cc = c & 31, ob = rr * 64 + cc * 2; return st * 1024 + (ob ^ (((ob >> 9) & 1) << 5)); }
__host__ __device__ __forceinline__ void stage_rc(int b, int& R, int& C) { const int st = b / 1024, sb = b % 1024, swz = sb ^ (((sb >> 9) & 1) << 5); R = (st >> 1) * 16 + swz / 64; C = (st & 1) * 32 + (swz % 64) / 2; }
__host__ __device__ __forceinline__ int perm32(int rho) { const int n = rho >> 4, i = rho & 15; return 8 * (i >> 2) + 4 * n + (i & 3); }
struct Unit { int pm, pn; };
struct Gemm { const bf16_t* A; const bf16_t* Bt; int K; };

struct TileOrder {
    int nM, nN, nwg, G, c, n2;
    __device__ void init(int nM_, int nN_, int G_, int c_, int n2_) { nM = nM_; nN = nN_; nwg = nM * nN; G = G_; c = c_; n2 = n2_; }
    __device__ bool next(int i, Unit& u) const {
        const int L = i * G + c;
        if (L < nwg) {
            int wgid = L; { const int q = nwg / NXCD, r = nwg % NXCD, xcd = wgid % NXCD, off = wgid / NXCD; wgid = (xcd < r ? xcd * (q + 1) : r * (q + 1) + (xcd - r) * q) + off; }
            const int nig = WGM * nN, gid = wgid / nig, fm = gid * WGM, gsz = (nM - fm) < WGM ? (nM - fm) : WGM;
            u.pm = fm + ((wgid % nig) % gsz); u.pn = (wgid % nig) / gsz; return true;
        }
        const int L2 = L - nwg;
        if (L2 < n2) { u.pm = 128 + (L2 & 15); const int ci = L2 >> 4; u.pn = ci == 0 ? 0 : (ci < 3 ? ci + 2 : ci + 4); return true; }
        return false;
    }
};

template <class Epi, bool ALIGN_EPI>
__device__ __forceinline__ void gemm_phase(PG8_LAS unsigned char* lds, const Gemm g, const TileOrder& S, const Epi& E, const int wave_id) {
    const int lane = lane_fresh(), wid = launder_s(wave_id), tid = wid * 64 + lane, wr = wid >> 2, wc = wid & 3, fr = lane & 15, fq = lane >> 4;
    const int K = g.K, nt = K / BK;
    unsigned voffA[2], voffB[2];
#pragma unroll
    for (int i = 0; i < 2; ++i) { int R, C; stage_rc(tid * 16 + i * 8192, R, C); const int Rb = (R & ~31) + perm32(R & 31);
        voffA[i] = (unsigned)(R * K + C) * 2u; voffB[i] = (unsigned)(Rb * K + C) * 2u; }
    const size_t kstep = (size_t)(BK * 2);
    const size_t hstep = (size_t)HALF * K * 2;
    const size_t tstep = 2 * hstep;
    const unsigned ldsw = (unsigned)wid * 1024u;
    const int aoff = lds_byte(wr * 64 + fr, fq * 8), boff = lds_byte(wc * 32 + fr, fq * 8);
#define PG8_SA(b, h) (((b) * 2 + (h)) * HTB)
#define PG8_SB(b, h) ((4 + (b) * 2 + (h)) * HTB)
#define PG8_STAGE(bufoff, gbase, voff) do { _Pragma("unroll") for (int _i = 0; _i < 2; ++_i) \
        __builtin_amdgcn_global_load_lds((const unsigned*)((const char*)(gbase) + (voff)[_i]), (PG8_LAS unsigned*)(lds + (bufoff) + ldsw + _i * 8192), 16, 0, 0); } while (0)
#define PG8_LDA(dst, b, h) do { _Pragma("unroll") for (int m = 0; m < 4; ++m) _Pragma("unroll") for (int k = 0; k < 2; ++k) dst[m][k] = *(const PG8_LAS bf16x8*)(lds + PG8_SA(b, h) + aoff + m * 2048 + k * 1024); } while (0)
#define PG8_LDB(dst, b, h) do { _Pragma("unroll") for (int n = 0; n < 2; ++n) _Pragma("unroll") for (int k = 0; k < 2; ++k) dst[n][k] = *(const PG8_LAS bf16x8*)(lds + PG8_SB(b, h) + boff + n * 2048 + k * 1024); } while (0)
#define PG8_MMA(ai, bj, At, Bt) do { __builtin_amdgcn_s_setprio(1); _Pragma("unroll") for (int m = 0; m < 4; ++m) _Pragma("unroll") for (int n = 0; n < 2; ++n) _Pragma("unroll") for (int k = 0; k < 2; ++k) \
        acc[ai][bj][m][n] = __builtin_amdgcn_mfma_f32_16x16x32_bf16(Bt[n][k], At[m][k], acc[ai][bj][m][n], 0, 0, 0); __builtin_amdgcn_s_setprio(0); } while (0)
#define PG8_WAIT_V(n) asm volatile("s_waitcnt vmcnt(" #n ")" ::: "memory")
#define PG8_WAIT_L(n) asm volatile("s_waitcnt lgkmcnt(" #n ")" ::: "memory")
#define PG8_BAR __builtin_amdgcn_s_barrier()
#define PG8_SCHED __builtin_amdgcn_sched_barrier(0)
    Unit cur, nxt; int ui = 0;
    if (!S.next(0, cur)) return;
    f32x4 acc[2][2][4][2];
#pragma unroll
    for (int a = 0; a < 2; ++a)
#pragma unroll
        for (int b = 0; b < 2; ++b)
#pragma unroll
            for (int m = 0; m < 4; ++m)
#pragma unroll
                for (int n = 0; n < 2; ++n) acc[a][b][m][n] = (f32x4){0.f, 0.f, 0.f, 0.f};
    bf16x8 At[4][2], B0[2][2], B1[2][2];
    const char* cA = (const char*)g.A + (size_t)cur.pm * tstep; const char* cB = (const char*)g.Bt + (size_t)cur.pn * tstep;
    PG8_STAGE(PG8_SB(0, 0), cB, voffB); PG8_STAGE(PG8_SB(0, 1), cB + hstep, voffB); PG8_STAGE(PG8_SA(0, 0), cA, voffA); PG8_STAGE(PG8_SA(0, 1), cA + hstep, voffA);
    if (wr == 1) PG8_BAR;
    PG8_WAIT_V(2); PG8_BAR;
    PG8_STAGE(PG8_SB(1, 0), cB + kstep, voffB); PG8_STAGE(PG8_SA(1, 0), cA + kstep, voffA); PG8_STAGE(PG8_SB(1, 1), cB + hstep + kstep, voffB);
    PG8_WAIT_V(6); PG8_BAR;
    for (;;) {
        const bool has_next = S.next(ui + 1, nxt);
        const char* nA = has_next ? (const char*)g.A + (size_t)nxt.pm * tstep : cA; const char* nB = has_next ? (const char*)g.Bt + (size_t)nxt.pn * tstep : cB;
        for (int t = 0; t < nt; t += 2) {
            const bool last = (t == nt - 2);
            const char* a1 = cA + (size_t)(t + 1) * kstep;
            const char* a2 = last ? nA : cA + (size_t)(t + 2) * kstep; const char* b2 = last ? nB : cB + (size_t)(t + 2) * kstep;
            const char* a3 = a2 + kstep; const char* b3 = b2 + kstep;
            PG8_LDB(B0, 0, 0); PG8_LDB(B1, 0, 1); PG8_SCHED; PG8_LDA(At, 0, 0); PG8_STAGE(PG8_SA(1, 1), a1 + hstep, voffA);
            PG8_WAIT_V(8); PG8_WAIT_L(0); PG8_BAR; PG8_MMA(0, 0, At, B0); PG8_MMA(0, 1, At, B1); PG8_BAR; PG8_SCHED;
            PG8_LDA(At, 0, 1); PG8_STAGE(PG8_SB(0, 0), b2, voffB); PG8_STAGE(PG8_SB(0, 1), b2 + hstep, voffB); PG8_STAGE(PG8_SA(0, 0), a2, voffA);
            PG8_WAIT_V(8); PG8_WAIT_L(0); PG8_BAR; PG8_MMA(1, 0, At, B0); PG8_MMA(1, 1, At, B1); PG8_BAR; PG8_SCHED;
            PG8_LDB(B0, 1, 0); PG8_LDB(B1, 1, 1); PG8_SCHED; PG8_LDA(At, 1, 0); PG8_STAGE(PG8_SA(0, 1), a2 + hstep, voffA);
            PG8_WAIT_V(8); PG8_WAIT_L(0); PG8_BAR; PG8_MMA(0, 0, At, B0); PG8_MMA(0, 1, At, B1); PG8_BAR; PG8_SCHED;
            PG8_LDA(At, 1, 1); PG8_STAGE(PG8_SB(1, 0), b3, voffB); PG8_STAGE(PG8_SB(1, 1), b3 + hstep, voffB); PG8_STAGE(PG8_SA(1, 0), a3, voffA);
            PG8_WAIT_V(8); PG8_WAIT_L(0); PG8_BAR; PG8_MMA(1, 0, At, B0); PG8_MMA(1, 1, At, B1); PG8_BAR; PG8_SCHED;
        }
        if constexpr (ALIGN_EPI) { if (wr == 0) PG8_BAR; }
        E(acc, cur, wr, wc, fr, fq);
        if (!has_next) break;
#pragma unroll
        for (int a = 0; a < 2; ++a)
#pragma unroll
            for (int b = 0; b < 2; ++b)
#pragma unroll
                for (int m = 0; m < 4; ++m)
#pragma unroll
                    for (int n = 0; n < 2; ++n) acc[a][b][m][n] = (f32x4){0.f, 0.f, 0.f, 0.f};
        cur = nxt; cA = nA; cB = nB; ++ui;
        if constexpr (ALIGN_EPI) { if (wr == 1) PG8_BAR; }
    }
    PG8_WAIT_V(0);
    if constexpr (!ALIGN_EPI) { if (wr == 0) PG8_BAR; }
    PG8_BAR;
#undef PG8_SA
#undef PG8_SB
#undef PG8_STAGE
#undef PG8_LDA
#undef PG8_LDB
#undef PG8_MMA
#undef PG8_WAIT_V
#undef PG8_WAIT_L
#undef PG8_BAR
#undef PG8_SCHED
}

DI float row_rstd(const float* rowpart, int row) {
    const f32x4* rp = (const f32x4*)(rowpart + (size_t)row * 16);
    const f32x4 a = rp[0], b = rp[1], c = rp[2], d = rp[3];
    const float s = ((a.x + a.y) + (a.z + a.w)) + ((b.x + b.y) + (b.z + b.w)) + ((c.x + c.y) + (c.z + c.w)) + ((d.x + d.y) + (d.z + d.w));
    return 1.0f / sqrtf(s * (1.0f / DM) + EPS);
}

struct EpiIn {
    bf16_t* U; const float* rowpart; const float* bias; const float* rope;
    __device__ __forceinline__ void operator()(const f32x4 (&acc)[2][2][4][2], const Unit& u, int wr, int wc, int fr, int fq) const {
        const bool isctx = u.pm >= 128; const int bidx = isctx ? 16 : (u.pm >> 3);
        const int kind = (u.pn == 5 || u.pn == 6) ? 1 : ((u.pn == 7 || u.pn == 8) ? 2 : 0);
        const bool dorope = (kind != 0) && !isctx;
        const float osc = (kind == 1) ? QSCALE : 1.0f;
        const int colb = u.pn * BM + wc * 32 + 8 * fq;
        const float* bp = bias + (size_t)bidx * NU + colb;
        f32x4 bv[2][2];
#pragma unroll
        for (int bj = 0; bj < 2; ++bj)
#pragma unroll
            for (int n = 0; n < 2; ++n) bv[bj][n] = *(const f32x4*)(bp + bj * HALF + 4 * n);
#pragma unroll
        for (int ai = 0; ai < 2; ++ai)
#pragma unroll
            for (int m = 0; m < 4; ++m) {
                const int row = u.pm * BM + ai * HALF + wr * 64 + m * 16 + fr;
                const float rstd = row_rstd(rowpart, row);
                f32x4 cs[4];
                if (dorope) { const int t = row & (SEQ - 1); const int pos = (wc & 1) ? (t & 63) : (t >> 6);
                    const f32x4* rp = (const f32x4*)(rope + (size_t)(pos * 16 + 8 * (fq & 1)) * 2);
                    cs[0] = rp[0]; cs[1] = rp[1]; cs[2] = rp[2]; cs[3] = rp[3]; }
                bf16_t* rowp = U + (size_t)row * NU + colb;
#pragma unroll
                for (int bj = 0; bj < 2; ++bj) {
                    f32x4 v0 = acc[ai][bj][m][0] * rstd + bv[bj][0], v1 = acc[ai][bj][m][1] * rstd + bv[bj][1];
                    if (kind != 0) {
                        float x[8] = {v0[0], v0[1], v0[2], v0[3], v1[0], v1[1], v1[2], v1[3]};
#pragma unroll
                        for (int i = 0; i < 8; ++i) {
                            const float p = __shfl_xor(x[i], 32);
                            if (dorope) { const float co = cs[i >> 1][(i & 1) * 2], si = cs[i >> 1][(i & 1) * 2 + 1];
                                x[i] = (fq < 2) ? (x[i] * co - p * si) : (p * si + x[i] * co); }
                            x[i] *= osc;
                        }
                        v0 = (f32x4){x[0], x[1], x[2], x[3]}; v1 = (f32x4){x[4], x[5], x[6], x[7]};
                    }
                    u32x4 w; w.x = cvt_pk_bf16(v0[0], v0[1]); w.y = cvt_pk_bf16(v0[2], v0[3]); w.z = cvt_pk_bf16(v1[0], v1[1]); w.w = cvt_pk_bf16(v1[2], v1[3]);
                    *(u32x4*)(rowp + bj * HALF) = w;
                }
                asm volatile("" ::: "memory");
            }
    }
};

struct EpiRes {
    const float* hin_lat; const float* hin_ctx; float* hout_lat; float* hout_ctx;
    const float* gate;
    bf16_t* HBo; const float* gnext; const float* scnext;
    float* rowpart;
    __device__ __forceinline__ void operator()(const f32x4 (&acc)[2][2][4][2], const Unit& u, int wr, int wc, int fr, int fq) const {
        const bool isctx = u.pm >= 128; const int bidx = isctx ? 16 : (u.pm >> 3);
        const int colb = u.pn * BM + wc * 32 + 8 * fq;
        f32x4 gv[2][2], gm[2][2];
#pragma unroll
        for (int bj = 0; bj < 2; ++bj)
#pragma unroll
            for (int n = 0; n < 2; ++n) {
                gv[bj][n] = *(const f32x4*)(gate + (size_t)bidx * 6144 + colb + bj * HALF + 4 * n);
                if (HBo) { const f32x4 g = *(const f32x4*)(gnext + colb + bj * HALF + 4 * n), s = *(const f32x4*)(scnext + (size_t)bidx * 6144 + colb + bj * HALF + 4 * n); gm[bj][n] = g * (s + 1.0f); }
                else gm[bj][n] = (f32x4){0.f, 0.f, 0.f, 0.f};
            }
#pragma unroll
        for (int ai = 0; ai < 2; ++ai)
#pragma unroll
            for (int m = 0; m < 4; ++m) {
                const int row = u.pm * BM + ai * HALF + wr * 64 + m * 16 + fr;
                const float* hi_ = isctx ? hin_ctx + (size_t)(row - M_LAT) * DM : hin_lat + (size_t)row * DM;
                float* ho_ = isctx ? hout_ctx + (size_t)(row - M_LAT) * DM : hout_lat + (size_t)row * DM;
                float ss = 0.f;
#pragma unroll
                for (int bj = 0; bj < 2; ++bj) {
                    const int col = colb + bj * HALF;
                    const f32x4 h0 = *(const f32x4*)(hi_ + col), h1 = *(const f32x4*)(hi_ + col + 4);
                    const f32x4 n0 = h0 + gv[bj][0] * acc[ai][bj][m][0], n1 = h1 + gv[bj][1] * acc[ai][bj][m][1];
                    *(f32x4*)(ho_ + col) = n0; *(f32x4*)(ho_ + col + 4) = n1;
                    ss += (n0[0] * n0[0] + n0[1] * n0[1]) + (n0[2] * n0[2] + n0[3] * n0[3]) + (n1[0] * n1[0] + n1[1] * n1[1]) + (n1[2] * n1[2] + n1[3] * n1[3]);
                    if (HBo) { const f32x4 p0 = n0 * gm[bj][0], p1 = n1 * gm[bj][1];
                        u32x4 w; w.x = cvt_pk_bf16(p0[0], p0[1]); w.y = cvt_pk_bf16(p0[2], p0[3]); w.z = cvt_pk_bf16(p1[0], p1[1]); w.w = cvt_pk_bf16(p1[2], p1[3]);
                        *(u32x4*)(HBo + (size_t)row * DM + col) = w; }
                }
                ss += __shfl_xor(ss, 16); ss += __shfl_xor(ss, 32);
                if (fq == 0) rowpart[(size_t)row * 16 + u.pn * 4 + wc] = ss;
                asm volatile("" ::: "memory");
            }
    }
};

struct EpiGLU {
    bf16_t* HID; const float* rowpart; const float* bias;
    __device__ __forceinline__ void operator()(const f32x4 (&acc)[2][2][4][2], const Unit& u, int wr, int wc, int fr, int fq) const {
        const bool isctx = u.pm >= 128; const int bidx = isctx ? 16 : (u.pm >> 3);
        const float* bp = bias + (size_t)bidx * NGU + u.pn * BM + wc * 32 + 8 * fq;
        f32x4 bv[2][2];
#pragma unroll
        for (int bj = 0; bj < 2; ++bj)
#pragma unroll
            for (int n = 0; n < 2; ++n) bv[bj][n] = *(const f32x4*)(bp + bj * HALF + 4 * n);
#pragma unroll
        for (int ai = 0; ai < 2; ++ai)
#pragma unroll
            for (int m = 0; m < 4; ++m) {
                const int row = u.pm * BM + ai * HALF + wr * 64 + m * 16 + fr;
                const float rstd = row_rstd(rowpart, row);
                float o[8];
#pragma unroll
                for (int n = 0; n < 2; ++n) { const f32x4 g = acc[ai][0][m][n] * rstd + bv[0][n], uu = acc[ai][1][m][n] * rstd + bv[1][n];
#pragma unroll
                    for (int e = 0; e < 4; ++e) o[4 * n + e] = siluf_(g[e]) * uu[e]; }
                u32x4 w; w.x = cvt_pk_bf16(o[0], o[1]); w.y = cvt_pk_bf16(o[2], o[3]); w.z = cvt_pk_bf16(o[4], o[5]); w.w = cvt_pk_bf16(o[6], o[7]);
                *(u32x4*)(HID + (size_t)row * DFF + u.pn * HALF + wc * 32 + 8 * fq) = w;
                asm volatile("" ::: "memory");
            }
    }
};
}

DI void transpose_item(const float* W, int ldw, int col0, bf16_t* WT, int K, int dstrow0, int k0, LAS float* scr, int lane) {
#pragma unroll 8
    for (int i = 0; i < 32; ++i) { const int kk = 2 * i + (lane >> 5); scr[kk * 33 + (lane & 31)] = W[(size_t)(k0 + kk) * ldw + col0 + (lane & 31)]; }
    LDS_WAIT();
    const int c = lane & 7;
#pragma unroll
    for (int j = 0; j < 4; ++j) { const int n = (lane >> 3) + 8 * j; const LAS float* s = scr + (8 * c) * 33 + n;
        u32x4 o; o.x = f2bf(s[0]) | (f2bf(s[33]) << 16); o.y = f2bf(s[2 * 33]) | (f2bf(s[3 * 33]) << 16); o.z = f2bf(s[4 * 33]) | (f2bf(s[5 * 33]) << 16); o.w = f2bf(s[6 * 33]) | (f2bf(s[7 * 33]) << 16);
        *(u32x4*)(WT + (size_t)(dstrow0 + n) * K + k0 + 8 * c) = o; }
    LDS_WAIT();
}

DI void gemv17(LAS float* A, LAS float* red, const float* W, int ldw, int col0, int ncols, float* out, int ldo, int oc0, const float* addv, int tid) {
    const int col = tid & 63, ks = tid >> 6;
    float acc[17];
#pragma unroll
    for (int b = 0; b < 17; ++b) acc[b] = 0.f;
    const float* wp = W + (size_t)(ks * 128) * ldw + col0 + (col < ncols ? col : 0);
    for (int k4 = 0; k4 < 32; ++k4) {
        const float w0 = wp[0], w1 = wp[ldw], w2 = wp[2 * (size_t)ldw], w3 = wp[3 * (size_t)ldw]; wp += 4 * (size_t)ldw;
#pragma unroll
        for (int b = 0; b < 17; ++b) { const f32x4 a = *(const LAS f32x4*)(A + b * 1024 + ks * 128 + k4 * 4); acc[b] += (a.x * w0 + a.y * w1) + (a.z * w2 + a.w * w3); }
    }
#pragma unroll
    for (int b = 0; b < 17; ++b) red[(ks * 17 + b) * 64 + col] = acc[b];
    __syncthreads();
    for (int o = tid; o < 17 * 64; o += 512) { const int b = o >> 6, cc = o & 63;
        if (cc < ncols) { float s = 0.f;
#pragma unroll
            for (int k = 0; k < 8; ++k) s += red[(k * 17 + b) * 64 + cc];
            if (addv) s += addv[cc];
            out[(size_t)b * ldo + oc0 + cc] = s; } }
    __syncthreads();
}

DI void rg_unit(const KA a, LAS unsigned char* lds, int l, int b, int hd, int tid_in) {
    const int tid = launder(tid_in);
    const int lane = tid & 63, wid = __builtin_amdgcn_readfirstlane(tid >> 6), r32 = lane & 31, hi = lane >> 5;
    LAS bf16_t* XCB = (LAS bf16_t*)lds;
    LAS float* XCF = (LAS float*)(lds + 18432);
    LAS float* AA = XCF + 8192; LAS float* BX = AA + 8192;
    LAS float* SUB = BX + 8192;
    LAS float* START = SUB + 1024;
    LAS float* CARRY = START + 512;
    LAS float* CW = CARRY + 64;
    const bf16_t* U = (const bf16_t*)(a.ws() + WS_U); float* RGS = (float*)(a.ws() + WS_RGS); bf16_t* MIX = (bf16_t*)(a.ws() + WS_MIX);
    if (tid < 256) CW[tid] = a.in(I_RGCW)[(size_t)l * 1024 + (tid >> 6) * 256 + hd * 64 + (tid & 63)];
    else if (tid < 320) CW[tid] = a.in(I_RGCB)[(size_t)l * 256 + hd * 64 + (tid - 256)];
    __syncthreads();
    const int ch = wid & 1, tg = wid >> 1, cj = 32 * ch + r32;
    for (int dir = 0; dir < 2; ++dir) {
        const float* wa = a.in(I_RGWA) + (size_t)((l * 2 + dir) * 4 + hd) * 4096;
        const float* wx = a.in(I_RGWX) + (size_t)((l * 2 + dir) * 4 + hd) * 4096;
        bf16x8 wfa[4], wfx[4];
#pragma unroll
        for (int ks = 0; ks < 4; ++ks) {
            u32x4 pa, px;
#pragma unroll
            for (int jj = 0; jj < 4; ++jj) { const int i0 = 16 * ks + 8 * hi + 2 * jj;
                pa[jj] = f2bf(wa[i0 * 64 + cj]) | (f2bf(wa[(i0 + 1) * 64 + cj]) << 16);
                px[jj] = f2bf(wx[i0 * 64 + cj]) | (f2bf(wx[(i0 + 1) * 64 + cj]) << 16); }
            wfa[ks] = __builtin_bit_cast(bf16x8, pa); wfx[ks] = __builtin_bit_cast(bf16x8, px);
        }
        const float ba = a.in(I_RGBA)[(size_t)(l * 2 + dir) * 256 + hd * 64 + cj], bxb = a.in(I_RGBX)[(size_t)(l * 2 + dir) * 256 + hd * 64 + cj];
        const float sp8 = -8.0f * softplusf_(-a.in(I_RGLAM)[(size_t)(l * 2 + dir) * 256 + hd * 64 + cj]);
        if (tid < 64) CARRY[tid] = 0.f;
        for (int blk = 0; blk < 18; ++blk) {
            int seg, t0;
            if (dir == 0) { if (blk < 2) { seg = 0; t0 = blk * 128; } else { seg = 1; t0 = (blk - 2) * 128; } }
            else          { if (blk < 2) { seg = 0; t0 = (1 - blk) * 128; } else { seg = 1; t0 = (17 - blk) * 128; } }
            const int seglen = seg ? SEQ : CTXL; const int rowbase = seg ? b * SEQ : M_LAT + b * CTXL;
            { const int tt = tid >> 2, c0 = (tid & 3) * 16, t = t0 + tt;
              float xc[16];
#pragma unroll
              for (int e = 0; e < 16; ++e) xc[e] = CW[256 + c0 + e];
#pragma unroll
              for (int j = 0; j < 4; ++j) { const int ts = t + j - 2;
                  if (ts >= 0 && ts < seglen) { const u32x4* src = (const u32x4*)(U + (size_t)(rowbase + ts) * NU + C_RGX + hd * 64 + c0);
                      const u32x4 x0 = src[0], x1 = src[1];
#pragma unroll
                      for (int e = 0; e < 4; ++e) { xc[2 * e] += CW[j * 64 + c0 + 2 * e] * bflo(x0[e]); xc[2 * e + 1] += CW[j * 64 + c0 + 2 * e + 1] * bfhi(x0[e]);
                                                    xc[8 + 2 * e] += CW[j * 64 + c0 + 8 + 2 * e] * bflo(x1[e]); xc[8 + 2 * e + 1] += CW[j * 64 + c0 + 8 + 2 * e + 1] * bfhi(x1[e]); } } }
#pragma unroll
              for (int e = 0; e < 4; ++e) *(LAS f32x4*)(XCF + tt * 64 + c0 + 4 * e) = (f32x4){xc[4 * e], xc[4 * e + 1], xc[4 * e + 2], xc[4 * e + 3]};
              u32x4 w0, w1;
#pragma unroll
              for (int e = 0; e < 4; ++e) { w0[e] = cvt_pk_bf16(xc[2 * e], xc[2 * e + 1]); w1[e] = cvt_pk_bf16(xc[8 + 2 * e], xc[8 + 2 * e + 1]); }
              *(LAS u32x4*)(XCB + tt * 72 + c0) = w0; *(LAS u32x4*)(XCB + tt * 72 + c0 + 8) = w1; }
            __syncthreads();
            { f32x16 za = {}, zx = {};
#pragma unroll
              for (int ks = 0; ks < 4; ++ks) { const bf16x8 af = *(const LAS bf16x8*)(XCB + (32 * tg + r32) * 72 + 16 * ks + 8 * hi);
                  za = __builtin_amdgcn_mfma_f32_32x32x16_bf16(af, wfa[ks], za, 0, 0, 0); zx = __builtin_amdgcn_mfma_f32_32x32x16_bf16(af, wfx[ks], zx, 0, 0, 0); }
#pragma unroll
              for (int i = 0; i < 16; ++i) { const int tt = 32 * tg + crow(i, hi);
                  const float r = sigmoidf_(za[i] + ba), ig = sigmoidf_(zx[i] + bxb);
                  const float la = sp8 * r; const float av = __expf(la);
                  const float bv = sqrtf(neg_expm1(2.0f * la)) * (ig * XCF[tt * 64 + cj]);
                  AA[tt * 64 + cj] = av; BX[tt * 64 + cj] = bv; } }
            __syncthreads();
            const int c = tid & 63, s = tid >> 6;
            { float Ap = 1.f, Hh = 0.f;
#pragma unroll
              for (int k = 0; k < 16; ++k) { const int tt = 16 * s + (dir ? 15 - k : k); const float av = AA[tt * 64 + c], bv = BX[tt * 64 + c]; Hh = av * Hh + bv; Ap *= av; }
              SUB[(s * 64 + c) * 2] = Ap; SUB[(s * 64 + c) * 2 + 1] = Hh; }
            __syncthreads();
            if (tid < 64) { float carry = CARRY[tid];
#pragma unroll
                for (int si = 0; si < 8; ++si) { const int s2 = dir ? 7 - si : si; START[s2 * 64 + tid] = carry; carry = SUB[(s2 * 64 + tid) * 2] * carry + SUB[(s2 * 64 + tid) * 2 + 1]; }
                CARRY[tid] = carry; }
            __syncthreads();
            { float h = START[s * 64 + c]; const bool need = (seg == 1) || (l == 0);
#pragma unroll
              for (int k = 0; k < 16; ++k) { const int tt = 16 * s + (dir ? 15 - k : k); h = AA[tt * 64 + c] * h + BX[tt * 64 + c];
                  if (need) { const size_t row = (size_t)(rowbase + t0 + tt);
                      if (dir == 0) RGS[row * 256 + hd * 64 + c] = h;
                      else { const float hf = RGS[row * 256 + hd * 64 + c]; const float g = bf2f(U[row * NU + C_RGG + hd * 64 + c]);
                          MIX[row * DM + hd * 64 + c] = (bf16_t)f2bf((hf + h) * gelu_tanh(g)); } } } }
        }
        __syncthreads();
    }
}

DI void ssd_unit(const KA a, LAS unsigned char* lds, int l, int b, int head, int dir, int tid_in) {
    const int tid = launder(tid_in);
    LAS float* XS = (LAS float*)lds; LAS float* BS = XS + 4096; LAS float* CS = BS + 4096; LAS float* YB = CS + 4096;
    LAS float* DA = YB + 4096;
    LAS float* CWS = DA + 64;
    const bf16_t* U = (const bf16_t*)(a.ws() + WS_U); const float* DT = (const float*)(a.ws() + WS_DT); float* YS = (float*)(a.ws() + WS_HB) + (size_t)dir * M_ALL * 256;
    const int grp = head >> 1;
    for (int idx = tid; idx < 960; idx += 512) { const int j = idx / 192, cc = idx % 192;
        const int chn = cc < 64 ? head * 64 + cc : (cc < 128 ? 256 + grp * 64 + (cc - 64) : 384 + grp * 64 + (cc - 128));
        CWS[idx] = j < 4 ? a.in(I_SCW)[(size_t)l * 2048 + j * 512 + chn] : a.in(I_SCB)[(size_t)l * 512 + chn]; }
    const float a_neg = -__expf(a.in(I_SALOG)[(l * 2 + dir) * 4 + head]);
    const int p = tid >> 3, nq = tid & 7;
    float h[8];
#pragma unroll
    for (int j = 0; j < 8; ++j) h[j] = 0.f;
    __syncthreads();
    for (int blk = 0; blk < 36; ++blk) {
        int seg, t0;
        if (dir == 0) { if (blk < 4) { seg = 0; t0 = blk * 64; } else { seg = 1; t0 = (blk - 4) * 64; } }
        else          { if (blk < 4) { seg = 0; t0 = (3 - blk) * 64; } else { seg = 1; t0 = (35 - blk) * 64; } }
        const int seglen = seg ? SEQ : CTXL; const int rowbase = seg ? b * SEQ : M_LAT + b * CTXL;
#pragma unroll 1
        for (int k = 0; k < 3; ++k) { const int item = tid + 512 * k, i = item / 24, q = item % 24; const int t = dir ? t0 + 63 - i : t0 + i;
            const int chU = q < 8 ? head * 64 + 8 * q : (q < 16 ? 256 + grp * 64 + 8 * (q - 8) : 384 + grp * 64 + 8 * (q - 16));
            float v[8];
#pragma unroll
            for (int e = 0; e < 8; ++e) v[e] = CWS[4 * 192 + 8 * q + e];
#pragma unroll
            for (int j = 0; j < 4; ++j) { const int ts = t + j - 2;
                if (ts >= 0 && ts < seglen) { const u32x4 x = *(const u32x4*)(U + (size_t)(rowbase + ts) * NU + C_XBC + chU);
#pragma unroll
                    for (int e = 0; e < 4; ++e) { v[2 * e] += CWS[j * 192 + 8 * q + 2 * e] * bflo(x[e]); v[2 * e + 1] += CWS[j * 192 + 8 * q + 2 * e + 1] * bfhi(x[e]); } } }
            float sc = 1.0f; if (q < 8) sc = DT[(size_t)(rowbase + t) * 8 + dir * 4 + head];
#pragma unroll
            for (int e = 0; e < 8; ++e) v[e] = siluf_(v[e]) * sc;
            LAS float* dst = (q < 8 ? XS + i * 64 + 8 * q : (q < 16 ? BS + i * 64 + 8 * (q - 8) : CS + i * 64 + 8 * (q - 16)));
            *(LAS f32x4*)dst = (f32x4){v[0], v[1], v[2], v[3]}; *(LAS f32x4*)(dst + 4) = (f32x4){v[4], v[5], v[6], v[7]}; }
        if (tid < 64) { const int t = dir ? t0 + 63 - tid : t0 + tid; DA[tid] = __expf(DT[(size_t)(rowbase + t) * 8 + dir * 4 + head] * a_neg); }
        __syncthreads();
#pragma unroll 4
        for (int i = 0; i < 64; ++i) {
            const float dA = DA[i], x = XS[i * 64 + p];
            const f32x4 b0 = *(const LAS f32x4*)(BS + i * 64 + 8 * nq), b1 = *(const LAS f32x4*)(BS + i * 64 + 8 * nq + 4);
            const f32x4 c0 = *(const LAS f32x4*)(CS + i * 64 + 8 * nq), c1 = *(const LAS f32x4*)(CS + i * 64 + 8 * nq + 4);
            float part = 0.f;
#pragma unroll
            for (int j = 0; j < 4; ++j) { h[j] = h[j] * dA + x * b0[j]; h[4 + j] = h[4 + j] * dA + x * b1[j]; part += c0[j] * h[j] + c1[j] * h[4 + j]; }
            part += __shfl_xor(part, 1); part += __shfl_xor(part, 2); part += __shfl_xor(part, 4);
            if (nq == 0) YB[i * 64 + p] = part;
        }
        __syncthreads();
        if (seg == 1 || l == 0) { const int i = tid >> 3, pc = (tid & 7) * 8; const int t = dir ? t0 + 63 - i : t0 + i;
            float* dst = YS + (size_t)(rowbase + t) * 256 + head * 64 + pc;
            *(f32x4*)dst = *(const LAS f32x4*)(YB + i * 64 + pc); *(f32x4*)(dst + 4) = *(const LAS f32x4*)(YB + i * 64 + pc + 4); }
    }
    __syncthreads();
}

DI void ssd_combine_row(const KA a, int l, int row, int lane) {
    const bf16_t* U = (const bf16_t*)(a.ws() + WS_U); const float* YS = (const float*)(a.ws() + WS_HB); bf16_t* MIX = (bf16_t*)(a.ws() + WS_MIX);
    const bool isctx = row >= M_LAT; const int t = isctx ? (row - M_LAT) & (CTXL - 1) : row & (SEQ - 1); const int seglen = isctx ? CTXL : SEQ;
    const int ch = 4 * lane, head = lane >> 4;
    f32x4 v = *(const f32x4*)(a.in(I_SCB) + (size_t)l * 512 + ch);
#pragma unroll
    for (int j = 0; j < 4; ++j) { const int ts = t + j - 2;
        if (ts >= 0 && ts < seglen) { const u32x2 x = *(const u32x2*)(U + (size_t)(row + j - 2) * NU + C_XBC + ch); const f32x4 w = *(const f32x4*)(a.in(I_SCW) + (size_t)l * 2048 + j * 512 + ch);
            v[0] += w[0] * bflo(x[0]); v[1] += w[1] * bfhi(x[0]); v[2] += w[2] * bflo(x[1]); v[3] += w[3] * bfhi(x[1]); } }
    const float dsk = a.in(I_SD)[l * 4 + head];
    const f32x4 yf = *(const f32x4*)(YS + (size_t)row * 256 + ch), yb = *(const f32x4*)(YS + (size_t)M_ALL * 256 + (size_t)row * 256 + ch);
    const u32x2 zz = *(const u32x2*)(U + (size_t)row * NU + C_SZ + ch);
    const float z[4] = {bflo(zz[0]), bfhi(zz[0]), bflo(zz[1]), bfhi(zz[1])};
    float o[4]; float ss = 0.f;
#pragma unroll
    for (int e = 0; e < 4; ++e) { const float y = siluf_(v[e]) * dsk + yf[e] + yb[e]; o[e] = y * siluf_(z[e]); ss += o[e] * o[e]; }
#pragma unroll
    for (int s = 1; s < 32; s <<= 1) ss += __shfl_xor(ss, s);
    const float rs = 1.0f / sqrtf(ss * (1.0f / 128.0f) + EPS);
    const f32x4 g = *(const f32x4*)(a.in(I_SNG) + (size_t)l * 256 + ch);
    u32x2 w; w.x = cvt_pk_bf16(o[0] * rs * g[0], o[1] * rs * g[1]); w.y = cvt_pk_bf16(o[2] * rs * g[2], o[3] * rs * g[3]);
    *(u32x2*)(MIX + (size_t)row * DM + 256 + ch) = w;
}

namespace att {
constexpr int SHM_V = 16384, SHM_K = 16384;
constexpr float THR = 8.0f;
#define KSWZ(row, colB) ((row) * 256 + ((colB) ^ (((row) & 7) << 4)))
#define SBAR() __builtin_amdgcn_sched_barrier(0)
DI int v_st(int k, int c) { const int kk = (k & ~0xC) | ((k & 4) << 1) | ((k & 8) >> 1); return ((kk >> 3) * 4 + (c >> 5)) * 512 + ((kk & 7) * 32 + (c & 31)) * 2; }
DI int v_rd_base(int lane) { return ((lane & 3) << 3) | (((lane >> 2) & 3) << 6) | (((lane >> 4) & 1) << 5) | (((lane >> 5) & 1) << 8); }
constexpr int v_rd_off(int d0, int ks, int half) { return d0 * 512 + ks * 4096 + half * 2048; }
template <int OFF> DI s16x4 tr_read(int vb) { s16x4 r; asm volatile("ds_read_b64_tr_b16 %0, %1 offset:%2" : "=&v"(r) : "v"(vb), "i"(OFF) : "memory"); return r; }

template <int C> DI void qkt(f32x16& p0, f32x16& p1, const LAS char* Ks, const LAS char* Qs, int r32, int hi) {
    p0 = f32x16{}; p1 = f32x16{};
#pragma unroll
    for (int d = 0; d < 4; ++d) { const int d0 = 4 * C + d; const int cb = (d0 * 16 + hi * 8) * 2;
        const bf16x8 b0 = *(const LAS bf16x8*)(Ks + KSWZ(r32, cb));
        const bf16x8 b1 = *(const LAS bf16x8*)(Ks + KSWZ(32 + r32, cb));
        const bf16x8 q = *(const LAS bf16x8*)(Qs + KSWZ(r32, cb));
        p0 = __builtin_amdgcn_mfma_f32_32x32x16_bf16(b0, q, p0, 0, 0, 0);
        p1 = __builtin_amdgcn_mfma_f32_32x32x16_bf16(b1, q, p1, 0, 0, 0); }
}
DI void softmax_tile(f32x16& p0, f32x16& p1, float& m_reg, float& l_reg, float& alpha, bf16x8& pa0, bf16x8& pa1, bf16x8& pa2, bf16x8& pa3) {
    float pmax = p0[0];
#pragma unroll
    for (int r = 1; r < 16; ++r) pmax = fmaxf(pmax, p0[r]);
#pragma unroll
    for (int r = 0; r < 16; ++r) pmax = fmaxf(pmax, p1[r]);
    { auto rr = __builtin_amdgcn_permlane32_swap(__float_as_uint(pmax), __float_as_uint(pmax), false, false); pmax = fmaxf(__uint_as_float(rr[0]), __uint_as_float(rr[1])); }
    if (__builtin_expect(__all(pmax - m_reg <= THR), 1)) { alpha = 1.f; }
    else { const float mn = fmaxf(m_reg, pmax); alpha = __builtin_amdgcn_exp2f(m_reg - mn); m_reg = mn; }
    float ps = 0.f;
#pragma unroll
    for (int r = 0; r < 16; ++r) { p0[r] = __builtin_amdgcn_exp2f(p0[r] - m_reg); ps += p0[r]; }
#pragma unroll
    for (int r = 0; r < 16; ++r) { p1[r] = __builtin_amdgcn_exp2f(p1[r] - m_reg); ps += p1[r]; }
    { auto rr = __builtin_amdgcn_permlane32_swap(__float_as_uint(ps), __float_as_uint(ps), false, false); ps = __uint_as_float(rr[0]) + __uint_as_float(rr[1]); }
    l_reg = l_reg * alpha + ps;
#define PK4(P, BASE, OUT) do { unsigned a0 = cvt_pk_bf16(P[BASE + 0], P[BASE + 1]), a1 = cvt_pk_bf16(P[BASE + 2], P[BASE + 3]);   \
    unsigned b0 = cvt_pk_bf16(P[BASE + 4], P[BASE + 5]), b1 = cvt_pk_bf16(P[BASE + 6], P[BASE + 7]);                              \
    auto r0 = __builtin_amdgcn_permlane32_swap(a0, b0, false, false); auto r1 = __builtin_amdgcn_permlane32_swap(a1, b1, false, false); \
    u32x4 w = {r0[0], r1[0], r0[1], r1[1]}; OUT = __builtin_bit_cast(bf16x8, w); } while (0)
    PK4(p0, 0, pa0); PK4(p0, 8, pa1); PK4(p1, 0, pa2); PK4(p1, 8, pa3);
#undef PK4
}
template <int D0> DI void pv_one(f32x16& oa, f32x16& ob, int vb, const bf16x8 (&pa)[4], const bf16x8 (&pb)[4]) {
    const s16x4 l0 = tr_read<v_rd_off(D0, 0, 0)>(vb), h0 = tr_read<v_rd_off(D0, 0, 1)>(vb), l1 = tr_read<v_rd_off(D0, 1, 0)>(vb), h1 = tr_read<v_rd_off(D0, 1, 1)>(vb);
    const s16x4 l2 = tr_read<v_rd_off(D0, 2, 0)>(vb), h2 = tr_read<v_rd_off(D0, 2, 1)>(vb), l3 = tr_read<v_rd_off(D0, 3, 0)>(vb), h3 = tr_read<v_rd_off(D0, 3, 1)>(vb);
    asm volatile("s_waitcnt lgkmcnt(0)" ::: "memory"); SBAR();
#define PK(L, H) (bf16x8){L[0], L[1], L[2], L[3], H[0], H[1], H[2], H[3]}
    const bf16x8 v0 = PK(l0, h0), v1 = PK(l1, h1), v2 = PK(l2, h2), v3 = PK(l3, h3);
    oa = __builtin_amdgcn_mfma_f32_32x32x16_bf16(pa[0], v0, oa, 0, 0, 0); ob = __builtin_amdgcn_mfma_f32_32x32x16_bf16(pb[0], v0, ob, 0, 0, 0);
    oa = __builtin_amdgcn_mfma_f32_32x32x16_bf16(pa[1], v1, oa, 0, 0, 0); ob = __builtin_amdgcn_mfma_f32_32x32x16_bf16(pb[1], v1, ob, 0, 0, 0);
    oa = __builtin_amdgcn_mfma_f32_32x32x16_bf16(pa[2], v2, oa, 0, 0, 0); ob = __builtin_amdgcn_mfma_f32_32x32x16_bf16(pb[2], v2, ob, 0, 0, 0);
    oa = __builtin_amdgcn_mfma_f32_32x32x16_bf16(pa[3], v3, oa, 0, 0, 0); ob = __builtin_amdgcn_mfma_f32_32x32x16_bf16(pb[3], v3, ob, 0, 0, 0);
#undef PK
}

DI void attn_unit(LAS unsigned char* lds, const bf16_t* __restrict__ U, bf16_t* __restrict__ MIX, int qrow0, int lat0, int nlat, int ctx0, int nctx, int h,
                  float lam, float outscale, const float* __restrict__ subg, int tid_in) {
    const int tid = launder(tid_in);
    const int wid = __builtin_amdgcn_readfirstlane(tid >> 6), lane = tid & 63, r32 = lane & 31, hi = lane >> 5;
    LAS char* V_lds = (LAS char*)lds; LAS char* K_lds = (LAS char*)lds + 2 * SHM_V;
    LAS float* wsf = (LAS float*)(lds + 2 * SHM_V + 2 * SHM_K) + wid * 128;
    LAS char* Qs = (LAS char*)lds + 2 * SHM_V + 2 * SHM_K + 4096 + wid * 8192;
    float mA = -1e30f, lA = 0.f, mB = -1e30f, lB = 0.f;
    f32x16 oA[4] = {}, oB[4] = {};
    { const bf16_t* Qw = U + (size_t)(qrow0 + wid * 32 + r32) * NU + C_Q + h * 128 + hi * 8;
#pragma unroll
      for (int d0 = 0; d0 < 8; ++d0) *(LAS bf16x8*)(Qs + KSWZ(r32, (d0 * 16 + hi * 8) * 2)) = *(const bf16x8*)(Qw + d0 * 16); }
    const int vb0 = (int)(uintptr_t)V_lds + v_rd_base(lane);
    const int NT = nlat + nctx;
    unsigned offK[2], offV[2];
#pragma unroll
    for (int e = 0; e < 2; ++e) { const int row = 8 * wid + 4 * e + (lane >> 4), p = (lane & 15) ^ (row & 7); offK[e] = (unsigned)(row * NU + p * 8) * 2u;
        const int kk = 8 * wid + ((lane & 31) >> 2), k = (kk & ~0xC) | ((kk & 4) << 1) | ((kk & 8) >> 1), col = (2 * e + (lane >> 5)) * 32 + (lane & 3) * 8; offV[e] = (unsigned)(k * NU + col) * 2u; }
    const char* Ubase = (const char*)U + (size_t)h * 256;
#define KROW(j) ((j) < nlat ? lat0 + 64 * (j) : ctx0 + 64 * ((j) - nlat))
#define DMA_TILE(j, bsel) do { const char* tb_ = Ubase + (size_t)KROW(j) * (NU * 2); \
        _Pragma("unroll") for (int e_ = 0; e_ < 2; ++e_) { \
            __builtin_amdgcn_global_load_lds((const unsigned*)(tb_ + C_K * 2 + offK[e_]), (LAS unsigned*)(K_lds + (bsel) * SHM_K + (2 * wid + e_) * 1024), 16, 0, 0); \
            __builtin_amdgcn_global_load_lds((const unsigned*)(tb_ + C_V * 2 + offV[e_]), (LAS unsigned*)(V_lds + (bsel) * SHM_V + (2 * wid + e_) * 1024), 16, 0, 0); } } while (0)
    DMA_TILE(0, 0);
    asm volatile("s_waitcnt vmcnt(0)" ::: "memory"); __syncthreads();
    for (int j = 0; j < NT; ++j) {
        const int bsel = j & 1;
        if (j + 1 < NT) DMA_TILE(j + 1, bsel ^ 1);
        const LAS char* Ks = K_lds + bsel * SHM_K;
        f32x16 p0, p1; bf16x8 pa[4], pb[4]; float alA, alB;
        qkt<0>(p0, p1, Ks, Qs, r32, hi); softmax_tile(p0, p1, mA, lA, alA, pa[0], pa[1], pa[2], pa[3]);
        qkt<1>(p0, p1, Ks, Qs, r32, hi); softmax_tile(p0, p1, mB, lB, alB, pb[0], pb[1], pb[2], pb[3]);
        if (__any(alA < 1.f || alB < 1.f)) {
            if (hi == 0) { wsf[r32] = alA; wsf[32 + r32] = alB; }
            LDS_WAIT();
#pragma unroll
            for (int r = 0; r < 16; ++r) { const float fa = wsf[crow(r, hi)], fb = wsf[32 + crow(r, hi)];
#pragma unroll
                for (int d = 0; d < 4; ++d) { oA[d][r] *= fa; oB[d][r] *= fb; } }
        }
        const int vb = vb0 + bsel * SHM_V;
        pv_one<0>(oA[0], oB[0], vb, pa, pb); pv_one<1>(oA[1], oB[1], vb, pa, pb); pv_one<2>(oA[2], oB[2], vb, pa, pb); pv_one<3>(oA[3], oB[3], vb, pa, pb);
        asm volatile("s_waitcnt vmcnt(0)" ::: "memory"); __syncthreads();
    }
#undef KROW
#undef DMA_TILE
    if (hi == 0) { wsf[64 + r32] = lA; wsf[96 + r32] = lB; }
    LDS_WAIT();
    float ssq[16];
#pragma unroll
    for (int r = 0; r < 16; ++r) { const float ra = __builtin_amdgcn_rcpf(wsf[64 + crow(r, hi)]), rb = lam * __builtin_amdgcn_rcpf(wsf[96 + crow(r, hi)]);
        float s = 0.f;
#pragma unroll
        for (int d = 0; d < 4; ++d) { const float o = oA[d][r] * ra - oB[d][r] * rb; oA[d][r] = o; s += o * o; }
        ssq[r] = s; }
#pragma unroll
    for (int r = 0; r < 16; ++r) {
#pragma unroll
        for (int s = 1; s < 32; s <<= 1) ssq[r] += __shfl_xor(ssq[r], s);
    }
    float gsub[4];
#pragma unroll
    for (int d = 0; d < 4; ++d) gsub[d] = subg[32 * d + r32] * outscale;
#pragma unroll
    for (int r = 0; r < 16; ++r) { const float rs = 1.0f / sqrtf(ssq[r] * (1.0f / 128.0f) + EPS);
        bf16_t* op = MIX + (size_t)(qrow0 + wid * 32 + crow(r, hi)) * DM + 512 + h * 128 + r32;
#pragma unroll
        for (int d = 0; d < 4; ++d) op[32 * d] = (bf16_t)f2bf(oA[d][r] * rs * gsub[d]); }
    __syncthreads();
}
#undef KSWZ
#undef SBAR
}

#define XB_TMO      128
#define XB_XCNT(j)  (256  + 64 * (j))
#define XB_XSUB(j)  (1280 + 64 * (j))
#define XB_XGEN(j)  (2304 + 64 * (j))
#define XB_TOP      3328
#define XB_TOPGEN   3392
#define XCD_BAR_WORDS 3456
#define XB_SPIN_CAP (1u << 20)
DI unsigned xb_ld(unsigned* p)              { return __hip_atomic_load(p, __ATOMIC_RELAXED, __HIP_MEMORY_SCOPE_AGENT); }
DI unsigned xb_add(unsigned* p, unsigned v) { return __hip_atomic_fetch_add(p, v, __ATOMIC_RELAXED, __HIP_MEMORY_SCOPE_AGENT); }
DI unsigned xb_xcc_id() { return (unsigned)__builtin_amdgcn_s_getreg((3 << 11) | 20) & 0xFu; }
#define XB_SPIN(cond, bar) do { unsigned _sp = 0; while (cond) { __builtin_amdgcn_s_sleep(1); \
    if ((++_sp & 255u) == 0u) { if (xb_ld(&(bar)[XB_TMO])) break; if (_sp > XB_SPIN_CAP) { atomicAdd(&(bar)[XB_TMO], 1u); break; } } } } while (0)
struct XcdBarrier { unsigned* bar; unsigned x; volatile LAS unsigned* st; };
DI void xcd_barrier_complete(unsigned* bar, unsigned x, unsigned& nloc, unsigned& nx) {
    const unsigned G = gridDim.x;
    unsigned sum, cnt, mine, sp = 0u;
    for (;;) {
        sum = 0u; cnt = 0u; mine = 0u;
#pragma unroll
        for (unsigned j = 0; j < 16; ++j) { const unsigned c = xb_ld(&bar[XB_XCNT(j)]); sum += c; cnt += (c > 0u) ? 1u : 0u; mine = (j == x) ? c : mine; }
        if (sum == G) break;
        __builtin_amdgcn_s_sleep(1);
        if ((++sp & 255u) == 0u) { if (xb_ld(&bar[XB_TMO])) break; if (sp > XB_SPIN_CAP) { atomicAdd(&bar[XB_TMO], 1u); break; } }
    }
    nloc = mine > 0u ? mine : 1u; nx = cnt > 0u ? cnt : 1u;
}
DI void xcd_barrier(const XcdBarrier& b, int tid) {
    asm volatile("s_waitcnt vmcnt(0)" ::: "memory");
    __syncthreads();
    if (tid == 0) {
        unsigned* bar = b.bar;
        __builtin_amdgcn_s_waitcnt(0);
        unsigned nloc = b.st[0], nx = b.st[1];
        if (nloc == 0u) { xcd_barrier_complete(bar, b.x, nloc, nx); b.st[0] = nloc; b.st[1] = nx; }
        const unsigned old = xb_add(&bar[XB_XSUB(b.x)], 1u);
        const unsigned gen = old / nloc;
        if (old + 1u == (gen + 1u) * nloc) {
            __builtin_amdgcn_fence(__ATOMIC_RELEASE, "agent");
            asm volatile("s_waitcnt vmcnt(0)" ::: "memory");
            const unsigned og = xb_add(&bar[XB_TOP], 1u);
            const unsigned tg = og / nx;
            if (og + 1u == (tg + 1u) * nx) xb_add(&bar[XB_TOPGEN], 1u);
            else XB_SPIN(xb_ld(&bar[XB_TOPGEN]) == tg, bar);
            __builtin_amdgcn_fence(__ATOMIC_ACQUIRE, "agent");
            xb_add(&bar[XB_XGEN(b.x)], 1u);
            asm volatile("s_waitcnt vmcnt(0)" ::: "memory");
        } else {
            XB_SPIN(xb_ld(&bar[XB_XGEN(b.x)]) == gen, bar);
            __builtin_amdgcn_fence(__ATOMIC_ACQUIRE, "agent");
            asm volatile("s_waitcnt vmcnt(0)" ::: "memory");
        }
    }
    __syncthreads();
}

__global__ void __launch_bounds__(512) hybrid_fwd(Args args_unused) {
    extern __shared__ __attribute__((aligned(16))) unsigned char lds_raw[];
    LAS unsigned char* lds = (LAS unsigned char*)lds_raw;
    const int wave0 = __builtin_amdgcn_readfirstlane((int)threadIdx.x >> 6);
    const int G = gridDim.x, bid = blockIdx.x;
    const int vcu = (G % 8 == 0) ? (bid % 8) * (G / 8) + bid / 8 : bid;
    const int NGW = G * 8;
#define PHASE_IDS() const KA a = ka_fresh(); unsigned char* const ws = a.ws(); const int lane = lane_fresh(), wave = launder_s(wave0), tid = wave * 64 + lane, gw = vcu * 8 + wave; (void)tid; (void)gw; (void)ws
    {
        const KA a = ka_fresh(); unsigned* bar = (unsigned*)a.ws(); const unsigned x = (unsigned)__builtin_amdgcn_readfirstlane((int)xb_xcc_id());
        volatile LAS unsigned* st = (volatile LAS unsigned*)(lds + 143360);
        if (threadIdx.x == 0) { st[0] = 0u; st[1] = 0u; (void)xb_add(&bar[XB_XCNT(x)], 1u); }
        __syncthreads();
    }
#define GRID_BAR() do { const KA a_ = ka_fresh(); XcdBarrier xb_; xb_.bar = (unsigned*)a_.ws(); xb_.x = (unsigned)__builtin_amdgcn_readfirstlane((int)xb_xcc_id()); xb_.st = (volatile LAS unsigned*)(lds + 143360); \
        xcd_barrier(xb_, launder_s(wave0) * 64 + lane_fresh()); } while (0)

    {
        PHASE_IDS();
        float* MOD = (float*)(ws + WS_MOD); float* ROPE = (float*)(ws + WS_ROPE); float* WDT = (float*)(ws + WS_WDT);
        LAS float* A = (LAS float*)lds; LAS float* red = (LAS float*)(lds + 73728);
        for (int it = bid; it < 2 * 96; it += G) { const int l = it / 96, cb = it % 96;
            for (int i = tid; i < 17 * 1024; i += 512) { const int b = i >> 10, k = i & 1023; const float cv = b < 16 ? a.in(I_C)[b * 1024 + k] : a.in(I_CCTX)[k]; A[i] = siluf_(cv); }
            __syncthreads();
            gemv17(A, red, a.in(I_WMOD) + (size_t)l * 1024 * 6144, 6144, cb * 64, 64, MOD + (size_t)l * 17 * 6144, 6144, cb * 64, a.in(I_BMOD) + (size_t)l * 6144 + cb * 64, tid);
        }
        LAS float* scr = (LAS float*)(lds + wave * 16384);
        for (int it = gw; it < 2 * 6144; it += NGW) { const int l = it / 6144; int r = it % 6144; unsigned char* wl = ws + WS_W + (size_t)l * W_LAYER;
            if (r < 1408) { const int kb = r / 88, nb = r % 88, n0 = 32 * nb; transpose_item(a.in(I_WIN) + (size_t)l * 1024 * DIN, DIN, n0 < 1280 ? n0 : n0 + 8, (bf16_t*)(wl + W_IN), 1024, n0, 64 * kb, scr, lane); continue; } r -= 1408;
            if (r < 512) { const int kb = r / 32, nb = r % 32; transpose_item(a.in(I_WOUT) + (size_t)l * 1024 * 1024, 1024, 32 * nb, (bf16_t*)(wl + W_OUT), 1024, 32 * nb, 64 * kb, scr, lane); continue; } r -= 512;
            if (r < 2816) { const int kb = r / 176, nb = r % 176, n0 = 32 * nb, pn = n0 >> 8, bj = (n0 >> 7) & 1, j = n0 & 127;
                transpose_item((bj ? a.in(I_WUP) : a.in(I_WGATE)) + (size_t)l * 1024 * DFF, DFF, 128 * pn + j, (bf16_t*)(wl + W_GU), 1024, n0, 64 * kb, scr, lane); continue; } r -= 2816;
            { const int kb = r / 32, nb = r % 32; transpose_item(a.in(I_WDOWN) + (size_t)l * DFF * 1024, 1024, 32 * nb, (bf16_t*)(wl + W_DOWN), DFF, 32 * nb, 64 * kb, scr, lane); }
        }
        const int gt = bid * 512 + tid;
        if (gt < 2 * 8192) { const int l = gt >> 13, j = (gt >> 10) & 7, k = gt & 1023; WDT[gt] = a.in(I_WIN)[(size_t)l * 1024 * DIN + (size_t)k * DIN + 1280 + j]; }
        if (gt < 1024) { const int pos = gt >> 4, j = gt & 15; const float invf = __builtin_amdgcn_exp2f(-(float)j * 0.8304820237218406f); const float ang = (float)pos * invf; ROPE[gt * 2] = __cosf(ang); ROPE[gt * 2 + 1] = __sinf(ang); }
    }
    cg::this_grid().sync();
    {
        PHASE_IDS();
        float* MOD = (float*)(ws + WS_MOD); float* BIAS_IN = (float*)(ws + WS_BIAS_IN); float* BIAS_DT = (float*)(ws + WS_BIAS_DT); float* BIAS_GU = (float*)(ws + WS_BIAS_GU);
        float* ROWPART = (float*)(ws + WS_ROWPART); bf16_t* HB = (bf16_t*)(ws + WS_HB);
        LAS float* A = (LAS float*)lds; LAS float* red = (LAS float*)(lds + 73728);
        for (int it = bid; it < 2 * 133; it += G) { const int l = it / 133, r = it % 133; const int chunk = r < 45 ? 0 : 3;
            for (int i = tid; i < 17 * 1024; i += 512) { const int b = i >> 10, k = i & 1023; A[i] = MOD[(size_t)l * 17 * 6144 + (size_t)b * 6144 + chunk * 1024 + k]; }
            __syncthreads();
            if (r < 44) gemv17(A, red, a.in(I_WIN) + (size_t)l * 1024 * DIN, DIN, (64 * r < 1280 ? 64 * r : 64 * r + 8), 64, BIAS_IN + (size_t)l * 17 * NU, NU, 64 * r, nullptr, tid);
            else if (r == 44) gemv17(A, red, a.in(I_WIN) + (size_t)l * 1024 * DIN, DIN, 1280, 8, BIAS_DT + (size_t)l * 17 * 8, 8, 0, nullptr, tid);
            else { const int n0 = 64 * (r - 45), pn = n0 >> 8, bj = (n0 >> 7) & 1, j = n0 & 127;
                gemv17(A, red, (bj ? a.in(I_WUP) : a.in(I_WGATE)) + (size_t)l * 1024 * DFF, DFF, 128 * pn + j, 64, BIAS_GU + (size_t)l * 17 * NGU, NGU, n0, nullptr, tid); }
        }
        for (int row = gw; row < M_ALL; row += NGW) {
            const bool isctx = row >= M_LAT; const int b = isctx ? 16 : row >> 11;
            const float* xr = isctx ? a.in(I_CTX) + (size_t)(row - M_LAT) * DM : a.in(I_X) + (size_t)row * DM;
            const float* g = a.in(I_N1G); const float* sc = MOD + (size_t)b * 6144 + 1024;
            float ss = 0.f;
#pragma unroll
            for (int j = 0; j < 4; ++j) { const int col = (lane + 64 * j) * 4; const f32x4 v = *(const f32x4*)(xr + col); const f32x4 gg = *(const f32x4*)(g + col), s4 = *(const f32x4*)(sc + col);
                ss += (v.x * v.x + v.y * v.y) + (v.z * v.z + v.w * v.w); const f32x4 p = v * (gg * (s4 + 1.0f));
                u32x2 w; w.x = cvt_pk_bf16(p.x, p.y); w.y = cvt_pk_bf16(p.z, p.w); *(u32x2*)(HB + (size_t)row * DM + col) = w; }
            ss = wave_sum(ss);
            if (lane < 4) { f32x4 o = {0.f, 0.f, 0.f, 0.f}; if (lane == 0) o.x = ss; *(f32x4*)(ROWPART + (size_t)row * 16 + lane * 4) = o; }
        }
    }
    GRID_BAR();

    for (int l = 0; l < 2; ++l) {
        const int nM = (l == 0) ? 144 : 128;
        {
            PHASE_IDS();
            bf16_t* HB = (bf16_t*)(ws + WS_HB); float* rp1 = (float*)(ws + WS_ROWPART) + (size_t)(2 * l) * ROWPART_STRIDE;
            pg8::Gemm g{HB, (const bf16_t*)(ws + WS_W + (size_t)l * W_LAYER + W_IN), 1024}; pg8::TileOrder S; S.init(nM, 11, G, bid, l == 0 ? 0 : 112);
            pg8::EpiIn E{(bf16_t*)(ws + WS_U), rp1, (const float*)(ws + WS_BIAS_IN) + (size_t)l * 17 * NU, (const float*)(ws + WS_ROPE)};
            pg8::gemm_phase<pg8::EpiIn, true>(lds, g, S, E, wave0);
            LAS float* WT = (LAS float*)lds;
            const float* WDT = (const float*)(ws + WS_WDT); const float* BIAS_DT = (const float*)(ws + WS_BIAS_DT); float* DT = (float*)(ws + WS_DT);
            for (int i = tid; i < 8192; i += 512) WT[i] = WDT[l * 8192 + i];
            __syncthreads();
            for (int row = gw; row < M_ALL; row += NGW) {
                const bool isctx = row >= M_LAT; const int b = isctx ? 16 : row >> 11;
                float acc[8];
#pragma unroll
                for (int j = 0; j < 8; ++j) acc[j] = 0.f;
#pragma unroll
                for (int kk = 0; kk < 2; ++kk) { const u32x4 x = *(const u32x4*)(HB + (size_t)row * DM + 8 * lane + 512 * kk);
                    const float xf[8] = {bflo(x[0]), bfhi(x[0]), bflo(x[1]), bfhi(x[1]), bflo(x[2]), bfhi(x[2]), bflo(x[3]), bfhi(x[3])};
#pragma unroll
                    for (int j = 0; j < 8; ++j) { const f32x4 w0 = *(const LAS f32x4*)(WT + j * 1024 + 8 * lane + 512 * kk), w1 = *(const LAS f32x4*)(WT + j * 1024 + 8 * lane + 512 * kk + 4);
                        acc[j] += (xf[0] * w0[0] + xf[1] * w0[1]) + (xf[2] * w0[2] + xf[3] * w0[3]) + (xf[4] * w1[0] + xf[5] * w1[1]) + (xf[6] * w1[2] + xf[7] * w1[3]); } }
#pragma unroll
                for (int j = 0; j < 8; ++j) acc[j] = wave_sum(acc[j]);
                const float rstd = pg8::row_rstd(rp1, row);
                float mine = acc[0];
#pragma unroll
                for (int j = 1; j < 8; ++j) mine = (lane == j) ? acc[j] : mine;
                if (lane < 8) { const float raw = mine * rstd + BIAS_DT[(size_t)l * 17 * 8 + b * 8 + lane] + a.in(I_SDTB)[l * 8 + lane]; DT[(size_t)row * 8 + lane] = softplusf_(raw); }
            }
        }
        GRID_BAR();
        {
            PHASE_IDS();
            const bf16_t* U = (const bf16_t*)(ws + WS_U); bf16_t* MIX = (bf16_t*)(ws + WS_MIX);
            float lam, lam_init;
            { const float* lv = a.in(I_DALAM) + (size_t)l * 256; const float s1 = wave_sum(lv[lane] * lv[64 + lane]), s2 = wave_sum(lv[128 + lane] * lv[192 + lane]);
              lam_init = 0.8f - 0.6f * __expf(-0.3f * (float)l); lam = uniformf(__expf(s1) - __expf(s2) + lam_init); lam_init = uniformf(lam_init); }
            const float* subg = a.in(I_DASG) + (size_t)l * 128;
            for (int u = vcu; u < 768; u += G) {
                if (u < 128) ssd_unit(a, lds, l, u >> 3, (u >> 1) & 3, u & 1, tid);
                else if (u < 192) rg_unit(a, lds, l, (u - 128) >> 2, (u - 128) & 3, tid);
                else if (u < 256) { if (l == 0) { const int b = (u - 192) >> 2, h = (u - 192) & 3; att::attn_unit(lds, U, MIX, M_LAT + b * CTXL, 0, 0, M_LAT + b * CTXL, 4, h, lam, 1.0f - lam_init, subg, tid); } }
                else { const int aidx = u - 256, bh = aidx >> 3, qb = aidx & 7, b = bh >> 2, h = bh & 3;
                    att::attn_unit(lds, U, MIX, b * SEQ + qb * 256, b * SEQ, 32, M_LAT + b * CTXL, 4, h, lam, 1.0f - lam_init, subg, tid); }
                __syncthreads();
            }
        }
        GRID_BAR();
        {
            PHASE_IDS();
            const int nrows = (l == 0) ? M_ALL : M_LAT;
            for (int row = gw; row < nrows; row += NGW) ssd_combine_row(a, l, row, lane);
        }
        GRID_BAR();
        {
            PHASE_IDS();
            const float* modl = (const float*)(ws + WS_MOD) + (size_t)l * 17 * 6144; float* HCTX = (float*)(ws + WS_HCTX);
            pg8::Gemm g{(const bf16_t*)(ws + WS_MIX), (const bf16_t*)(ws + WS_W + (size_t)l * W_LAYER + W_OUT), 1024}; pg8::TileOrder S; S.init(nM, 4, G, bid, 0);
            pg8::EpiRes E{l == 0 ? a.in(I_X) : (const float*)a.out(), l == 0 ? a.in(I_CTX) : (const float*)HCTX, a.out(), HCTX, modl + 2 * 1024, (bf16_t*)(ws + WS_HB), a.in(I_N2G) + (size_t)l * 1024, modl + 4 * 1024,
                          (float*)(ws + WS_ROWPART) + (size_t)(2 * l + 1) * ROWPART_STRIDE};
            pg8::gemm_phase<pg8::EpiRes, true>(lds, g, S, E, wave0);
        }
        GRID_BAR();
        {
            PHASE_IDS();
            pg8::Gemm g{(const bf16_t*)(ws + WS_HB), (const bf16_t*)(ws + WS_W + (size_t)l * W_LAYER + W_GU), 1024}; pg8::TileOrder S; S.init(nM, 22, G, bid, 0);
            pg8::EpiGLU E{(bf16_t*)(ws + WS_U), (const float*)(ws + WS_ROWPART) + (size_t)(2 * l + 1) * ROWPART_STRIDE, (const float*)(ws + WS_BIAS_GU) + (size_t)l * 17 * NGU};
            pg8::gemm_phase<pg8::EpiGLU, true>(lds, g, S, E, wave0);
        }
        GRID_BAR();
        {
            PHASE_IDS();
            const float* MOD = (const float*)(ws + WS_MOD); float* HCTX = (float*)(ws + WS_HCTX);
            pg8::Gemm g{(const bf16_t*)(ws + WS_U), (const bf16_t*)(ws + WS_W + (size_t)l * W_LAYER + W_DOWN), DFF}; pg8::TileOrder S; S.init(nM, 4, G, bid, 0);
            pg8::EpiRes E{(const float*)a.out(), (const float*)HCTX, a.out(), HCTX, MOD + (size_t)l * 17 * 6144 + 5 * 1024, l == 0 ? (bf16_t*)(ws + WS_HB) : nullptr, a.in(I_N1G) + 1024, MOD + (size_t)17 * 6144 + 1024,
                          (float*)(ws + WS_ROWPART) + (size_t)(2 * l + 2) * ROWPART_STRIDE};
            pg8::gemm_phase<pg8::EpiRes, true>(lds, g, S, E, wave0);
        }
        GRID_BAR();
    }
    {
        PHASE_IDS();
        const float* rpf = (const float*)(ws + WS_ROWPART) + (size_t)4 * ROWPART_STRIDE; const float* g = a.in(I_FNG); float* outp = a.out();
        for (int row = gw; row < M_LAT; row += NGW) {
            const float rstd = pg8::row_rstd(rpf, row); float* o = outp + (size_t)row * DM;
#pragma unroll
            for (int j = 0; j < 4; ++j) { const int col = (lane + 64 * j) * 4; const f32x4 v = *(const f32x4*)(o + col), gg = *(const f32x4*)(g + col); *(f32x4*)(o + col) = v * rstd * gg; }
        }
    }
}

extern "C" void kernel_launch(void* const* d_in, const int* in_sizes, int n_in, void* d_out, int out_size, void* d_ws, size_t ws_size, hipStream_t stream) {
    static int grid = 0;
    if (grid == 0) {
        if (n_in != N_IN || in_sizes[0] != M_LAT * DM || out_size != M_LAT * DM || ws_size < WS_END) {
            fprintf(stderr, "kernel_launch: unexpected shapes (n_in %d, in0 %d, out %d, ws %zu); nothing launched\n", n_in, n_in > 0 ? in_sizes[0] : -1, out_size, ws_size); grid = -1; return; }
        int dev = 0, cus = 0, per_cu = 0;
        if (hipGetDevice(&dev) != hipSuccess || hipDeviceGetAttribute(&cus, hipDeviceAttributeMultiprocessorCount, dev) != hipSuccess) { grid = -1; return; }
        if (hipFuncSetAttribute((const void*)hybrid_fwd, hipFuncAttributeMaxDynamicSharedMemorySize, LDS_BYTES) != hipSuccess) { fprintf(stderr, "kernel_launch: hipFuncSetAttribute failed\n"); grid = -1; return; }
        if (hipOccupancyMaxActiveBlocksPerMultiprocessor(&per_cu, (const void*)hybrid_fwd, 512, LDS_BYTES) != hipSuccess || per_cu < 1) { fprintf(stderr, "kernel_launch: occupancy query says %d\n", per_cu); (void)hipGetLastError(); grid = -1; return; }
        grid = cus * (per_cu < 1 ? 1 : 1);
    }
    if (grid < 0) return;
    if (hipMemsetAsync(d_ws, 0, 65536, stream) != hipSuccess) { fprintf(stderr, "kernel_launch: memset failed\n"); return; }
    Args a{};
    for (int i = 0; i < N_IN; ++i) a.in[i] = (const float*)d_in[i];
    a.out = (float*)d_out; a.ws = (unsigned char*)d_ws;
    void* args[] = {&a};
    hipError_t e = hipLaunchCooperativeKernel((const void*)hybrid_fwd, dim3(grid), dim3(512), args, LDS_BYTES, stream);
    if (e != hipSuccess) fprintf(stderr, "kernel_launch: cooperative launch failed: %s (grid %d)\n", hipGetErrorString(e), grid);
}
```

```cpp
#include <hip/hip_runtime.h>
#include <hip/hip_cooperative_groups.h>
#include <cstdio>
#include <cstdint>
namespace cg = cooperative_groups;

#define LAS __attribute__((address_space(3)))
#define DI __device__ __forceinline__
typedef unsigned short bf16_t;
typedef short bf16x8 __attribute__((ext_vector_type(8)));
typedef short s16x4 __attribute__((ext_vector_type(4)));
typedef float f32x4 __attribute__((ext_vector_type(4)));
typedef float f32x2 __attribute__((ext_vector_type(2)));
typedef float f32x16 __attribute__((ext_vector_type(16)));
typedef unsigned u32x4 __attribute__((ext_vector_type(4)));
typedef unsigned u32x2 __attribute__((ext_vector_type(2)));

constexpr int DM = 1024, NB = 16, SEQ = 2048, CTXL = 256;
constexpr int M_LAT = NB * SEQ, M_CTX = NB * CTXL, M_ALL = M_LAT + M_CTX;
constexpr int NU = 2816, DFF = 2816, NGU = 5632, DIN = 2824;
constexpr int C_RGX = 0, C_RGG = 256, C_SZ = 512, C_XBC = 768, C_Q = 1280, C_K = 1792, C_V = 2304;
constexpr float EPS = 1e-6f;
constexpr float QSCALE = 0.125f * 1.4426950408889634f;
enum { I_X = 0, I_C, I_CTX, I_CCTX, I_WMOD, I_BMOD, I_N1G, I_WIN, I_RGCW, I_RGCB, I_RGWA, I_RGBA, I_RGWX, I_RGBX, I_RGLAM, I_SCW, I_SCB, I_SDTB, I_SALOG,
       I_SD, I_SNG, I_DALAM, I_DASG, I_WOUT, I_N2G, I_WGATE, I_WUP, I_WDOWN, I_FNG, N_IN };

constexpr size_t MiB = 1u << 20;
constexpr size_t WS_MOD = 1 * MiB;
constexpr size_t WS_BIAS_IN = 2 * MiB;
constexpr size_t WS_BIAS_DT = 2 * MiB + 512 * 1024;
constexpr size_t WS_BIAS_GU = 3 * MiB;
constexpr size_t WS_ROPE = 4 * MiB;
constexpr size_t WS_WDT = 4 * MiB + 64 * 1024;
constexpr size_t WS_DT = 5 * MiB;
constexpr size_t WS_ROWPART = 8 * MiB;
constexpr size_t ROWPART_STRIDE = (size_t)M_ALL * 16;
constexpr size_t WS_W = 20 * MiB;
constexpr size_t W_LAYER = 24 * MiB, W_IN = 0, W_OUT = 5 * MiB + 512 * 1024, W_GU = 7 * MiB + 512 * 1024, W_DOWN = 18 * MiB + 512 * 1024;
constexpr size_t WS_CS = 68 * MiB;
constexpr size_t WS_DTS = 70 * MiB;
constexpr size_t WS_HCTX = 426 * MiB;
constexpr size_t WS_HB = 84 * MiB;
constexpr size_t WS_U = 156 * MiB;
constexpr size_t WS_MIX = 354 * MiB;
constexpr size_t WS_RGS = 426 * MiB;
constexpr size_t WS_XBCA = 444 * MiB;
constexpr size_t WS_XC = 480 * MiB;
constexpr size_t WS_END = 498 * MiB;
constexpr int LDS_BYTES = 147456;
constexpr int REP_P0 = 1, REP_P1 = 1, REP_P2 = 1, REP_P4 = 1; constexpr bool P2_SKIP_SSD_ON_REP = false, P2_SKIP_ATT_ON_REP = false, P2_SKIP_RG_ON_REP = false;

struct Args { const float* in[N_IN]; float* out; unsigned char* ws; };
typedef const unsigned char __attribute__((address_space(4)))* kptr_t;
struct KA {
    kptr_t kb;
    __device__ __forceinline__ const float* in(int i) const { return *(const float* const __attribute__((address_space(4)))*)(kb + 8 * i); }
    __device__ __forceinline__ float* out() const { return *(float* const __attribute__((address_space(4)))*)(kb + 8 * N_IN); }
    __device__ __forceinline__ unsigned char* ws() const { return *(unsigned char* const __attribute__((address_space(4)))*)(kb + 8 * (N_IN + 1)); }
};
__device__ __forceinline__ KA ka_fresh() { kptr_t p = (kptr_t)__builtin_amdgcn_kernarg_segment_ptr(); asm volatile("" : "+s"(p)); return KA{p}; }

DI unsigned cvt_pk_bf16(float lo, float hi) { unsigned r; asm volatile("v_cvt_pk_bf16_f32 %0, %1, %2" : "=v"(r) : "v"(lo), "v"(hi)); return r; }
DI unsigned f2bf(float f) { unsigned u = __builtin_bit_cast(unsigned, f); return (u + 0x7fffu + ((u >> 16) & 1u)) >> 16; }
DI float bf2f(unsigned v) { return __builtin_bit_cast(float, v << 16); }
DI float bflo(unsigned w) { return __builtin_bit_cast(float, w << 16); }
DI float bfhi(unsigned w) { return __builtin_bit_cast(float, w & 0xffff0000u); }
DI float sigmoidf_(float x) { return 1.0f / (1.0f + __expf(-x)); }
DI float siluf_(float x) { return x / (1.0f + __expf(-x)); }
DI float log1p_small(float e) { return e < 1e-3f ? e * (1.0f - 0.5f * e) : __logf(1.0f + e); }
DI float softplusf_(float x) { return fmaxf(x, 0.f) + log1p_small(__expf(-fabsf(x))); }
DI float neg_expm1(float x) { return x > -0.02f ? -x * (1.0f + x * (0.5f + x * 0.16666667f)) : 1.0f - __expf(x); }
DI float gelu_tanh(float x) { const float u = 0.7978845608028654f * (x + 0.044715f * x * x * x); return x / (1.0f + __expf(-2.0f * u)); }
DI float uniformf(float v) { return __builtin_bit_cast(float, __builtin_amdgcn_readfirstlane(__builtin_bit_cast(int, v))); }
DI float wave_sum(float v) {
#pragma unroll
    for (int o = 1; o < 64; o <<= 1) v += __shfl_xor(v, o);
    return v;
}
DI int crow(int r, int hi) { return (r & 3) + 8 * (r >> 2) + 4 * hi; }
#define LDS_WAIT() asm volatile("s_waitcnt lgkmcnt(0)" ::: "memory")
DI int lane_fresh() { int r; asm volatile("v_mbcnt_lo_u32_b32 %0, -1, 0\n\tv_mbcnt_hi_u32_b32 %0, -1, %0" : "=v"(r)); return r; }
DI int launder_s(int x) { asm volatile("" : "+s"(x)); return x; }
DI int launder(int x) { asm volatile("" : "+v"(x)); return x; }

namespace pg8 {
#define PG8_LAS __attribute__((address_space(3)))
constexpr int BM = 256, BK = 64, HALF = 128, HTB = HALF * BK * 2, STAGE_BYTES = 8 * HTB, NXCD = 8, WGM = 8;
__host__ __device__ __forceinline__ int lds_byte(int r, int c) { const int st = (r >> 4) * 2 + (c >> 5), rr = r & 15, cc = c & 31, ob = rr * 64 + cc * 2; return st * 1024 + (ob ^ (((ob >> 9) & 1) << 5)); }
__host__ __device__ __forceinline__ void stage_rc(int b, int& R, int& C) { const int st = b / 1024, sb = b % 1024, swz = sb ^ (((sb >> 9) & 1) << 5); R = (st >> 1) * 16 + swz / 64; C = (st & 1) * 32 + (swz % 64) / 2; }
__host__ __device__ __forceinline__ int perm32(int rho) { const int n = rho >> 4, i = rho & 15; return 8 * (i >> 2) + 4 * n + (i & 3); }
struct Unit { int pm, pn; };
struct Gemm { const bf16_t* A; const bf16_t* Bt; int K; };

struct TileOrder {
    int nM, nN, nwg, G, c, n2;
    __device__ void init(int nM_, int nN_, int G_, int c_, int n2_) { nM = nM_; nN = nN_; nwg = nM * nN; G = G_; c = c_; n2 = n2_; }
    __device__ bool next(int i, Unit& u) const {
        const int L = i * G + c;
        if (L < nwg) {
            int wgid = L; { const int q = nwg / NXCD, r = nwg % NXCD, xcd = wgid % NXCD, off = wgid / NXCD; wgid = (xcd < r ? xcd * (q + 1) : r * (q + 1) + (xcd - r) * q) + off; }
            const int nig = WGM * nN, gid = wgid / nig, fm = gid * WGM, gsz = (nM - fm) < WGM ? (nM - fm) : WGM;
            u.pm = fm + ((wgid % nig) % gsz); u.pn = (wgid % nig) / gsz; return true;
        }
        const int L2 = L - nwg;
        if (L2 < n2) { u.pm = 128 + (L2 & 15); const int ci = L2 >> 4; u.pn = ci == 0 ? 0 : (ci < 3 ? ci + 2 : ci + 4); return true; }
        return false;
    }
};

template <class Epi, bool ALIGN_EPI>
__device__ __forceinline__ void gemm_phase(PG8_LAS unsigned char* lds, const Gemm g, const TileOrder& S, const Epi& E, const int wave_id) {
    const int lane = lane_fresh(), wid = launder_s(wave_id), tid = wid * 64 + lane, wr = wid >> 2, wc = wid & 3, fr = lane & 15, fq = lane >> 4;
    const int K = g.K, nt = K / BK;
    unsigned voffA[2], voffB[2];
#pragma unroll
    for (int i = 0; i < 2; ++i) { int R, C; stage_rc(tid * 16 + i * 8192, R, C); const int Rb = (R & ~31) + perm32(R & 31);
        voffA[i] = (unsigned)(R * K + C) * 2u; voffB[i] = (unsigned)(Rb * K + C) * 2u; }
    const size_t kstep = (size_t)(BK * 2);
    const size_t hstep = (size_t)HALF * K * 2;
    const size_t tstep = 2 * hstep;
    const unsigned ldsw = (unsigned)wid * 1024u;
    const int aoff = lds_byte(wr * 64 + fr, fq * 8), boff = lds_byte(wc * 32 + fr, fq * 8);
#define PG8_SA(b, h) (((b) * 2 + (h)) * HTB)
#define PG8_SB(b, h) ((4 + (b) * 2 + (h)) * HTB)
#define PG8_STAGE(bufoff, gbase, voff) do { _Pragma("unroll") for (int _i = 0; _i < 2; ++_i) \
        __builtin_amdgcn_global_load_lds((const unsigned*)((const char*)(gbase) + (voff)[_i]), (PG8_LAS unsigned*)(lds + (bufoff) + ldsw + _i * 8192), 16, 0, 0); } while (0)
#define PG8_LDA(dst, b, h) do { _Pragma("unroll") for (int m = 0; m < 4; ++m) _Pragma("unroll") for (int k = 0; k < 2; ++k) dst[m][k] = *(const PG8_LAS bf16x8*)(lds + PG8_SA(b, h) + aoff + m * 2048 + k * 1024); } while (0)
#define PG8_LDB(dst, b, h) do { _Pragma("unroll") for (int n = 0; n < 2; ++n) _Pragma("unroll") for (int k = 0; k < 2; ++k) dst[n][k] = *(const PG8_LAS bf16x8*)(lds + PG8_SB(b, h) + boff + n * 2048 + k * 1024); } while (0)
#define PG8_MMA(ai, bj, At, Bt) do { __builtin_amdgcn_s_setprio(1); _Pragma("unroll") for (int m = 0; m < 4; ++m) _Pragma("unroll") for (int n = 0; n < 2; ++n) _Pragma("unroll") for (int k = 0; k < 2; ++k) \
        acc[ai][bj][m][n] = __builtin_amdgcn_mfma_f32_16x16x32_bf16(Bt[n][k], At[m][k], acc[ai][bj][m][n], 0, 0, 0); __builtin_amdgcn_s_setprio(0); } while (0)
#define PG8_WAIT_V(n) asm volatile("s_waitcnt vmcnt(" #n ")" ::: "memory")
#define PG8_WAIT_L(n) asm volatile("s_waitcnt lgkmcnt(" #n ")" ::: "memory")
#define PG8_BAR __builtin_amdgcn_s_barrier()
#define PG8_SCHED __builtin_amdgcn_sched_barrier(0)
    Unit cur, nxt; int ui = 0;
    if (!S.next(0, cur)) return;
    f32x4 acc[2][2][4][2];
#pragma unroll
    for (int a = 0; a < 2; ++a)
#pragma unroll
        for (int b = 0; b < 2; ++b)
#pragma unroll
            for (int m = 0; m < 4; ++m)
#pragma unroll
                for (int n = 0; n < 2; ++n) acc[a][b][m][n] = (f32x4){0.f, 0.f, 0.f, 0.f};
    bf16x8 At[4][2], B0[2][2], B1[2][2];
    const char* cA = (const char*)g.A + (size_t)cur.pm * tstep; const char* cB = (const char*)g.Bt + (size_t)cur.pn * tstep;
    PG8_STAGE(PG8_SB(0, 0), cB, voffB); PG8_STAGE(PG8_SB(0, 1), cB + hstep, voffB); PG8_STAGE(PG8_SA(0, 0), cA, voffA); PG8_STAGE(PG8_SA(0, 1), cA + hstep, voffA);
    if (wr == 1) PG8_BAR;
    PG8_WAIT_V(2); PG8_BAR;
    PG8_STAGE(PG8_SB(1, 0), cB + kstep, voffB); PG8_STAGE(PG8_SA(1, 0), cA + kstep, voffA); PG8_STAGE(PG8_SB(1, 1), cB + hstep + kstep, voffB);
    PG8_WAIT_V(6); PG8_BAR;
    for (;;) {
        const bool has_next = S.next(ui + 1, nxt);
        const char* nA = has_next ? (const char*)g.A + (size_t)nxt.pm * tstep : cA; const char* nB = has_next ? (const char*)g.Bt + (size_t)nxt.pn * tstep : cB;
        for (int t = 0; t < nt; t += 2) {
            const bool last = (t == nt - 2);
            const char* a1 = cA + (size_t)(t + 1) * kstep;
            const char* a2 = last ? nA : cA + (size_t)(t + 2) * kstep; const char* b2 = last ? nB : cB + (size_t)(t + 2) * kstep;
            const char* a3 = a2 + kstep; const char* b3 = b2 + kstep;
            PG8_LDB(B0, 0, 0); PG8_LDB(B1, 0, 1); PG8_SCHED; PG8_LDA(At, 0, 0); PG8_STAGE(PG8_SA(1, 1), a1 + hstep, voffA);
            PG8_WAIT_V(8); PG8_WAIT_L(0); PG8_BAR; PG8_MMA(0, 0, At, B0); PG8_MMA(0, 1, At, B1); PG8_BAR; PG8_SCHED;
            PG8_LDA(At, 0, 1); PG8_STAGE(PG8_SB(0, 0), b2, voffB); PG8_STAGE(PG8_SB(0, 1), b2 + hstep, voffB); PG8_STAGE(PG8_SA(0, 0), a2, voffA);
            PG8_WAIT_V(8); PG8_WAIT_L(0); PG8_BAR; PG8_MMA(1, 0, At, B0); PG8_MMA(1, 1, At, B1); PG8_BAR; PG8_SCHED;
            PG8_LDB(B0, 1, 0); PG8_LDB(B1, 1, 1); PG8_SCHED; PG8_LDA(At, 1, 0); PG8_STAGE(PG8_SA(0, 1), a2 + hstep, voffA);
            PG8_WAIT_V(8); PG8_WAIT_L(0); PG8_BAR; PG8_MMA(0, 0, At, B0); PG8_MMA(0, 1, At, B1); PG8_BAR; PG8_SCHED;
            PG8_LDA(At, 1, 1); PG8_STAGE(PG8_SB(1, 0), b3, voffB); PG8_STAGE(PG8_SB(1, 1), b3 + hstep, voffB); PG8_STAGE(PG8_SA(1, 0), a3, voffA);
            PG8_WAIT_V(8); PG8_WAIT_L(0); PG8_BAR; PG8_MMA(1, 0, At, B0); PG8_MMA(1, 1, At, B1); PG8_BAR; PG8_SCHED;
        }
        if constexpr (ALIGN_EPI) { if (wr == 0) PG8_BAR; }
        E(acc, cur, wr, wc, fr, fq);
        if (!has_next) break;
#pragma unroll
        for (int a = 0; a < 2; ++a)
#pragma unroll
            for (int b = 0; b < 2; ++b)
#pragma unroll
                for (int m = 0; m < 4; ++m)
#pragma unroll
                    for (int n = 0; n < 2; ++n) acc[a][b][m][n] = (f32x4){0.f, 0.f, 0.f, 0.f};
        cur = nxt; cA = nA; cB = nB; ++ui;
        if constexpr (ALIGN_EPI) { if (wr == 1) PG8_BAR; }
    }
    PG8_WAIT_V(0);
    if constexpr (!ALIGN_EPI) { if (wr == 0) PG8_BAR; }
    PG8_BAR;
#undef PG8_SA
#undef PG8_SB
#undef PG8_STAGE
#undef PG8_LDA
#undef PG8_LDB
#undef PG8_MMA
#undef PG8_WAIT_V
#undef PG8_WAIT_L
#undef PG8_BAR
#undef PG8_SCHED
}

DI float row_rstd(const float* rowpart, int row) {
    const f32x4* rp = (const f32x4*)(rowpart + (size_t)row * 16);
    const f32x4 a = rp[0], b = rp[1], c = rp[2], d = rp[3];
    const float s = ((a.x + a.y) + (a.z + a.w)) + ((b.x + b.y) + (b.z + b.w)) + ((c.x + c.y) + (c.z + c.w)) + ((d.x + d.y) + (d.z + d.w));
    return 1.0f / sqrtf(s * (1.0f / DM) + EPS);
}

struct EpiIn {
    bf16_t* U; const float* rowpart; const float* bias; const float* rope;
    __device__ __forceinline__ void operator()(const f32x4 (&acc)[2][2][4][2], const Unit& u, int wr, int wc, int fr, int fq) const {
        const bool isctx = u.pm >= 128; const int bidx = isctx ? 16 : (u.pm >> 3);
        const int kind = (u.pn == 5 || u.pn == 6) ? 1 : ((u.pn == 7 || u.pn == 8) ? 2 : 0);
        const bool dorope = (kind != 0) && !isctx;
        const float osc = (kind == 1) ? QSCALE : 1.0f;
        const int colb = u.pn * BM + wc * 32 + 8 * fq;
        const float* bp = bias + (size_t)bidx * NU + colb;
        f32x4 bv[2][2];
#pragma unroll
        for (int bj = 0; bj < 2; ++bj)
#pragma unroll
            for (int n = 0; n < 2; ++n) bv[bj][n] = *(const f32x4*)(bp + bj * HALF + 4 * n);
#pragma unroll
        for (int ai = 0; ai < 2; ++ai)
#pragma unroll
            for (int m = 0; m < 4; ++m) {
                const int row = u.pm * BM + ai * HALF + wr * 64 + m * 16 + fr;
                const float rstd = row_rstd(rowpart, row);
                f32x4 cs[4];
                if (dorope) { const int t = row & (SEQ - 1); const int pos = (wc & 1) ? (t & 63) : (t >> 6);
                    const f32x4* rp = (const f32x4*)(rope + (size_t)(pos * 16 + 8 * (fq & 1)) * 2);
                    cs[0] = rp[0]; cs[1] = rp[1]; cs[2] = rp[2]; cs[3] = rp[3]; }
                bf16_t* rowp = U + (size_t)row * NU + colb;
#pragma unroll
                for (int bj = 0; bj < 2; ++bj) {
                    f32x4 v0 = acc[ai][bj][m][0] * rstd + bv[bj][0], v1 = acc[ai][bj][m][1] * rstd + bv[bj][1];
                    if (kind != 0) {
                        float x[8] = {v0[0], v0[1], v0[2], v0[3], v1[0], v1[1], v1[2], v1[3]};
#pragma unroll
                        for (int i = 0; i < 8; ++i) {
                            const float p = __shfl_xor(x[i], 32);
                            if (dorope) { const float co = cs[i >> 1][(i & 1) * 2], si = cs[i >> 1][(i & 1) * 2 + 1];
                                x[i] = (fq < 2) ? (x[i] * co - p * si) : (p * si + x[i] * co); }
                            x[i] *= osc;
                        }
                        v0 = (f32x4){x[0], x[1], x[2], x[3]}; v1 = (f32x4){x[4], x[5], x[6], x[7]};
                    }
                    u32x4 w; w.x = cvt_pk_bf16(v0[0], v0[1]); w.y = cvt_pk_bf16(v0[2], v0[3]); w.z = cvt_pk_bf16(v1[0], v1[1]); w.w = cvt_pk_bf16(v1[2], v1[3]);
                    *(u32x4*)(rowp + bj * HALF) = w;
                }
                asm volatile("" ::: "memory");
            }
    }
};

struct EpiRes {
    const float* hin_lat; const float* hin_ctx; float* hout_lat; float* hout_ctx;
    const float* gate;
    bf16_t* HBo; const float* gnext; const float* scnext;
    float* rowpart;
    __device__ __forceinline__ void operator()(const f32x4 (&acc)[2][2][4][2], const Unit& u, int wr, int wc, int fr, int fq) const {
        const bool isctx = u.pm >= 128; const int bidx = isctx ? 16 : (u.pm >> 3);
        const int colb = u.pn * BM + wc * 32 + 8 * fq;
        f32x4 gv[2][2], gm[2][2];
#pragma unroll
        for (int bj = 0; bj < 2; ++bj)
#pragma unroll
            for (int n = 0; n < 2; ++n) {
                gv[bj][n] = *(const f32x4*)(gate + (size_t)bidx * 6144 + colb + bj * HALF + 4 * n);
                if (HBo) { const f32x4 g = *(const f32x4*)(gnext + colb + bj * HALF + 4 * n), s = *(const f32x4*)(scnext + (size_t)bidx * 6144 + colb + bj * HALF + 4 * n); gm[bj][n] = g * (s + 1.0f); }
                else gm[bj][n] = (f32x4){0.f, 0.f, 0.f, 0.f};
            }
#pragma unroll
        for (int ai = 0; ai < 2; ++ai)
#pragma unroll
            for (int m = 0; m < 4; ++m) {
                const int row = u.pm * BM + ai * HALF + wr * 64 + m * 16 + fr;
                const float* hi_ = isctx ? hin_ctx + (size_t)(row - M_LAT) * DM : hin_lat + (size_t)row * DM;
                float* ho_ = isctx ? hout_ctx + (size_t)(row - M_LAT) * DM : hout_lat + (size_t)row * DM;
                float ss = 0.f;
#pragma unroll
                for (int bj = 0; bj < 2; ++bj) {
                    const int col = colb + bj * HALF;
                    const f32x4 h0 = *(const f32x4*)(hi_ + col), h1 = *(const f32x4*)(hi_ + col + 4);
                    const f32x4 n0 = h0 + gv[bj][0] * acc[ai][bj][m][0], n1 = h1 + gv[bj][1] * acc[ai][bj][m][1];
                    *(f32x4*)(ho_ + col) = n0; *(f32x4*)(ho_ + col + 4) = n1;
                    ss += (n0[0] * n0[0] + n0[1] * n0[1]) + (n0[2] * n0[2] + n0[3] * n0[3]) + (n1[0] * n1[0] + n1[1] * n1[1]) + (n1[2] * n1[2] + n1[3] * n1[3]);
                    if (HBo) { const f32x4 p0 = n0 * gm[bj][0], p1 = n1 * gm[bj][1];
                        u32x4 w; w.x = cvt_pk_bf16(p0[0], p0[1]); w.y = cvt_pk_bf16(p0[2], p0[3]); w.z = cvt_pk_bf16(p1[0], p1[1]); w.w = cvt_pk_bf16(p1[2], p1[3]);
                        *(u32x4*)(HBo + (size_t)row * DM + col) = w; }
                }
                ss += __shfl_xor(ss, 16); ss += __shfl_xor(ss, 32);
                if (fq == 0) rowpart[(size_t)row * 16 + u.pn * 4 + wc] = ss;
                asm volatile("" ::: "memory");
            }
    }
};

struct EpiGLU {
    bf16_t* HID; const float* rowpart; const float* bias;
    __device__ __forceinline__ void operator()(const f32x4 (&acc)[2][2][4][2], const Unit& u, int wr, int wc, int fr, int fq) const {
        const bool isctx = u.pm >= 128; const int bidx = isctx ? 16 : (u.pm >> 3);
        const float* bp = bias + (size_t)bidx * NGU + u.pn * BM + wc * 32 + 8 * fq;
        f32x4 bv[2][2];
#pragma unroll
        for (int bj = 0; bj < 2; ++bj)
#pragma unroll
            for (int n = 0; n < 2; ++n) bv[bj][n] = *(const f32x4*)(bp + bj * HALF + 4 * n);
#pragma unroll
        for (int ai = 0; ai < 2; ++ai)
#pragma unroll
            for (int m = 0; m < 4; ++m) {
                const int row = u.pm * BM + ai * HALF + wr * 64 + m * 16 + fr;
                const float rstd = row_rstd(rowpart, row);
                float o[8];
#pragma unroll
                for (int n = 0; n < 2; ++n) { const f32x4 g = acc[ai][0][m][n] * rstd + bv[0][n], uu = acc[ai][1][m][n] * rstd + bv[1][n];
#pragma unroll
                    for (int e = 0; e < 4; ++e) o[4 * n + e] = siluf_(g[e]) * uu[e]; }
                u32x4 w; w.x = cvt_pk_bf16(o[0], o[1]); w.y = cvt_pk_bf16(o[2], o[3]); w.z = cvt_pk_bf16(o[4], o[5]); w.w = cvt_pk_bf16(o[6], o[7]);
                *(u32x4*)(HID + (size_t)row * DFF + u.pn * HALF + wc * 32 + 8 * fq) = w;
                asm volatile("" ::: "memory");
            }
    }
};
}

DI void transpose_item(const float* W, int ldw, int col0, bf16_t* WT, int K, int dstrow0, int k0, LAS float* scr, int lane) {
#pragma unroll 8
    for (int i = 0; i < 32; ++i) { const int kk = 2 * i + (lane >> 5); scr[kk * 33 + (lane & 31)] = W[(size_t)(k0 + kk) * ldw + col0 + (lane & 31)]; }
    LDS_WAIT();
    const int c = lane & 7;
#pragma unroll
    for (int j = 0; j < 4; ++j) { const int n = (lane >> 3) + 8 * j; const LAS float* s = scr + (8 * c) * 33 + n;
        u32x4 o; o.x = f2bf(s[0]) | (f2bf(s[33]) << 16); o.y = f2bf(s[2 * 33]) | (f2bf(s[3 * 33]) << 16); o.z = f2bf(s[4 * 33]) | (f2bf(s[5 * 33]) << 16); o.w = f2bf(s[6 * 33]) | (f2bf(s[7 * 33]) << 16);
        *(u32x4*)(WT + (size_t)(dstrow0 + n) * K + k0 + 8 * c) = o; }
    LDS_WAIT();
}

DI void gemv17(LAS float* A, LAS float* red, const float* W, int ldw, int col0, int ncols, float* out, int ldo, int oc0, const float* addv, int tid) {
    const int col = tid & 63, ks = tid >> 6;
    float acc[17];
#pragma unroll
    for (int b = 0; b < 17; ++b) acc[b] = 0.f;
    const float* wp = W + (size_t)(ks * 128) * ldw + col0 + (col < ncols ? col : 0);
    for (int k4 = 0; k4 < 32; ++k4) {
        const float w0 = wp[0], w1 = wp[ldw], w2 = wp[2 * (size_t)ldw], w3 = wp[3 * (size_t)ldw]; wp += 4 * (size_t)ldw;
#pragma unroll
        for (int b = 0; b < 17; ++b) { const f32x4 a = *(const LAS f32x4*)(A + b * 1024 + ks * 128 + k4 * 4); acc[b] += (a.x * w0 + a.y * w1) + (a.z * w2 + a.w * w3); }
    }
#pragma unroll
    for (int b = 0; b < 17; ++b) red[(ks * 17 + b) * 64 + col] = acc[b];
    __syncthreads();
    for (int o = tid; o < 17 * 64; o += 512) { const int b = o >> 6, cc = o & 63;
        if (cc < ncols) { float s = 0.f;
#pragma unroll
            for (int k = 0; k < 8; ++k) s += red[(k * 17 + b) * 64 + cc];
            if (addv) s += addv[cc];
            out[(size_t)b * ldo + oc0 + cc] = s; } }
    __syncthreads();
}

DI int swz128(int row, int piece) { return row * 128 + ((piece ^ ((row >> 1) & 7)) << 4); }
DI int tr64_st(int k, int c) { const int kk = (k & ~0xC) | ((k & 4) << 1) | ((k & 8) >> 1); return ((kk >> 3) * 2 + (c >> 5)) * 512 + ((kk & 7) * 32 + (c & 31)) * 2; }
DI int tr_rd_base(int lane) { return ((lane & 3) << 3) | (((lane >> 2) & 3) << 6) | (((lane >> 4) & 1) << 5) | (((lane >> 5) & 1) << 8); }
template <int OFF> DI s16x4 tr_read_g(int vb) { s16x4 r; asm volatile("ds_read_b64_tr_b16 %0, %1 offset:%2" : "=&v"(r) : "v"(vb), "i"(OFF) : "memory"); return r; }
#define PKV(L, H) (bf16x8){L[0], L[1], L[2], L[3], H[0], H[1], H[2], H[3]}
#define PK4G(P, BASE, OUT) do { unsigned a0 = cvt_pk_bf16(P[BASE + 0], P[BASE + 1]), a1 = cvt_pk_bf16(P[BASE + 2], P[BASE + 3]);   \
    unsigned b0 = cvt_pk_bf16(P[BASE + 4], P[BASE + 5]), b1 = cvt_pk_bf16(P[BASE + 6], P[BASE + 7]);                              \
    auto r0 = __builtin_amdgcn_permlane32_swap(a0, b0, false, false); auto r1 = __builtin_amdgcn_permlane32_swap(a1, b1, false, false); \
    u32x4 w = {r0[0], r1[0], r0[1], r1[1]}; OUT = __builtin_bit_cast(bf16x8, w); } while (0)

DI void rg_unit(const KA a, LAS unsigned char* lds, int l, int b, int hd, int half, int tid_in) {
    const int tid_u = launder(tid_in);
    const int lane_u = tid_u & 63, wid = __builtin_amdgcn_readfirstlane(tid_u >> 6);
    LAS unsigned char* XCT = lds;
    LAS float* AA = (LAS float*)(lds + 32768);
    LAS float* BX = (LAS float*)(lds + 65536);
    LAS bf16_t* GT = (LAS bf16_t*)(lds + 98304);
    LAS bf16_t* RT = (LAS bf16_t*)(lds + 114688);
    LAS float* SUB = (LAS float*)(lds + 131072);
    LAS float* START = SUB + 1024;
    LAS float* CARRY = START + 512;
    unsigned char* ws = a.ws();
    const bf16_t* U = (const bf16_t*)(ws + WS_U); const bf16_t* XC = (const bf16_t*)(ws + WS_XC); bf16_t* RGS = (bf16_t*)(ws + WS_RGS); bf16_t* MIX = (bf16_t*)(ws + WS_MIX);
    const int chb = hd * 64 + 32 * half;
    for (int dir = 0; dir < 2; ++dir) {
        const int cj = 32 * half + (lane_u & 31), hi0 = lane_u >> 5;
        const float* wa = a.in(I_RGWA) + (size_t)((l * 2 + dir) * 4 + hd) * 4096;
        const float* wx = a.in(I_RGWX) + (size_t)((l * 2 + dir) * 4 + hd) * 4096;
        bf16x8 wfa[4], wfx[4];
#pragma unroll
        for (int ks = 0; ks < 4; ++ks) {
            u32x4 pa, px;
#pragma unroll
            for (int jj = 0; jj < 4; ++jj) { const int i0 = 16 * ks + 8 * hi0 + 2 * jj;
                pa[jj] = f2bf(wa[i0 * 64 + cj]) | (f2bf(wa[(i0 + 1) * 64 + cj]) << 16);
                px[jj] = f2bf(wx[i0 * 64 + cj]) | (f2bf(wx[(i0 + 1) * 64 + cj]) << 16); }
            wfa[ks] = __builtin_bit_cast(bf16x8, pa); wfx[ks] = __builtin_bit_cast(bf16x8, px);
        }
        const float ba = a.in(I_RGBA)[(size_t)(l * 2 + dir) * 256 + hd * 64 + cj], bxb = a.in(I_RGBX)[(size_t)(l * 2 + dir) * 256 + hd * 64 + cj];
        const float sp8 = -8.0f * softplusf_(-a.in(I_RGLAM)[(size_t)(l * 2 + dir) * 256 + hd * 64 + cj]);
        if (tid_u < 32) CARRY[tid_u] = 0.f;
#define RG_ROWBASE(blk) ((blk) == 0 ? M_LAT + b * CTXL : b * SEQ + (dir ? 8 - (blk) : (blk) - 1) * 256)
#define RG_DMA_XC(blk) do { const int rb_ = RG_ROWBASE(blk); _Pragma("unroll") for (int k_ = 0; k_ < 4; ++k_) { const int row_ = 8 * (4 * wid + k_) + (lane >> 3), pc_ = (lane & 7) ^ ((row_ >> 1) & 7); \
            __builtin_amdgcn_global_load_lds((const unsigned*)(XC + (size_t)(rb_ + row_) * 256 + hd * 64 + 8 * pc_), (LAS unsigned*)(XCT + (4 * wid + k_) * 1024), 16, 0, 0); } } while (0)
        { const int lane = lane_u; RG_DMA_XC(0); }
        for (int blk = 0; blk < 9; ++blk) {
            const int lane = launder(lane_u), r32 = lane & 31, hi = lane >> 5, tid = wid * 64 + lane, c = tid & 31, s = tid >> 5;
            const int rowbase = RG_ROWBASE(blk);
            const bool need = (blk != 0) || (l == 0);
            asm volatile("s_waitcnt vmcnt(0)" ::: "memory"); __syncthreads();
            if (dir == 1 && need) {
#pragma unroll
                for (int k = 0; k < 2; ++k) { const int row = 16 * (2 * wid + k) + (lane >> 2), pc = lane & 3;
                    __builtin_amdgcn_global_load_lds((const unsigned*)(U + (size_t)(rowbase + row) * NU + C_RGG + chb + 8 * pc), (LAS unsigned*)((LAS unsigned char*)GT + (2 * wid + k) * 1024), 16, 0, 0);
                    __builtin_amdgcn_global_load_lds((const unsigned*)(RGS + (size_t)(rowbase + row) * 256 + chb + 8 * pc), (LAS unsigned*)((LAS unsigned char*)RT + (2 * wid + k) * 1024), 16, 0, 0); }
            }
            { f32x16 za = {}, zx = {}; const int row = 32 * wid + r32;
#pragma unroll
              for (int ks = 0; ks < 4; ++ks) { const bf16x8 af = *(const LAS bf16x8*)(XCT + swz128(row, 2 * ks + hi));
                  za = __builtin_amdgcn_mfma_f32_32x32x16_bf16(af, wfa[ks], za, 0, 0, 0); zx = __builtin_amdgcn_mfma_f32_32x32x16_bf16(af, wfx[ks], zx, 0, 0, 0); }
#pragma unroll
              for (int i = 0; i < 16; ++i) { const int tt = 32 * wid + crow(i, hi);
                  const float xcv = bf2f(*(const LAS bf16_t*)(XCT + swz128(tt, cj >> 3) + (cj & 7) * 2));
                  const float r = sigmoidf_(za[i] + ba), ig = sigmoidf_(zx[i] + bxb);
                  const float la = sp8 * r;
                  AA[tt * 32 + r32] = __expf(la); BX[tt * 32 + r32] = sqrtf(neg_expm1(2.0f * la)) * (ig * xcv); } }
            __syncthreads();
            if (blk + 1 < 9) RG_DMA_XC(blk + 1);
            { float Ap = 1.f, Hh = 0.f;
#pragma unroll
              for (int k = 0; k < 16; ++k) { const int tt = 16 * s + (dir ? 15 - k : k); const float av = AA[tt * 32 + c], bv = BX[tt * 32 + c]; Hh = av * Hh + bv; Ap *= av; }
              SUB[(s * 32 + c) * 2] = Ap; SUB[(s * 32 + c) * 2 + 1] = Hh; }
            __syncthreads();
            if (tid < 32) { float carry = CARRY[tid];
#pragma unroll
                for (int si = 0; si < 16; ++si) { const int s2 = dir ? 15 - si : si; START[s2 * 32 + tid] = carry; carry = SUB[(s2 * 32 + tid) * 2] * carry + SUB[(s2 * 32 + tid) * 2 + 1]; }
                CARRY[tid] = carry; }
            if (blk + 1 < 9) asm volatile("s_waitcnt vmcnt(4)" ::: "memory"); else asm volatile("s_waitcnt vmcnt(0)" ::: "memory");
            __syncthreads();
            { float h = START[s * 32 + c];
#pragma unroll
              for (int k = 0; k < 16; ++k) { const int tt = 16 * s + (dir ? 15 - k : k); h = AA[tt * 32 + c] * h + BX[tt * 32 + c];
                  if (need) { const size_t row = (size_t)(rowbase + tt);
                      if (dir == 0) RGS[row * 256 + chb + c] = (bf16_t)f2bf(h);
                      else MIX[row * DM + chb + c] = (bf16_t)f2bf((bf2f(RT[tt * 32 + c]) + h) * gelu_tanh(bf2f(GT[tt * 32 + c]))); } } }
        }
        asm volatile("s_waitcnt vmcnt(0)" ::: "memory"); __syncthreads();
#undef RG_ROWBASE
#undef RG_DMA_XC
    }
}

DI void ssd_unit(const KA a, LAS unsigned char* lds, int l, int b, int head, int dir, int tid_in) {
    const int tid_u = launder(tid_in);
    const int lane_u = tid_u & 63, wid = __builtin_amdgcn_readfirstlane(tid_u >> 6);
    LAS unsigned char* BD = lds + 98304; LAS unsigned char* HL = lds + 114688;
    unsigned char* ws = a.ws();
    const bf16_t* XA = (const bf16_t*)(ws + WS_XBCA); const float* CS = (const float*)(ws + WS_CS); const float* DTS = (const float*)(ws + WS_DTS);
    float* YS = (float*)(ws + WS_HB) + (size_t)dir * M_ALL * 256;
    const int grp = head >> 1, j8 = dir * 4 + head;
    const int lb = wid >> 1, ph = wid & 1;
    const int pb = (wid >> 1) & 1, nb = wid & 1;
    f32x16 Hreg = {};
    for (int i = tid_u; i < 2048; i += 512) ((LAS unsigned*)HL)[i] = 0u;
#define SSD_CHUNK(c) ((c) < 2 ? 256 + b * 2 + (dir ? 1 - (c) : (c)) : b * 16 + (dir ? 17 - (c) : (c) - 2))
#define SSD_DMA(c, buf) do { const int ci_ = SSD_CHUNK(c); const int row0_ = 128 * ci_; LAS unsigned char* db_ = lds + (buf) * 49152; \
        _Pragma("unroll") for (int e_ = 0; e_ < 2; ++e_) { \
            { const int srow_ = 8 * (2 * wid + e_) + (lane >> 3), pc_ = (lane & 7) ^ ((srow_ >> 1) & 7); const int grow_ = dir ? row0_ + 127 - srow_ : row0_ + srow_; \
              const bf16_t* src_ = XA + (size_t)grow_ * 512 + 256 + grp * 64 + 8 * pc_; \
              __builtin_amdgcn_global_load_lds((const unsigned*)src_, (LAS unsigned*)(db_ + (2 * wid + e_) * 1024), 16, 0, 0); \
              __builtin_amdgcn_global_load_lds((const unsigned*)(src_ + 128), (LAS unsigned*)(db_ + 16384 + (2 * wid + e_) * 1024), 16, 0, 0); } \
            { const int kk_ = 8 * (2 * wid + e_) + ((lane & 31) >> 2), k_ = (kk_ & ~0xC) | ((kk_ & 4) << 1) | ((kk_ & 8) >> 1), col_ = (lane >> 5) * 32 + (lane & 3) * 8; \
              const int grow_ = dir ? row0_ + 127 - k_ : row0_ + k_; \
              __builtin_amdgcn_global_load_lds((const unsigned*)(XA + (size_t)grow_ * 512 + head * 64 + col_), (LAS unsigned*)(db_ + 32768 + (2 * wid + e_) * 1024), 16, 0, 0); } } \
        if (wid < 4) { const float* sp_ = (wid < 2 ? CS : DTS) + ((size_t)ci_ * 8 + j8) * 128 + 64 * (wid & 1) + lane; \
            __builtin_amdgcn_global_load_lds((const unsigned*)sp_, (LAS unsigned*)(lds + 122880 + (buf) * 1024 + (wid >> 1) * 512 + (wid & 1) * 256), 4, 0, 0); } } while (0)
    { const int lane = lane_u; SSD_DMA(0, 0); }
    for (int c = 0; c < 18; ++c) {
        const int lane = launder(lane_u), r32 = lane & 31, hi = lane >> 5, tid = wid * 64 + lane;
        const int buf = c & 1;
        asm volatile("s_waitcnt vmcnt(0)" ::: "memory"); __syncthreads();
        if (c + 1 < 18) SSD_DMA(c + 1, buf ^ 1);
        LAS unsigned char* BT = lds + buf * 49152; LAS unsigned char* CT = BT + 16384; LAS unsigned char* XT = BT + 32768;
        const LAS float* CSL = (const LAS float*)(lds + 122880 + buf * 1024); const LAS float* DTL = CSL + 128;
        const int row0 = 128 * SSD_CHUNK(c);
        const float cs_end = CSL[127];
#pragma unroll
        for (int e = 0; e < 2; ++e) { const int q = tid + 512 * e, sr = q >> 3, p8 = q & 7;
            const u32x4 x = *(const LAS u32x4*)(BT + swz128(sr, p8)); const float f = __expf(cs_end - CSL[sr]) * DTL[sr];
            u32x4 w;
#pragma unroll
            for (int t = 0; t < 4; ++t) w[t] = cvt_pk_bf16(bflo(x[t]) * f, bfhi(x[t]) * f);
            *(LAS u32x4*)(BD + tr64_st(sr, 8 * p8)) = w; }
        {
            f32x16 accy = {}, acco = {};
            const float cs_l = CSL[32 * lb + r32];
            const int xb = (int)(uintptr_t)XT + tr_rd_base(lane) + ph * 512;
            for (int sb = 0; sb <= lb; ++sb) {
                f32x16 g = {};
#pragma unroll
                for (int ks = 0; ks < 4; ++ks) { const bf16x8 bf = *(const LAS bf16x8*)(BT + swz128(32 * sb + r32, 2 * ks + hi)); const bf16x8 cf = *(const LAS bf16x8*)(CT + swz128(32 * lb + r32, 2 * ks + hi));
                    g = __builtin_amdgcn_mfma_f32_32x32x16_bf16(bf, cf, g, 0, 0, 0); }
#pragma unroll
                for (int r = 0; r < 16; ++r) { const int sl = crow(r, hi); const float f = __expf(cs_l - CSL[32 * sb + sl]) * DTL[32 * sb + sl];
                    g[r] = (sb < lb || sl <= r32) ? g[r] * f : 0.f; }
                bf16x8 pa0, pa1; PK4G(g, 0, pa0); PK4G(g, 8, pa1);
                const int xs = xb + sb * 4096;
                const s16x4 l0 = tr_read_g<0>(xs), h0 = tr_read_g<1024>(xs), l1 = tr_read_g<2048>(xs), h1 = tr_read_g<3072>(xs);
                asm volatile("s_waitcnt lgkmcnt(0)" ::: "memory"); __builtin_amdgcn_sched_barrier(0);
                accy = __builtin_amdgcn_mfma_f32_32x32x16_bf16(pa0, PKV(l0, h0), accy, 0, 0, 0);
                accy = __builtin_amdgcn_mfma_f32_32x32x16_bf16(pa1, PKV(l1, h1), accy, 0, 0, 0);
            }
#pragma unroll
            for (int ks = 0; ks < 4; ++ks) { const bf16x8 cf = *(const LAS bf16x8*)(CT + swz128(32 * lb + r32, 2 * ks + hi)); const bf16x8 hf = *(const LAS bf16x8*)(HL + swz128(32 * ph + r32, 2 * ks + hi));
                acco = __builtin_amdgcn_mfma_f32_32x32x16_bf16(cf, hf, acco, 0, 0, 0); }
            if (c >= 2 || l == 0) {
#pragma unroll
                for (int r = 0; r < 16; ++r) { const int ll = 32 * lb + crow(r, hi); const int grow = dir ? row0 + 127 - ll : row0 + ll;
                    YS[(size_t)grow * 256 + head * 64 + 32 * ph + r32] = accy[r] + __expf(CSL[ll]) * acco[r]; }
            }
        }
        __syncthreads();
        if (wid < 4) {
            f32x16 sacc = {};
            const int xa = (int)(uintptr_t)XT + tr_rd_base(lane) + pb * 512, xbd = (int)(uintptr_t)BD + tr_rd_base(lane) + nb * 512;
#pragma unroll
            for (int kq = 0; kq < 4; ++kq) {
                const s16x4 al0 = tr_read_g<0>(xa + kq * 4096), ah0 = tr_read_g<1024>(xa + kq * 4096), al1 = tr_read_g<2048>(xa + kq * 4096), ah1 = tr_read_g<3072>(xa + kq * 4096);
                const s16x4 bl0 = tr_read_g<0>(xbd + kq * 4096), bh0 = tr_read_g<1024>(xbd + kq * 4096), bl1 = tr_read_g<2048>(xbd + kq * 4096), bh1 = tr_read_g<3072>(xbd + kq * 4096);
                asm volatile("s_waitcnt lgkmcnt(0)" ::: "memory"); __builtin_amdgcn_sched_barrier(0);
                sacc = __builtin_amdgcn_mfma_f32_32x32x16_bf16(PKV(al0, ah0), PKV(bl0, bh0), sacc, 0, 0, 0);
                sacc = __builtin_amdgcn_mfma_f32_32x32x16_bf16(PKV(al1, ah1), PKV(bl1, bh1), sacc, 0, 0, 0);
            }
            const float e_end = __expf(cs_end); const int n = 32 * nb + r32;
#pragma unroll
            for (int r = 0; r < 16; ++r) { Hreg[r] = e_end * Hreg[r] + sacc[r]; const int p = 32 * pb + crow(r, hi);
                *(LAS bf16_t*)(HL + swz128(p, n >> 3) + (n & 7) * 2) = (bf16_t)f2bf(Hreg[r]); }
        }
    }
    asm volatile("s_waitcnt vmcnt(0)" ::: "memory"); __syncthreads();
#undef SSD_CHUNK
#undef SSD_DMA
}

DI void ssd_combine_row(const KA a, int l, int row, int lane) {
    unsigned char* ws = a.ws();
    const bf16_t* U = (const bf16_t*)(ws + WS_U); const bf16_t* XA = (const bf16_t*)(ws + WS_XBCA); const float* YS = (const float*)(ws + WS_HB); bf16_t* MIX = (bf16_t*)(ws + WS_MIX);
    const int ch = 4 * lane, head = lane >> 4;
    const u32x2 xx = *(const u32x2*)(XA + (size_t)row * 512 + ch);
    const float xv[4] = {bflo(xx[0]), bfhi(xx[0]), bflo(xx[1]), bfhi(xx[1])};
    const float dsk = a.in(I_SD)[l * 4 + head];
    const f32x4 yf = *(const f32x4*)(YS + (size_t)row * 256 + ch), yb = *(const f32x4*)(YS + (size_t)M_ALL * 256 + (size_t)row * 256 + ch);
    const u32x2 zz = *(const u32x2*)(U + (size_t)row * NU + C_SZ + ch);
    const float z[4] = {bflo(zz[0]), bfhi(zz[0]), bflo(zz[1]), bfhi(zz[1])};
    float o[4]; float ss = 0.f;
#pragma unroll
    for (int e = 0; e < 4; ++e) { const float y = xv[e] * dsk + yf[e] + yb[e]; o[e] = y * siluf_(z[e]); ss += o[e] * o[e]; }
#pragma unroll
    for (int sft = 1; sft < 32; sft <<= 1) ss += __shfl_xor(ss, sft);
    const float rs = 1.0f / sqrtf(ss * (1.0f / 128.0f) + EPS);
    const f32x4 g = *(const f32x4*)(a.in(I_SNG) + (size_t)l * 256 + ch);
    u32x2 w; w.x = cvt_pk_bf16(o[0] * rs * g[0], o[1] * rs * g[1]); w.y = cvt_pk_bf16(o[2] * rs * g[2], o[3] * rs * g[3]);
    *(u32x2*)(MIX + (size_t)row * DM + 256 + ch) = w;
}

DI void preconv_rows(const KA a, int l, int gw, int NGW, int lane) {
    unsigned char* ws = a.ws();
    const bf16_t* U = (const bf16_t*)(ws + WS_U); bf16_t* XA = (bf16_t*)(ws + WS_XBCA); bf16_t* XC = (bf16_t*)(ws + WS_XC);
    float ws8[4][8], bs8[8], wr4[4][4], br4[4];
#pragma unroll
    for (int j = 0; j < 4; ++j) { const f32x4 w0 = *(const f32x4*)(a.in(I_SCW) + (size_t)l * 2048 + j * 512 + 8 * lane), w1 = *(const f32x4*)(a.in(I_SCW) + (size_t)l * 2048 + j * 512 + 8 * lane + 4);
        const f32x4 r0 = *(const f32x4*)(a.in(I_RGCW) + (size_t)l * 1024 + j * 256 + 4 * lane);
#pragma unroll
        for (int e = 0; e < 4; ++e) { ws8[j][e] = w0[e]; ws8[j][4 + e] = w1[e]; wr4[j][e] = r0[e]; } }
    { const f32x4 b0 = *(const f32x4*)(a.in(I_SCB) + (size_t)l * 512 + 8 * lane), b1 = *(const f32x4*)(a.in(I_SCB) + (size_t)l * 512 + 8 * lane + 4), r0 = *(const f32x4*)(a.in(I_RGCB) + (size_t)l * 256 + 4 * lane);
#pragma unroll
      for (int e = 0; e < 4; ++e) { bs8[e] = b0[e]; bs8[4 + e] = b1[e]; br4[e] = r0[e]; } }
    for (int row = gw; row < M_ALL; row += NGW) {
        const bool isctx = row >= M_LAT; const int t = isctx ? (row - M_LAT) & (CTXL - 1) : row & (SEQ - 1); const int seglen = isctx ? CTXL : SEQ;
        float v[8], r[4];
#pragma unroll
        for (int e = 0; e < 8; ++e) v[e] = bs8[e];
#pragma unroll
        for (int e = 0; e < 4; ++e) r[e] = br4[e];
#pragma unroll
        for (int j = 0; j < 4; ++j) { const int ts = t + j - 2;
            if (ts >= 0 && ts < seglen) { const bf16_t* up = U + (size_t)(row + j - 2) * NU;
                const u32x4 x = *(const u32x4*)(up + C_XBC + 8 * lane); const u32x2 y = *(const u32x2*)(up + C_RGX + 4 * lane);
#pragma unroll
                for (int e = 0; e < 4; ++e) { v[2 * e] += ws8[j][2 * e] * bflo(x[e]); v[2 * e + 1] += ws8[j][2 * e + 1] * bfhi(x[e]); }
                r[0] += wr4[j][0] * bflo(y[0]); r[1] += wr4[j][1] * bfhi(y[0]); r[2] += wr4[j][2] * bflo(y[1]); r[3] += wr4[j][3] * bfhi(y[1]); } }
        u32x4 w;
#pragma unroll
        for (int e = 0; e < 4; ++e) w[e] = cvt_pk_bf16(siluf_(v[2 * e]), siluf_(v[2 * e + 1]));
        *(u32x4*)(XA + (size_t)row * 512 + 8 * lane) = w;
        u32x2 w2; w2.x = cvt_pk_bf16(r[0], r[1]); w2.y = cvt_pk_bf16(r[2], r[3]);
        *(u32x2*)(XC + (size_t)row * 256 + 4 * lane) = w2;
    }
}
DI void ssd_chunk_scan(const KA a, int l, int ci, int lane) {
    unsigned char* ws = a.ws();
    const float* DT = (const float*)(ws + WS_DT); float* CS = (float*)(ws + WS_CS); float* DTS = (float*)(ws + WS_DTS);
    const int row0 = 128 * ci;
    const f32x4 d00 = *(const f32x4*)(DT + (size_t)(row0 + 2 * lane) * 8), d01 = *(const f32x4*)(DT + (size_t)(row0 + 2 * lane) * 8 + 4);
    const f32x4 d10 = *(const f32x4*)(DT + (size_t)(row0 + 2 * lane + 1) * 8), d11 = *(const f32x4*)(DT + (size_t)(row0 + 2 * lane + 1) * 8 + 4);
    const float dt0[8] = {d00[0], d00[1], d00[2], d00[3], d01[0], d01[1], d01[2], d01[3]}, dt1[8] = {d10[0], d10[1], d10[2], d10[3], d11[0], d11[1], d11[2], d11[3]};
#pragma unroll
    for (int j = 0; j < 8; ++j) {
        const float an = -__expf(a.in(I_SALOG)[l * 8 + j]);
        const float a0 = dt0[j] * an, a1 = dt1[j] * an;
        float incl = a0 + a1;
#pragma unroll
        for (int d = 1; d < 64; d <<= 1) { const float o = __shfl_up(incl, d); if (lane >= d) incl += o; }
        const float excl = incl - (a0 + a1);
        float* cs = CS + ((size_t)ci * 8 + j) * 128; float* ds = DTS + ((size_t)ci * 8 + j) * 128;
        if (j < 4) { cs[2 * lane] = excl + a0; cs[2 * lane + 1] = incl; ds[2 * lane] = dt0[j]; ds[2 * lane + 1] = dt1[j]; }
        else { const float tot = __shfl(incl, 63);
            cs[127 - 2 * lane] = tot - excl; cs[126 - 2 * lane] = tot - excl - a0; ds[127 - 2 * lane] = dt0[j]; ds[126 - 2 * lane] = dt1[j]; }
    }
}

namespace att {
constexpr int SHM_V = 16384, SHM_K = 16384;
constexpr float THR = 8.0f;
#define KSWZ(row, colB) ((row) * 256 + ((colB) ^ (((row) & 7) << 4)))
#define SBAR() __builtin_amdgcn_sched_barrier(0)
DI int v_st(int k, int c) { const int kk = (k & ~0xC) | ((k & 4) << 1) | ((k & 8) >> 1); return ((kk >> 3) * 4 + (c >> 5)) * 512 + ((kk & 7) * 32 + (c & 31)) * 2; }
DI int v_rd_base(int lane) { return ((lane & 3) << 3) | (((lane >> 2) & 3) << 6) | (((lane >> 4) & 1) << 5) | (((lane >> 5) & 1) << 8); }
constexpr int v_rd_off(int d0, int ks, int half) { return d0 * 512 + ks * 4096 + half * 2048; }
template <int OFF> DI s16x4 tr_read(int vb) { s16x4 r; asm volatile("ds_read_b64_tr_b16 %0, %1 offset:%2" : "=&v"(r) : "v"(vb), "i"(OFF) : "memory"); return r; }

template <int C> DI void qkt(f32x16& p0, f32x16& p1, const LAS char* Ks, const LAS char* Qs, int r32, int hi) {
    p0 = f32x16{}; p1 = f32x16{};
#pragma unroll
    for (int d = 0; d < 4; ++d) { const int d0 = 4 * C + d; const int cb = (d0 * 16 + hi * 8) * 2;
        const bf16x8 b0 = *(const LAS bf16x8*)(Ks + KSWZ(r32, cb));
        const bf16x8 b1 = *(const LAS bf16x8*)(Ks + KSWZ(32 + r32, cb));
        const bf16x8 q = *(const LAS bf16x8*)(Qs + KSWZ(r32, cb));
        p0 = __builtin_amdgcn_mfma_f32_32x32x16_bf16(b0, q, p0, 0, 0, 0);
        p1 = __builtin_amdgcn_mfma_f32_32x32x16_bf16(b1, q, p1, 0, 0, 0); }
}
DI void softmax_tile(f32x16& p0, f32x16& p1, float& m_reg, float& l_reg, float& alpha, bf16x8& pa0, bf16x8& pa1, bf16x8& pa2, bf16x8& pa3) {
    float pmax = p0[0];
#pragma unroll
    for (int r = 1; r < 16; ++r) pmax = fmaxf(pmax, p0[r]);
#pragma unroll
    for (int r = 0; r < 16; ++r) pmax = fmaxf(pmax, p1[r]);
    { auto rr = __builtin_amdgcn_permlane32_swap(__float_as_uint(pmax), __float_as_uint(pmax), false, false); pmax = fmaxf(__uint_as_float(rr[0]), __uint_as_float(rr[1])); }
    if (__builtin_expect(__all(pmax - m_reg <= THR), 1)) { alpha = 1.f; }
    else { const float mn = fmaxf(m_reg, pmax); alpha = __builtin_amdgcn_exp2f(m_reg - mn); m_reg = mn; }
    float ps = 0.f;
#pragma unroll
    for (int r = 0; r < 16; ++r) { p0[r] = __builtin_amdgcn_exp2f(p0[r] - m_reg); ps += p0[r]; }
#pragma unroll
    for (int r = 0; r < 16; ++r) { p1[r] = __builtin_amdgcn_exp2f(p1[r] - m_reg); ps += p1[r]; }
    { auto rr = __builtin_amdgcn_permlane32_swap(__float_as_uint(ps), __float_as_uint(ps), false, false); ps = __uint_as_float(rr[0]) + __uint_as_float(rr[1]); }
    l_reg = l_reg * alpha + ps;
#define PK4(P, BASE, OUT) do { unsigned a0 = cvt_pk_bf16(P[BASE + 0], P[BASE + 1]), a1 = cvt_pk_bf16(P[BASE + 2], P[BASE + 3]);   \
    unsigned b0 = cvt_pk_bf16(P[BASE + 4], P[BASE + 5]), b1 = cvt_pk_bf16(P[BASE + 6], P[BASE + 7]);                              \
    auto r0 = __builtin_amdgcn_permlane32_swap(a0, b0, false, false); auto r1 = __builtin_amdgcn_permlane32_swap(a1, b1, false, false); \
    u32x4 w = {r0[0], r1[0], r0[1], r1[1]}; OUT = __builtin_bit_cast(bf16x8, w); } while (0)
    PK4(p0, 0, pa0); PK4(p0, 8, pa1); PK4(p1, 0, pa2); PK4(p1, 8, pa3);
#undef PK4
}
template <int D0> DI void pv_one(f32x16& oa, f32x16& ob, int vb, const bf16x8 (&pa)[4], const bf16x8 (&pb)[4]) {
    const s16x4 l0 = tr_read<v_rd_off(D0, 0, 0)>(vb), h0 = tr_read<v_rd_off(D0, 0, 1)>(vb), l1 = tr_read<v_rd_off(D0, 1, 0)>(vb), h1 = tr_read<v_rd_off(D0, 1, 1)>(vb);
    const s16x4 l2 = tr_read<v_rd_off(D0, 2, 0)>(vb), h2 = tr_read<v_rd_off(D0, 2, 1)>(vb), l3 = tr_read<v_rd_off(D0, 3, 0)>(vb), h3 = tr_read<v_rd_off(D0, 3, 1)>(vb);
    asm volatile("s_waitcnt lgkmcnt(0)" ::: "memory"); SBAR();
#define PK(L, H) (bf16x8){L[0], L[1], L[2], L[3], H[0], H[1], H[2], H[3]}
    const bf16x8 v0 = PK(l0, h0), v1 = PK(l1, h1), v2 = PK(l2, h2), v3 = PK(l3, h3);
    oa = __builtin_amdgcn_mfma_f32_32x32x16_bf16(pa[0], v0, oa, 0, 0, 0); ob = __builtin_amdgcn_mfma_f32_32x32x16_bf16(pb[0], v0, ob, 0, 0, 0);
    oa = __builtin_amdgcn_mfma_f32_32x32x16_bf16(pa[1], v1, oa, 0, 0, 0); ob = __builtin_amdgcn_mfma_f32_32x32x16_bf16(pb[1], v1, ob, 0, 0, 0);
    oa = __builtin_amdgcn_mfma_f32_32x32x16_bf16(pa[2], v2, oa, 0, 0, 0); ob = __builtin_amdgcn_mfma_f32_32x32x16_bf16(pb[2], v2, ob, 0, 0, 0);
    oa = __builtin_amdgcn_mfma_f32_32x32x16_bf16(pa[3], v3, oa, 0, 0, 0); ob = __builtin_amdgcn_mfma_f32_32x32x16_bf16(pb[3], v3, ob, 0, 0, 0);
#undef PK
}

DI void attn_unit(LAS unsigned char* lds, const bf16_t* __restrict__ U, bf16_t* __restrict__ MIX, int qrow0, int lat0, int nlat, int ctx0, int nctx, int h,
                  float lam, float outscale, const float* __restrict__ subg, int tid_in) {
    const int tid = launder(tid_in);
    const int wid = __builtin_amdgcn_readfirstlane(tid >> 6), lane = tid & 63, r32 = lane & 31, hi = lane >> 5;
    LAS char* V_lds = (LAS char*)lds; LAS char* K_lds = (LAS char*)lds + 2 * SHM_V;
    LAS float* wsf = (LAS float*)(lds + 2 * SHM_V + 2 * SHM_K) + wid * 128;
    LAS char* Qs = (LAS char*)lds + 2 * SHM_V + 2 * SHM_K + 4096 + wid * 8192;
    float mA = -1e30f, lA = 0.f, mB = -1e30f, lB = 0.f;
    f32x16 oA[4] = {}, oB[4] = {};
    { const bf16_t* Qw = U + (size_t)(qrow0 + wid * 32 + r32) * NU + C_Q + h * 128 + hi * 8;
#pragma unroll
      for (int d0 = 0; d0 < 8; ++d0) *(LAS bf16x8*)(Qs + KSWZ(r32, (d0 * 16 + hi * 8) * 2)) = *(const bf16x8*)(Qw + d0 * 16); }
    const int vb0 = (int)(uintptr_t)V_lds + v_rd_base(lane);
    const int NT = nlat + nctx;
    unsigned offK[2], offV[2];
#pragma unroll
    for (int e = 0; e < 2; ++e) { const int row = 8 * wid + 4 * e + (lane >> 4), p = (lane & 15) ^ (row & 7); offK[e] = (unsigned)(row * NU + p * 8) * 2u;
        const int kk = 8 * wid + ((lane & 31) >> 2), k = (kk & ~0xC) | ((kk & 4) << 1) | ((kk & 8) >> 1), col = (2 * e + (lane >> 5)) * 32 + (lane & 3) * 8; offV[e] = (unsigned)(k * NU + col) * 2u; }
    const char* Ubase = (const char*)U + (size_t)h * 256;
#define KROW(j) ((j) < nlat ? lat0 + 64 * (j) : ctx0 + 64 * ((j) - nlat))
#define DMA_TILE(j, bsel) do { const char* tb_ = Ubase + (size_t)KROW(j) * (NU * 2); \
        _Pragma("unroll") for (int e_ = 0; e_ < 2; ++e_) { \
            __builtin_amdgcn_global_load_lds((const unsigned*)(tb_ + C_K * 2 + offK[e_]), (LAS unsigned*)(K_lds + (bsel) * SHM_K + (2 * wid + e_) * 1024), 16, 0, 0); \
            __builtin_amdgcn_global_load_lds((const unsigned*)(tb_ + C_V * 2 + offV[e_]), (LAS unsigned*)(V_lds + (bsel) * SHM_V + (2 * wid + e_) * 1024), 16, 0, 0); } } while (0)
    DMA_TILE(0, 0);
    asm volatile("s_waitcnt vmcnt(0)" ::: "memory"); __syncthreads();
    for (int j = 0; j < NT; ++j) {
        const int bsel = j & 1;
        if (j + 1 < NT) DMA_TILE(j + 1, bsel ^ 1);
        const LAS char* Ks = K_lds + bsel * SHM_K;
        f32x16 p0, p1; bf16x8 pa[4], pb[4]; float alA, alB;
        qkt<0>(p0, p1, Ks, Qs, r32, hi); softmax_tile(p0, p1, mA, lA, alA, pa[0], pa[1], pa[2], pa[3]);
        qkt<1>(p0, p1, Ks, Qs, r32, hi); softmax_tile(p0, p1, mB, lB, alB, pb[0], pb[1], pb[2], pb[3]);
        if (__any(alA < 1.f || alB < 1.f)) {
            if (hi == 0) { wsf[r32] = alA; wsf[32 + r32] = alB; }
            LDS_WAIT();
#pragma unroll
            for (int r = 0; r < 16; ++r) { const float fa = wsf[crow(r, hi)], fb = wsf[32 + crow(r, hi)];
#pragma unroll
                for (int d = 0; d < 4; ++d) { oA[d][r] *= fa; oB[d][r] *= fb; } }
        }
        const int vb = vb0 + bsel * SHM_V;
        pv_one<0>(oA[0], oB[0], vb, pa, pb); pv_one<1>(oA[1], oB[1], vb, pa, pb); pv_one<2>(oA[2], oB[2], vb, pa, pb); pv_one<3>(oA[3], oB[3], vb, pa, pb);
        asm volatile("s_waitcnt vmcnt(0)" ::: "memory"); __syncthreads();
    }
#undef KROW
#undef DMA_TILE
    if (hi == 0) { wsf[64 + r32] = lA; wsf[96 + r32] = lB; }
    LDS_WAIT();
    float ssq[16];
#pragma unroll
    for (int r = 0; r < 16; ++r) { const float ra = __builtin_amdgcn_rcpf(wsf[64 + crow(r, hi)]), rb = lam * __builtin_amdgcn_rcpf(wsf[96 + crow(r, hi)]);
        float s = 0.f;
#pragma unroll
        for (int d = 0; d < 4; ++d) { const float o = oA[d][r] * ra - oB[d][r] * rb; oA[d][r] = o; s += o * o; }
        ssq[r] = s; }
#pragma unroll
    for (int r = 0; r < 16; ++r) {
#pragma unroll
        for (int s = 1; s < 32; s <<= 1) ssq[r] += __shfl_xor(ssq[r], s);
    }
    float gsub[4];
#pragma unroll
    for (int d = 0; d < 4; ++d) gsub[d] = subg[32 * d + r32] * outscale;
#pragma unroll
    for (int r = 0; r < 16; ++r) { const float rs = 1.0f / sqrtf(ssq[r] * (1.0f / 128.0f) + EPS);
        bf16_t* op = MIX + (size_t)(qrow0 + wid * 32 + crow(r, hi)) * DM + 512 + h * 128 + r32;
#pragma unroll
        for (int d = 0; d < 4; ++d) op[32 * d] = (bf16_t)f2bf(oA[d][r] * rs * gsub[d]); }
    __syncthreads();
}
#undef KSWZ
#undef SBAR
}

#define XB_TMO      128
#define XB_XCNT(j)  (256  + 64 * (j))
#define XB_XSUB(j)  (1280 + 64 * (j))
#define XB_XGEN(j)  (2304 + 64 * (j))
#define XB_TOP      3328
#define XB_TOPGEN   3392
#define XCD_BAR_WORDS 3456
#define XB_SPIN_CAP (1u << 20)
DI unsigned xb_ld(unsigned* p)              { return __hip_atomic_load(p, __ATOMIC_RELAXED, __HIP_MEMORY_SCOPE_AGENT); }
DI unsigned xb_add(unsigned* p, unsigned v) { return __hip_atomic_fetch_add(p, v, __ATOMIC_RELAXED, __HIP_MEMORY_SCOPE_AGENT); }
DI unsigned xb_xcc_id() { return (unsigned)__builtin_amdgcn_s_getreg((3 << 11) | 20) & 0xFu; }
#define XB_SPIN(cond, bar) do { unsigned _sp = 0; while (cond) { __builtin_amdgcn_s_sleep(1); \
    if ((++_sp & 255u) == 0u) { if (xb_ld(&(bar)[XB_TMO])) break; if (_sp > XB_SPIN_CAP) { atomicAdd(&(bar)[XB_TMO], 1u); break; } } } } while (0)
struct XcdBarrier { unsigned* bar; unsigned x; volatile LAS unsigned* st; };
DI void xcd_barrier_complete(unsigned* bar, unsigned x, unsigned& nloc, unsigned& nx) {
    const unsigned G = gridDim.x;
    unsigned sum, cnt, mine, sp = 0u;
    for (;;) {
        sum = 0u; cnt = 0u; mine = 0u;
#pragma unroll
        for (unsigned j = 0; j < 16; ++j) { const unsigned c = xb_ld(&bar[XB_XCNT(j)]); sum += c; cnt += (c > 0u) ? 1u : 0u; mine = (j == x) ? c : mine; }
        if (sum == G) break;
        __builtin_amdgcn_s_sleep(1);
        if ((++sp & 255u) == 0u) { if (xb_ld(&bar[XB_TMO])) break; if (sp > XB_SPIN_CAP) { atomicAdd(&bar[XB_TMO], 1u); break; } }
    }
    nloc = mine > 0u ? mine : 1u; nx = cnt > 0u ? cnt : 1u;
}
DI void xcd_barrier(const XcdBarrier& b, int tid) {
    asm volatile("s_waitcnt vmcnt(0)" ::: "memory");
    __syncthreads();
    if (tid == 0) {
        unsigned* bar = b.bar;
        __builtin_amdgcn_s_waitcnt(0);
        unsigned nloc = b.st[0], nx = b.st[1];
        if (nloc == 0u) { xcd_barrier_complete(bar, b.x, nloc, nx); b.st[0] = nloc; b.st[1] = nx; }
        const unsigned old = xb_add(&bar[XB_XSUB(b.x)], 1u);
        const unsigned gen = old / nloc;
        if (old + 1u == (gen + 1u) * nloc) {
            __builtin_amdgcn_fence(__ATOMIC_RELEASE, "agent");
            asm volatile("s_waitcnt vmcnt(0)" ::: "memory");
            const unsigned og = xb_add(&bar[XB_TOP], 1u);
            const unsigned tg = og / nx;
            if (og + 1u == (tg + 1u) * nx) xb_add(&bar[XB_TOPGEN], 1u);
            else XB_SPIN(xb_ld(&bar[XB_TOPGEN]) == tg, bar);
            __builtin_amdgcn_fence(__ATOMIC_ACQUIRE, "agent");
            xb_add(&bar[XB_XGEN(b.x)], 1u);
            asm volatile("s_waitcnt vmcnt(0)" ::: "memory");
        } else {
            XB_SPIN(xb_ld(&bar[XB_XGEN(b.x)]) == gen, bar);
            __builtin_amdgcn_fence(__ATOMIC_ACQUIRE, "agent");
            asm volatile("s_waitcnt vmcnt(0)" ::: "memory");
        }
    }
    __syncthreads();
}

__global__ void __launch_bounds__(512) hybrid_fwd(Args args_unused) {
    extern __shared__ __attribute__((aligned(16))) unsigned char lds_raw[];
    LAS unsigned char* lds = (LAS unsigned char*)lds_raw;
    const int wave0 = __builtin_amdgcn_readfirstlane((int)threadIdx.x >> 6);
    const int G = gridDim.x, bid = blockIdx.x;
    const int vcu = (G % 8 == 0) ? (bid % 8) * (G / 8) + bid / 8 : bid;
    const int NGW = G * 8;
#define PHASE_IDS() const KA a = ka_fresh(); unsigned char* const ws = a.ws(); const int lane = lane_fresh(), wave = launder_s(wave0), tid = wave * 64 + lane, gw = vcu * 8 + wave; (void)tid; (void)gw; (void)ws
    {
        const KA a = ka_fresh(); unsigned* bar = (unsigned*)a.ws(); const unsigned x = (unsigned)__builtin_amdgcn_readfirstlane((int)xb_xcc_id());
        volatile LAS unsigned* st = (volatile LAS unsigned*)(lds + 143360);
        if (threadIdx.x == 0) { st[0] = 0u; st[1] = 0u; (void)xb_add(&bar[XB_XCNT(x)], 1u); }
        __syncthreads();
    }
#define GRID_BAR() do { const KA a_ = ka_fresh(); XcdBarrier xb_; xb_.bar = (unsigned*)a_.ws(); xb_.x = (unsigned)__builtin_amdgcn_readfirstlane((int)xb_xcc_id()); xb_.st = (volatile LAS unsigned*)(lds + 143360); \
        xcd_barrier(xb_, launder_s(wave0) * 64 + lane_fresh()); } while (0)

    {
        PHASE_IDS();
        float* MOD = (float*)(ws + WS_MOD); float* ROPE = (float*)(ws + WS_ROPE); float* WDT = (float*)(ws + WS_WDT);
        LAS float* A = (LAS float*)lds; LAS float* red = (LAS float*)(lds + 73728);
        for (int it = bid; it < 2 * 96; it += G) { const int l = it / 96, cb = it % 96;
            for (int i = tid; i < 17 * 1024; i += 512) { const int b = i >> 10, k = i & 1023; const float cv = b < 16 ? a.in(I_C)[b * 1024 + k] : a.in(I_CCTX)[k]; A[i] = siluf_(cv); }
            __syncthreads();
            gemv17(A, red, a.in(I_WMOD) + (size_t)l * 1024 * 6144, 6144, cb * 64, 64, MOD + (size_t)l * 17 * 6144, 6144, cb * 64, a.in(I_BMOD) + (size_t)l * 6144 + cb * 64, tid);
        }
        LAS float* scr = (LAS float*)(lds + wave * 16384);
        for (int it = gw; it < 2 * 6144; it += NGW) { const int l = it / 6144; int r = it % 6144; unsigned char* wl = ws + WS_W + (size_t)l * W_LAYER;
            if (r < 1408) { const int kb = r / 88, nb = r % 88, n0 = 32 * nb; transpose_item(a.in(I_WIN) + (size_t)l * 1024 * DIN, DIN, n0 < 1280 ? n0 : n0 + 8, (bf16_t*)(wl + W_IN), 1024, n0, 64 * kb, scr, lane); continue; } r -= 1408;
            if (r < 512) { const int kb = r / 32, nb = r % 32; transpose_item(a.in(I_WOUT) + (size_t)l * 1024 * 1024, 1024, 32 * nb, (bf16_t*)(wl + W_OUT), 1024, 32 * nb, 64 * kb, scr, lane); continue; } r -= 512;
            if (r < 2816) { const int kb = r / 176, nb = r % 176, n0 = 32 * nb, pn = n0 >> 8, bj = (n0 >> 7) & 1, j = n0 & 127;
                transpose_item((bj ? a.in(I_WUP) : a.in(I_WGATE)) + (size_t)l * 1024 * DFF, DFF, 128 * pn + j, (bf16_t*)(wl + W_GU), 1024, n0, 64 * kb, scr, lane); continue; } r -= 2816;
            { const int kb = r / 32, nb = r % 32; transpose_item(a.in(I_WDOWN) + (size_t)l * DFF * 1024, 1024, 32 * nb, (bf16_t*)(wl + W_DOWN), DFF, 32 * nb, 64 * kb, scr, lane); }
        }
        const int gt = bid * 512 + tid;
        if (gt < 2 * 8192) { const int l = gt >> 13, j = (gt >> 10) & 7, k = gt & 1023; WDT[gt] = a.in(I_WIN)[(size_t)l * 1024 * DIN + (size_t)k * DIN + 1280 + j]; }
        if (gt < 1024) { const int pos = gt >> 4, j = gt & 15; const float invf = __builtin_amdgcn_exp2f(-(float)j * 0.8304820237218406f); const float ang = (float)pos * invf; ROPE[gt * 2] = __cosf(ang); ROPE[gt * 2 + 1] = __sinf(ang); }
    }
    cg::this_grid().sync();
    {
        PHASE_IDS();
        float* MOD = (float*)(ws + WS_MOD); float* BIAS_IN = (float*)(ws + WS_BIAS_IN); float* BIAS_DT = (float*)(ws + WS_BIAS_DT); float* BIAS_GU = (float*)(ws + WS_BIAS_GU);
        float* ROWPART = (float*)(ws + WS_ROWPART); bf16_t* HB = (bf16_t*)(ws + WS_HB);
        LAS float* A = (LAS float*)lds; LAS float* red = (LAS float*)(lds + 73728);
        for (int it = bid; it < 2 * 133; it += G) { const int l = it / 133, r = it % 133; const int chunk = r < 45 ? 0 : 3;
            for (int i = tid; i < 17 * 1024; i += 512) { const int b = i >> 10, k = i & 1023; A[i] = MOD[(size_t)l * 17 * 6144 + (size_t)b * 6144 + chunk * 1024 + k]; }
            __syncthreads();
            if (r < 44) gemv17(A, red, a.in(I_WIN) + (size_t)l * 1024 * DIN, DIN, (64 * r < 1280 ? 64 * r : 64 * r + 8), 64, BIAS_IN + (size_t)l * 17 * NU, NU, 64 * r, nullptr, tid);
            else if (r == 44) gemv17(A, red, a.in(I_WIN) + (size_t)l * 1024 * DIN, DIN, 1280, 8, BIAS_DT + (size_t)l * 17 * 8, 8, 0, nullptr, tid);
            else { const int n0 = 64 * (r - 45), pn = n0 >> 8, bj = (n0 >> 7) & 1, j = n0 & 127;
                gemv17(A, red, (bj ? a.in(I_WUP) : a.in(I_WGATE)) + (size_t)l * 1024 * DFF, DFF, 128 * pn + j, 64, BIAS_GU + (size_t)l * 17 * NGU, NGU, n0, nullptr, tid); }
        }
        for (int row = gw; row < M_ALL; row += NGW) {
            const bool isctx = row >= M_LAT; const int b = isctx ? 16 : row >> 11;
            const float* xr = isctx ? a.in(I_CTX) + (size_t)(row - M_LAT) * DM : a.in(I_X) + (size_t)row * DM;
            const float* g = a.in(I_N1G); const float* sc = MOD + (size_t)b * 6144 + 1024;
            float ss = 0.f;
#pragma unroll
            for (int j = 0; j < 4; ++j) { const int col = (lane + 64 * j) * 4; const f32x4 v = *(const f32x4*)(xr + col); const f32x4 gg = *(const f32x4*)(g + col), s4 = *(const f32x4*)(sc + col);
                ss += (v.x * v.x + v.y * v.y) + (v.z * v.z + v.w * v.w); const f32x4 p = v * (gg * (s4 + 1.0f));
                u32x2 w; w.x = cvt_pk_bf16(p.x, p.y); w.y = cvt_pk_bf16(p.z, p.w); *(u32x2*)(HB + (size_t)row * DM + col) = w; }
            ss = wave_sum(ss);
            if (lane < 4) { f32x4 o = {0.f, 0.f, 0.f, 0.f}; if (lane == 0) o.x = ss; *(f32x4*)(ROWPART + (size_t)row * 16 + lane * 4) = o; }
        }
    }
    GRID_BAR();

    for (int l = 0; l < 2; ++l) {
        const int nM = (l == 0) ? 144 : 128;
        for (int rep = 0; rep < REP_P1; ++rep) {
            if (rep) GRID_BAR();
            PHASE_IDS();
            bf16_t* HB = (bf16_t*)(ws + WS_HB); float* rp1 = (float*)(ws + WS_ROWPART) + (size_t)(2 * l) * ROWPART_STRIDE;
            pg8::Gemm g{HB, (const bf16_t*)(ws + WS_W + (size_t)l * W_LAYER + W_IN), 1024}; pg8::TileOrder S; S.init(nM, 11, G, bid, l == 0 ? 0 : 112);
            pg8::EpiIn E{(bf16_t*)(ws + WS_U), rp1, (const float*)(ws + WS_BIAS_IN) + (size_t)l * 17 * NU, (const float*)(ws + WS_ROPE)};
            pg8::gemm_phase<pg8::EpiIn, true>(lds, g, S, E, wave0);
            LAS float* WT = (LAS float*)lds;
            const float* WDT = (const float*)(ws + WS_WDT); const float* BIAS_DT = (const float*)(ws + WS_BIAS_DT); float* DT = (float*)(ws + WS_DT);
            for (int i = tid; i < 8192; i += 512) WT[i] = WDT[l * 8192 + i];
            __syncthreads();
            for (int row = gw; row < M_ALL; row += NGW) {
                const bool isctx = row >= M_LAT; const int b = isctx ? 16 : row >> 11;
                float acc[8];
#pragma unroll
                for (int j = 0; j < 8; ++j) acc[j] = 0.f;
#pragma unroll
                for (int kk = 0; kk < 2; ++kk) { const u32x4 x = *(const u32x4*)(HB + (size_t)row * DM + 8 * lane + 512 * kk);
                    const float xf[8] = {bflo(x[0]), bfhi(x[0]), bflo(x[1]), bfhi(x[1]), bflo(x[2]), bfhi(x[2]), bflo(x[3]), bfhi(x[3])};
#pragma unroll
                    for (int j = 0; j < 8; ++j) { const f32x4 w0 = *(const LAS f32x4*)(WT + j * 1024 + 8 * lane + 512 * kk), w1 = *(const LAS f32x4*)(WT + j * 1024 + 8 * lane + 512 * kk + 4);
                        acc[j] += (xf[0] * w0[0] + xf[1] * w0[1]) + (xf[2] * w0[2] + xf[3] * w0[3]) + (xf[4] * w1[0] + xf[5] * w1[1]) + (xf[6] * w1[2] + xf[7] * w1[3]); } }
#pragma unroll
                for (int j = 0; j < 8; ++j) acc[j] = wave_sum(acc[j]);
                const float rstd = pg8::row_rstd(rp1, row);
                float mine = acc[0];
#pragma unroll
                for (int j = 1; j < 8; ++j) mine = (lane == j) ? acc[j] : mine;
                if (lane < 8) { const float raw = mine * rstd + BIAS_DT[(size_t)l * 17 * 8 + b * 8 + lane] + a.in(I_SDTB)[l * 8 + lane]; DT[(size_t)row * 8 + lane] = softplusf_(raw); }
            }
        }
        GRID_BAR();
        {
            PHASE_IDS();
            for (int ci = gw; ci < M_ALL / 128; ci += NGW) ssd_chunk_scan(a, l, ci, lane);
            preconv_rows(a, l, gw, NGW, lane);
        }
        GRID_BAR();
        for (int rep = 0; rep < REP_P2; ++rep) {
            if (rep) GRID_BAR();
            PHASE_IDS();
            const bf16_t* U = (const bf16_t*)(ws + WS_U); bf16_t* MIX = (bf16_t*)(ws + WS_MIX);
            float lam, lam_init;
            { const float* lv = a.in(I_DALAM) + (size_t)l * 256; const float s1 = wave_sum(lv[lane] * lv[64 + lane]), s2 = wave_sum(lv[128 + lane] * lv[192 + lane]);
              lam_init = 0.8f - 0.6f * __expf(-0.3f * (float)l); lam = uniformf(__expf(s1) - __expf(s2) + lam_init); lam_init = uniformf(lam_init); }
            const float* subg = a.in(I_DASG) + (size_t)l * 128;
            for (int u = vcu; u < 1024; u += G) {
                if (u < 128) { if (!(rep && P2_SKIP_SSD_ON_REP)) ssd_unit(a, lds, l, u >> 3, (u >> 1) & 3, u & 1, tid); }
                else if (u < 256) { if (!(rep && P2_SKIP_RG_ON_REP)) rg_unit(a, lds, l, (u - 128) >> 3, ((u - 128) >> 1) & 3, (u - 128) & 1, tid); }
                else if (u < 320) { if (l == 0 && !(rep && P2_SKIP_ATT_ON_REP)) { const int b = (u - 256) >> 2, h = (u - 256) & 3; att::attn_unit(lds, U, MIX, M_LAT + b * CTXL, 0, 0, M_LAT + b * CTXL, 4, h, lam, 1.0f - lam_init, subg, tid); } }
                else if (u >= 512 && !(rep && P2_SKIP_ATT_ON_REP)) { const int aidx = u - 512, bh = aidx >> 3, qb = aidx & 7, b = bh >> 2, h = bh & 3;
                    att::attn_unit(lds, U, MIX, b * SEQ + qb * 256, b * SEQ, 32, M_LAT + b * CTXL, 4, h, lam, 1.0f - lam_init, subg, tid); }
                __syncthreads();
            }
        }
        GRID_BAR();
        {
            PHASE_IDS();
            const int nrows = (l == 0) ? M_ALL : M_LAT;
            for (int row = gw; row < nrows; row += NGW) ssd_combine_row(a, l, row, lane);
        }
        GRID_BAR();
        {
            PHASE_IDS();
            const float* modl = (const float*)(ws + WS_MOD) + (size_t)l * 17 * 6144; float* HCTX = (float*)(ws + WS_HCTX);
            pg8::Gemm g{(const bf16_t*)(ws + WS_MIX), (const bf16_t*)(ws + WS_W + (size_t)l * W_LAYER + W_OUT), 1024}; pg8::TileOrder S; S.init(nM, 4, G, bid, 0);
            pg8::EpiRes E{l == 0 ? a.in(I_X) : (const float*)a.out(), l == 0 ? a.in(I_CTX) : (const float*)HCTX, a.out(), HCTX, modl + 2 * 1024, (bf16_t*)(ws + WS_HB), a.in(I_N2G) + (size_t)l * 1024, modl + 4 * 1024,
                          (float*)(ws + WS_ROWPART) + (size_t)(2 * l + 1) * ROWPART_STRIDE};
            pg8::gemm_phase<pg8::EpiRes, true>(lds, g, S, E, wave0);
        }
        GRID_BAR();
        for (int rep = 0; rep < REP_P4; ++rep) {
            if (rep) GRID_BAR();
            PHASE_IDS();
            pg8::Gemm g{(const bf16_t*)(ws + WS_HB), (const bf16_t*)(ws + WS_W + (size_t)l * W_LAYER + W_GU), 1024}; pg8::TileOrder S; S.init(nM, 22, G, bid, 0);
            pg8::EpiGLU E{(bf16_t*)(ws + WS_U), (const float*)(ws + WS_ROWPART) + (size_t)(2 * l + 1) * ROWPART_STRIDE, (const float*)(ws + WS_BIAS_GU) + (size_t)l * 17 * NGU};
            pg8::gemm_phase<pg8::EpiGLU, true>(lds, g, S, E, wave0);
        }
        GRID_BAR();
        {
            PHASE_IDS();
            const float* MOD = (const float*)(ws + WS_MOD); float* HCTX = (float*)(ws + WS_HCTX);
            pg8::Gemm g{(const bf16_t*)(ws + WS_U), (const bf16_t*)(ws + WS_W + (size_t)l * W_LAYER + W_DOWN), DFF}; pg8::TileOrder S; S.init(nM, 4, G, bid, 0);
            pg8::EpiRes E{(const float*)a.out(), (const float*)HCTX, a.out(), HCTX, MOD + (size_t)l * 17 * 6144 + 5 * 1024, l == 0 ? (bf16_t*)(ws + WS_HB) : nullptr, a.in(I_N1G) + 1024, MOD + (size_t)17 * 6144 + 1024,
                          (float*)(ws + WS_ROWPART) + (size_t)(2 * l + 2) * ROWPART_STRIDE};
            pg8::gemm_phase<pg8::EpiRes, true>(lds, g, S, E, wave0);
        }
        GRID_BAR();
    }
    {
        PHASE_IDS();
        const float* rpf = (const float*)(ws + WS_ROWPART) + (size_t)4 * ROWPART_STRIDE; const float* g = a.in(I_FNG); float* outp = a.out();
        for (int row = gw; row < M_LAT; row += NGW) {
            const float rstd = pg8::row_rstd(rpf, row); float* o = outp + (size_t)row * DM;
#pragma unroll
            for (int j = 0; j < 4; ++j) { const int col = (lane + 64 * j) * 4; const f32x4 v = *(const f32x4*)(o + col), gg = *(const f32x4*)(g + col); *(f32x4*)(o + col) = v * rstd * gg; }
        }
    }
}

extern "C" void kernel_launch(void* const* d_in, const int* in_sizes, int n_in, void* d_out, int out_size, void* d_ws, size_t ws_size, hipStream_t stream) {
    static int grid = 0;
    if (grid == 0) {
        if (n_in != N_IN || in_sizes[0] != M_LAT * DM || out_size != M_LAT * DM || ws_size < WS_END) {
            fprintf(stderr, "kernel_launch: unexpected shapes (n_in %d, in0 %d, out %d, ws %zu); nothing launched\n", n_in, n_in > 0 ? in_sizes[0] : -1, out_size, ws_size); grid = -1; return; }
        int dev = 0, cus = 0, per_cu = 0;
        if (hipGetDevice(&dev) != hipSuccess || hipDeviceGetAttribute(&cus, hipDeviceAttributeMultiprocessorCount, dev) != hipSuccess) { grid = -1; return; }
        if (hipFuncSetAttribute((const void*)hybrid_fwd, hipFuncAttributeMaxDynamicSharedMemorySize, LDS_BYTES) != hipSuccess) { fprintf(stderr, "kernel_launch: hipFuncSetAttribute failed\n"); grid = -1; return; }
        if (hipOccupancyMaxActiveBlocksPerMultiprocessor(&per_cu, (const void*)hybrid_fwd, 512, LDS_BYTES) != hipSuccess || per_cu < 1) { fprintf(stderr, "kernel_launch: occupancy query says %d\n", per_cu); (void)hipGetLastError(); grid = -1; return; }
        grid = cus * (per_cu < 1 ? 1 : 1);
    }
    if (grid < 0) return;
    if (hipMemsetAsync(d_ws, 0, 65536, stream) != hipSuccess) { fprintf(stderr, "kernel_launch: memset failed\n"); return; }
    Args a{};
    for (int i = 0; i < N_IN; ++i) a.in[i] = (const float*)d_in[i];
    a.out = (float*)d_out; a.ws = (unsigned char*)d_ws;
    void* args[] = {&a};
    hipError_t e = hipLaunchCooperativeKernel((const void*)hybrid_fwd, dim3(grid), dim3(512), args, LDS_BYTES, stream);
    if (e != hipSuccess) fprintf(stderr, "kernel_launch: cooperative launch failed: %s (grid %d)\n", hipGetErrorString(e), grid);
}
```

```cpp
#include <hip/hip_runtime.h>
#include <hip/hip_cooperative_groups.h>
#include <cstdio>
#include <cstdint>
namespace cg = cooperative_groups;

#define LAS __attribute__((address_space(3)))
#define DI __device__ __forceinline__
typedef unsigned short bf16_t;
typedef short bf16x8 __attribute__((ext_vector_type(8)));
typedef short s16x4 __attribute__((ext_vector_type(4)));
typedef float f32x4 __attribute__((ext_vector_type(4)));
typedef float f32x2 __attribute__((ext_vector_type(2)));
typedef float f32x16 __attribute__((ext_vector_type(16)));
typedef unsigned u32x4 __attribute__((ext_vector_type(4)));
typedef unsigned u32x2 __attribute__((ext_vector_type(2)));

constexpr int DM = 1024, NB = 16, SEQ = 2048, CTXL = 256;
constexpr int M_LAT = NB * SEQ, M_CTX = NB * CTXL, M_ALL = M_LAT + M_CTX;
constexpr int NU = 2816, DFF = 2816, NGU = 5632, DIN = 2824;
constexpr int C_RGX = 0, C_RGG = 256, C_SZ = 512, C_XBC = 768, C_Q = 1280, C_K = 1792, C_V = 2304;
constexpr float EPS = 1e-6f;
constexpr float QSCALE = 0.125f * 1.4426950408889634f;
enum { I_X = 0, I_C, I_CTX, I_CCTX, I_WMOD, I_BMOD, I_N1G, I_WIN, I_RGCW, I_RGCB, I_RGWA, I_RGBA, I_RGWX, I_RGBX, I_RGLAM, I_SCW, I_SCB, I_SDTB, I_SALOG,
       I_SD, I_SNG, I_DALAM, I_DASG, I_WOUT, I_N2G, I_WGATE, I_WUP, I_WDOWN, I_FNG, N_IN };

constexpr size_t MiB = 1u << 20;
constexpr size_t WS_MOD = 1 * MiB;
constexpr size_t WS_BIAS_IN = 2 * MiB;
constexpr size_t WS_BIAS_DT = 2 * MiB + 512 * 1024;
constexpr size_t WS_BIAS_GU = 3 * MiB;
constexpr size_t WS_ROPE = 4 * MiB;
constexpr size_t WS_WDT = 4 * MiB + 64 * 1024;
constexpr size_t WS_DT = 5 * MiB;
constexpr size_t WS_ROWPART = 8 * MiB;
constexpr size_t ROWPART_STRIDE = (size_t)M_ALL * 16;
constexpr size_t WS_W = 20 * MiB;
constexpr size_t W_LAYER = 24 * MiB, W_IN = 0, W_OUT = 5 * MiB + 512 * 1024, W_GU = 7 * MiB + 512 * 1024, W_DOWN = 18 * MiB + 512 * 1024;
constexpr size_t WS_CS = 68 * MiB;
constexpr size_t WS_DTS = 70 * MiB;
constexpr size_t WS_HCTX = 426 * MiB;
constexpr size_t WS_HB = 84 * MiB;
constexpr size_t WS_U = 156 * MiB;
constexpr size_t WS_MIX = 354 * MiB;
constexpr size_t WS_RGS = 426 * MiB;
constexpr size_t WS_XBCA = 444 * MiB;
constexpr size_t WS_XC = 480 * MiB;
constexpr size_t WS_END = 498 * MiB;
constexpr int LDS_BYTES = 147456;
constexpr int REP_P0 = 1, REP_P1 = 1, REP_P2 = 1, REP_P4 = 1; constexpr bool P2_SKIP_SSD_ON_REP = false, P2_SKIP_ATT_ON_REP = false, P2_SKIP_RG_ON_REP = false;

struct Args { const float* in[N_IN]; float* out; unsigned char* ws; };
typedef const unsigned char __attribute__((address_space(4)))* kptr_t;
struct KA {
    kptr_t kb;
    __device__ __forceinline__ const float* in(int i) const { return *(const float* const __attribute__((address_space(4)))*)(kb + 8 * i); }
    __device__ __forceinline__ float* out() const { return *(float* const __attribute__((address_space(4)))*)(kb + 8 * N_IN); }
    __device__ __forceinline__ unsigned char* ws() const { return *(unsigned char* const __attribute__((address_space(4)))*)(kb + 8 * (N_IN + 1)); }
};
__device__ __forceinline__ KA ka_fresh() { kptr_t p = (kptr_t)__builtin_amdgcn_kernarg_segment_ptr(); asm volatile("" : "+s"(p)); return KA{p}; }

DI unsigned cvt_pk_bf16(float lo, float hi) { unsigned r; asm volatile("v_cvt_pk_bf16_f32 %0, %1, %2" : "=v"(r) : "v"(lo), "v"(hi)); return r; }
DI unsigned f2bf(float f) { unsigned u = __builtin_bit_cast(unsigned, f); return (u + 0x7fffu + ((u >> 16) & 1u)) >> 16; }
DI float bf2f(unsigned v) { return __builtin_bit_cast(float, v << 16); }
DI float bflo(unsigned w) { return __builtin_bit_cast(float, w << 16); }
DI float bfhi(unsigned w) { return __builtin_bit_cast(float, w & 0xffff0000u); }
DI float rcpf_(float x) { return __builtin_amdgcn_rcpf(x); }
DI float sigmoidf_(float x) { return rcpf_(1.0f + __expf(-x)); }
DI float siluf_(float x) { return x * rcpf_(1.0f + __expf(-x)); }
DI float log1p_small(float e) { return e < 1e-3f ? e * (1.0f - 0.5f * e) : __logf(1.0f + e); }
DI float softplusf_(float x) { return fmaxf(x, 0.f) + log1p_small(__expf(-fabsf(x))); }
DI float neg_expm1(float x) { return x > -0.02f ? -x * (1.0f + x * (0.5f + x * 0.16666667f)) : 1.0f - __expf(x); }
DI float gelu_tanh(float x) { const float u = 0.7978845608028654f * (x + 0.044715f * x * x * x); return x * rcpf_(1.0f + __expf(-2.0f * u)); }
DI float uniformf(float v) { return __builtin_bit_cast(float, __builtin_amdgcn_readfirstlane(__builtin_bit_cast(int, v))); }
DI float wave_sum(float v) {
#pragma unroll
    for (int o = 1; o < 64; o <<= 1) v += __shfl_xor(v, o);
    return v;
}
DI int crow(int r, int hi) { return (r & 3) + 8 * (r >> 2) + 4 * hi; }
#define LDS_WAIT() asm volatile("s_waitcnt lgkmcnt(0)" ::: "memory")
DI int lane_fresh() { int r; asm volatile("v_mbcnt_lo_u32_b32 %0, -1, 0\n\tv_mbcnt_hi_u32_b32 %0, -1, %0" : "=v"(r)); return r; }
DI int launder_s(int x) { asm volatile("" : "+s"(x)); return x; }
DI int launder(int x) { asm volatile("" : "+v"(x)); return x; }

namespace pg8 {
#define PG8_LAS __attribute__((address_space(3)))
constexpr int BM = 256, BK = 64, HALF = 128, HTB = HALF * BK * 2, STAGE_BYTES = 8 * HTB, NXCD = 8, WGM = 8;
__host__ __device__ __forceinline__ int lds_byte(int r, int c) { const int st = (r >> 4) * 2 + (c >> 5), rr = r & 15, cc = c & 31, ob = rr * 64 + cc * 2; return st * 1024 + (ob ^ (((ob >> 9) & 1) << 5)); }
__host__ __device__ __forceinline__ void stage_rc(int b, int& R, int& C) { const int st = b / 1024, sb = b % 1024, swz = sb ^ (((sb >> 9) & 1) << 5); R = (st >> 1) * 16 + swz / 64; C = (st & 1) * 32 + (swz % 64) / 2; }
__host__ __device__ __forceinline__ int perm32(int rho) { const int n = rho >> 4, i = rho & 15; return 8 * (i >> 2) + 4 * n + (i & 3); }
struct Unit { int pm, pn; };
struct Gemm { const bf16_t* A; const bf16_t* Bt; int K; };

struct TileOrder {
    int nM, nN, nwg, G, c, n2;
    __device__ void init(int nM_, int nN_, int G_, int c_, int n2_) { nM = nM_; nN = nN_; nwg = nM * nN; G = G_; c = c_; n2 = n2_; }
    __device__ bool next(int i, Unit& u) const {
        const int L = i * G + c;
        if (L < nwg) {
            int wgid = L; { const int q = nwg / NXCD, r = nwg % NXCD, xcd = wgid % NXCD, off = wgid / NXCD; wgid = (xcd < r ? xcd * (q + 1) : r * (q + 1) + (xcd - r) * q) + off; }
            const int nig = WGM * nN, gid = wgid / nig, fm = gid * WGM, gsz = (nM - fm) < WGM ? (nM - fm) : WGM;
            u.pm = fm + ((wgid % nig) % gsz); u.pn = (wgid % nig) / gsz; return true;
        }
        const int L2 = L - nwg;
        if (L2 < n2) { u.pm = 128 + (L2 & 15); const int ci = L2 >> 4; u.pn = ci == 0 ? 0 : (ci < 3 ? ci + 2 : ci + 4); return true; }
        return false;
    }
};

template <class Epi, bool ALIGN_EPI>
__device__ __forceinline__ void gemm_phase(PG8_LAS unsigned char* lds, const Gemm g, const TileOrder& S, const Epi& E, const int wave_id) {
    const int lane = lane_fresh(), wid = launder_s(wave_id), tid = wid * 64 + lane, wr = wid >> 2, wc = wid & 3, fr = lane & 15, fq = lane >> 4;
    const int K = g.K, nt = K / BK;
    unsigned voffA[2], voffB[2];
#pragma unroll
    for (int i = 0; i < 2; ++i) { int R, C; stage_rc(tid * 16 + i * 8192, R, C); const int Rb = (R & ~31) + perm32(R & 31);
        voffA[i] = (unsigned)(R * K + C) * 2u; voffB[i] = (unsigned)(Rb * K + C) * 2u; }
    const size_t kstep = (size_t)(BK * 2);
    const size_t hstep = (size_t)HALF * K * 2;
    const size_t tstep = 2 * hstep;
    const unsigned ldsw = (unsigned)wid * 1024u;
    const int aoff = lds_byte(wr * 64 + fr, fq * 8), boff = lds_byte(wc * 32 + fr, fq * 8);
#define PG8_SA(b, h) (((b) * 2 + (h)) * HTB)
#define PG8_SB(b, h) ((4 + (b) * 2 + (h)) * HTB)
#define PG8_STAGE(bufoff, gbase, voff) do { _Pragma("unroll") for (int _i = 0; _i < 2; ++_i) \
        __builtin_amdgcn_global_load_lds((const unsigned*)((const char*)(gbase) + (voff)[_i]), (PG8_LAS unsigned*)(lds + (bufoff) + ldsw + _i * 8192), 16, 0, 0); } while (0)
#define PG8_LDA(dst, b, h) do { _Pragma("unroll") for (int m = 0; m < 4; ++m) _Pragma("unroll") for (int k = 0; k < 2; ++k) dst[m][k] = *(const PG8_LAS bf16x8*)(lds + PG8_SA(b, h) + aoff + m * 2048 + k * 1024); } while (0)
#define PG8_LDB(dst, b, h) do { _Pragma("unroll") for (int n = 0; n < 2; ++n) _Pragma("unroll") for (int k = 0; k < 2; ++k) dst[n][k] = *(const PG8_LAS bf16x8*)(lds + PG8_SB(b, h) + boff + n * 2048 + k * 1024); } while (0)
#define PG8_MMA(ai, bj, At, Bt) do { __builtin_amdgcn_s_setprio(1); _Pragma("unroll") for (int m = 0; m < 4; ++m) _Pragma("unroll") for (int n = 0; n < 2; ++n) _Pragma("unroll") for (int k = 0; k < 2; ++k) \
        acc[ai][bj][m][n] = __builtin_amdgcn_mfma_f32_16x16x32_bf16(Bt[n][k], At[m][k], acc[ai][bj][m][n], 0, 0, 0); __builtin_amdgcn_s_setprio(0); } while (0)
#define PG8_WAIT_V(n) asm volatile("s_waitcnt vmcnt(" #n ")" ::: "memory")
#define PG8_WAIT_L(n) asm volatile("s_waitcnt lgkmcnt(" #n ")" ::: "memory")
#define PG8_BAR __builtin_amdgcn_s_barrier()
#define PG8_SCHED __builtin_amdgcn_sched_barrier(0)
    Unit cur, nxt; int ui = 0;
    if (!S.next(0, cur)) return;
    f32x4 acc[2][2][4][2];
#pragma unroll
    for (int a = 0; a < 2; ++a)
#pragma unroll
        for (int b = 0; b < 2; ++b)
#pragma unroll
            for (int m = 0; m < 4; ++m)
#pragma unroll
                for (int n = 0; n < 2; ++n) acc[a][b][m][n] = (f32x4){0.f, 0.f, 0.f, 0.f};
    bf16x8 At[4][2], B0[2][2], B1[2][2];
    const char* cA = (const char*)g.A + (size_t)cur.pm * tstep; const char* cB = (const char*)g.Bt + (size_t)cur.pn * tstep;
    PG8_STAGE(PG8_SB(0, 0), cB, voffB); PG8_STAGE(PG8_SB(0, 1), cB + hstep, voffB); PG8_STAGE(PG8_SA(0, 0), cA, voffA); PG8_STAGE(PG8_SA(0, 1), cA + hstep, voffA);
    if (wr == 1) PG8_BAR;
    PG8_WAIT_V(2); PG8_BAR;
    PG8_STAGE(PG8_SB(1, 0), cB + kstep, voffB); PG8_STAGE(PG8_SA(1, 0), cA + kstep, voffA); PG8_STAGE(PG8_SB(1, 1), cB + hstep + kstep, voffB);
    PG8_WAIT_V(6); PG8_BAR;
    for (;;) {
        const bool has_next = S.next(ui + 1, nxt);
        const char* nA = has_next ? (const char*)g.A + (size_t)nxt.pm * tstep : cA; const char* nB = has_next ? (const char*)g.Bt + (size_t)nxt.pn * tstep : cB;
        for (int t = 0; t < nt; t += 2) {
            const bool last = (t == nt - 2);
            const char* a1 = cA + (size_t)(t + 1) * kstep;
            const char* a2 = last ? nA : cA + (size_t)(t + 2) * kstep; const char* b2 = last ? nB : cB + (size_t)(t + 2) * kstep;
            const char* a3 = a2 + kstep; const char* b3 = b2 + kstep;
            PG8_LDB(B0, 0, 0); PG8_LDB(B1, 0, 1); PG8_SCHED; PG8_LDA(At, 0, 0); PG8_STAGE(PG8_SA(1, 1), a1 + hstep, voffA);
            PG8_WAIT_V(8); PG8_WAIT_L(0); PG8_BAR; PG8_MMA(0, 0, At, B0); PG8_MMA(0, 1, At, B1); PG8_BAR; PG8_SCHED;
            PG8_LDA(At, 0, 1); PG8_STAGE(PG8_SB(0, 0), b2, voffB); PG8_STAGE(PG8_SB(0, 1), b2 + hstep, voffB); PG8_STAGE(PG8_SA(0, 0), a2, voffA);
            PG8_WAIT_V(8); PG8_WAIT_L(0); PG8_BAR; PG8_MMA(1, 0, At, B0); PG8_MMA(1, 1, At, B1); PG8_BAR; PG8_SCHED;
            PG8_LDB(B0, 1, 0); PG8_LDB(B1, 1, 1); PG8_SCHED; PG8_LDA(At, 1, 0); PG8_STAGE(PG8_SA(0, 1), a2 + hstep, voffA);
            PG8_WAIT_V(8); PG8_WAIT_L(0); PG8_BAR; PG8_MMA(0, 0, At, B0); PG8_MMA(0, 1, At, B1); PG8_BAR; PG8_SCHED;
            PG8_LDA(At, 1, 1); PG8_STAGE(PG8_SB(1, 0), b3, voffB); PG8_STAGE(PG8_SB(1, 1), b3 + hstep, voffB); PG8_STAGE(PG8_SA(1, 0), a3, voffA);
            PG8_WAIT_V(8); PG8_WAIT_L(0); PG8_BAR; PG8_MMA(1, 0, At, B0); PG8_MMA(1, 1, At, B1); PG8_BAR; PG8_SCHED;
        }
        if constexpr (ALIGN_EPI) { if (wr == 0) PG8_BAR; }
        E(acc, cur, wr, wc, fr, fq);
        if (!has_next) break;
#pragma unroll
        for (int a = 0; a < 2; ++a)
#pragma unroll
            for (int b = 0; b < 2; ++b)
#pragma unroll
                for (int m = 0; m < 4; ++m)
#pragma unroll
                    for (int n = 0; n < 2; ++n) acc[a][b][m][n] = (f32x4){0.f, 0.f, 0.f, 0.f};
        cur = nxt; cA = nA; cB = nB; ++ui;
        if constexpr (ALIGN_EPI) { if (wr == 1) PG8_BAR; }
    }
    PG8_WAIT_V(0);
    if constexpr (!ALIGN_EPI) { if (wr == 0) PG8_BAR; }
    PG8_BAR;
#undef PG8_SA
#undef PG8_SB
#undef PG8_STAGE
#undef PG8_LDA
#undef PG8_LDB
#undef PG8_MMA
#undef PG8_WAIT_V
#undef PG8_WAIT_L
#undef PG8_BAR
#undef PG8_SCHED
}

DI float row_rstd(const float* rowpart, int row) {
    const f32x4* rp = (const f32x4*)(rowpart + (size_t)row * 16);
    const f32x4 a = rp[0], b = rp[1], c = rp[2], d = rp[3];
    const float s = ((a.x + a.y) + (a.z + a.w)) + ((b.x + b.y) + (b.z + b.w)) + ((c.x + c.y) + (c.z + c.w)) + ((d.x + d.y) + (d.z + d.w));
    return __builtin_amdgcn_rsqf(s * (1.0f / DM) + EPS);
}
DI void row_rstd8(const float* rowpart, int row0, int fq, float (&rs)[2][4]) {
    f32x4 p[2][4];
#pragma unroll
    for (int ai = 0; ai < 2; ++ai)
#pragma unroll
        for (int m = 0; m < 4; ++m) p[ai][m] = *(const f32x4*)(rowpart + (size_t)(row0 + ai * HALF + m * 16) * 16 + 4 * fq);
#pragma unroll
    for (int ai = 0; ai < 2; ++ai)
#pragma unroll
        for (int m = 0; m < 4; ++m) { float s = (p[ai][m].x + p[ai][m].y) + (p[ai][m].z + p[ai][m].w); s += __shfl_xor(s, 16); s += __shfl_xor(s, 32); rs[ai][m] = __builtin_amdgcn_rsqf(s * (1.0f / DM) + EPS); }
}

struct EpiIn {
    bf16_t* U; const float* rowpart; const float* bias; const float* rope;
    __device__ __forceinline__ void operator()(const f32x4 (&acc)[2][2][4][2], const Unit& u, int wr, int wc, int fr, int fq) const {
        const bool isctx = u.pm >= 128; const int bidx = isctx ? 16 : (u.pm >> 3);
        const int kind = (u.pn == 5 || u.pn == 6) ? 1 : ((u.pn == 7 || u.pn == 8) ? 2 : 0);
        const bool dorope = (kind != 0) && !isctx;
        const float osc = (kind == 1) ? QSCALE : 1.0f;
        const int colb = u.pn * BM + wc * 32 + 8 * fq;
        const float* bp = bias + (size_t)bidx * NU + colb;
        const int row0 = u.pm * BM + wr * 64 + fr;
        float rs[2][4]; row_rstd8(rowpart, row0, fq, rs);
        f32x4 bv[2][2];
#pragma unroll
        for (int bj = 0; bj < 2; ++bj)
#pragma unroll
            for (int n = 0; n < 2; ++n) bv[bj][n] = *(const f32x4*)(bp + bj * HALF + 4 * n);
        f32x4 csn[4];
#define EPI_ROPE_LD(it_) do { const int t_ = (row0 + ((it_) >> 2) * HALF + ((it_) & 3) * 16) & (SEQ - 1); const int pos_ = (wc & 1) ? (t_ & 63) : (t_ >> 6); \
            const f32x4* rp_ = (const f32x4*)(rope + (size_t)(pos_ * 16 + 8 * (fq & 1)) * 2); csn[0] = rp_[0]; csn[1] = rp_[1]; csn[2] = rp_[2]; csn[3] = rp_[3]; } while (0)
        if (dorope) EPI_ROPE_LD(0);
#pragma unroll
        for (int it = 0; it < 8; ++it) {
            const int ai = it >> 2, m = it & 3;
            const int row = row0 + ai * HALF + m * 16;
            const float rstd = rs[ai][m];
            f32x4 cs[4];
            if (dorope) { cs[0] = csn[0]; cs[1] = csn[1]; cs[2] = csn[2]; cs[3] = csn[3]; if (it < 7) EPI_ROPE_LD(it + 1); }
            bf16_t* rowp = U + (size_t)row * NU + colb;
#pragma unroll
            for (int bj = 0; bj < 2; ++bj) {
                f32x4 v0 = acc[ai][bj][m][0] * rstd + bv[bj][0], v1 = acc[ai][bj][m][1] * rstd + bv[bj][1];
                if (kind != 0) {
                    float x[8] = {v0[0], v0[1], v0[2], v0[3], v1[0], v1[1], v1[2], v1[3]};
#pragma unroll
                    for (int i = 0; i < 8; ++i) {
                        const float p = __shfl_xor(x[i], 32);
                        if (dorope) { const float co = cs[i >> 1][(i & 1) * 2], si = cs[i >> 1][(i & 1) * 2 + 1];
                            x[i] = (fq < 2) ? (x[i] * co - p * si) : (p * si + x[i] * co); }
                        x[i] *= osc;
                    }
                    v0 = (f32x4){x[0], x[1], x[2], x[3]}; v1 = (f32x4){x[4], x[5], x[6], x[7]};
                }
                u32x4 w; w.x = cvt_pk_bf16(v0[0], v0[1]); w.y = cvt_pk_bf16(v0[2], v0[3]); w.z = cvt_pk_bf16(v1[0], v1[1]); w.w = cvt_pk_bf16(v1[2], v1[3]);
                *(u32x4*)(rowp + bj * HALF) = w;
            }
            asm volatile("" ::: "memory");
        }
#undef EPI_ROPE_LD
    }
};

struct EpiRes {
    const float* hin_lat; const float* hin_ctx; float* hout_lat; float* hout_ctx;
    const float* gate;
    bf16_t* HBo; const float* gnext; const float* scnext;
    float* rowpart;
    __device__ __forceinline__ void operator()(const f32x4 (&acc)[2][2][4][2], const Unit& u, int wr, int wc, int fr, int fq) const {
        const bool isctx = u.pm >= 128; const int bidx = isctx ? 16 : (u.pm >> 3);
        const int colb = u.pn * BM + wc * 32 + 8 * fq;
        const int row0 = u.pm * BM + wr * 64 + fr;
        const float* hi0 = (isctx ? hin_ctx + (size_t)(row0 - M_LAT) * DM : hin_lat + (size_t)row0 * DM) + colb;
        float* ho0 = (isctx ? hout_ctx + (size_t)(row0 - M_LAT) * DM : hout_lat + (size_t)row0 * DM) + colb;
        f32x4 hq[2][4];
#define EPI_H_LD(it_, slot_) do { const float* hp_ = hi0 + (size_t)(((it_) >> 2) * HALF + ((it_) & 3) * 16) * DM; \
            hq[slot_][0] = *(const f32x4*)(hp_); hq[slot_][1] = *(const f32x4*)(hp_ + 4); hq[slot_][2] = *(const f32x4*)(hp_ + HALF); hq[slot_][3] = *(const f32x4*)(hp_ + HALF + 4); } while (0)
        EPI_H_LD(0, 0); EPI_H_LD(1, 1);
        f32x4 gv[2][2], gm[2][2];
#pragma unroll
        for (int bj = 0; bj < 2; ++bj)
#pragma unroll
            for (int n = 0; n < 2; ++n) {
                gv[bj][n] = *(const f32x4*)(gate + (size_t)bidx * 6144 + colb + bj * HALF + 4 * n);
                if (HBo) { const f32x4 g = *(const f32x4*)(gnext + colb + bj * HALF + 4 * n), sc4 = *(const f32x4*)(scnext + (size_t)bidx * 6144 + colb + bj * HALF + 4 * n); gm[bj][n] = g * (sc4 + 1.0f); }
                else gm[bj][n] = (f32x4){0.f, 0.f, 0.f, 0.f};
            }
#pragma unroll
        for (int it = 0; it < 8; ++it) {
            const int ai = it >> 2, m = it & 3;
            const int roff = ai * HALF + m * 16;
            f32x4 hc[4];
#pragma unroll
            for (int q = 0; q < 4; ++q) hc[q] = hq[it & 1][q];
            if (it + 2 < 8) EPI_H_LD(it + 2, it & 1);
            float* ho_ = ho0 + (size_t)roff * DM;
            float ss = 0.f;
#pragma unroll
            for (int bj = 0; bj < 2; ++bj) {
                const f32x4 n0 = hc[2 * bj] + gv[bj][0] * acc[ai][bj][m][0], n1 = hc[2 * bj + 1] + gv[bj][1] * acc[ai][bj][m][1];
                *(f32x4*)(ho_ + bj * HALF) = n0; *(f32x4*)(ho_ + bj * HALF + 4) = n1;
                ss += (n0[0] * n0[0] + n0[1] * n0[1]) + (n0[2] * n0[2] + n0[3] * n0[3]) + (n1[0] * n1[0] + n1[1] * n1[1]) + (n1[2] * n1[2] + n1[3] * n1[3]);
                if (HBo) { const f32x4 p0 = n0 * gm[bj][0], p1 = n1 * gm[bj][1];
                    u32x4 w; w.x = cvt_pk_bf16(p0[0], p0[1]); w.y = cvt_pk_bf16(p0[2], p0[3]); w.z = cvt_pk_bf16(p1[0], p1[1]); w.w = cvt_pk_bf16(p1[2], p1[3]);
                    *(u32x4*)(HBo + (size_t)(row0 + roff) * DM + colb + bj * HALF) = w; }
            }
            ss += __shfl_xor(ss, 16); ss += __shfl_xor(ss, 32);
            if (fq == 0) rowpart[(size_t)(row0 + roff) * 16 + u.pn * 4 + wc] = ss;
            asm volatile("" ::: "memory");
        }
#undef EPI_H_LD
    }
};

struct EpiGLU {
    bf16_t* HID; const float* rowpart; const float* bias;
    __device__ __forceinline__ void operator()(const f32x4 (&acc)[2][2][4][2], const Unit& u, int wr, int wc, int fr, int fq) const {
        const bool isctx = u.pm >= 128; const int bidx = isctx ? 16 : (u.pm >> 3);
        const float* bp = bias + (size_t)bidx * NGU + u.pn * BM + wc * 32 + 8 * fq;
        const int row0 = u.pm * BM + wr * 64 + fr;
        float rs[2][4]; row_rstd8(rowpart, row0, fq, rs);
        f32x4 bv[2][2];
#pragma unroll
        for (int bj = 0; bj < 2; ++bj)
#pragma unroll
            for (int n = 0; n < 2; ++n) bv[bj][n] = *(const f32x4*)(bp + bj * HALF + 4 * n);
#pragma unroll
        for (int ai = 0; ai < 2; ++ai)
#pragma unroll
            for (int m = 0; m < 4; ++m) {
                const int row = row0 + ai * HALF + m * 16;
                const float rstd = rs[ai][m];
                float o[8];
#pragma unroll
                for (int n = 0; n < 2; ++n) { const f32x4 g = acc[ai][0][m][n] * rstd + bv[0][n], uu = acc[ai][1][m][n] * rstd + bv[1][n];
#pragma unroll
                    for (int e = 0; e < 4; ++e) o[4 * n + e] = siluf_(g[e]) * uu[e]; }
                u32x4 w; w.x = cvt_pk_bf16(o[0], o[1]); w.y = cvt_pk_bf16(o[2], o[3]); w.z = cvt_pk_bf16(o[4], o[5]); w.w = cvt_pk_bf16(o[6], o[7]);
                *(u32x4*)(HID + (size_t)row * DFF + u.pn * HALF + wc * 32 + 8 * fq) = w;
            }
    }
};
}

DI void transpose_item(const float* W, int ldw, int col0, bf16_t* WT, int K, int dstrow0, int k0, LAS float* scr, int lane) {
#pragma unroll 8
    for (int i = 0; i < 32; ++i) { const int kk = 2 * i + (lane >> 5); scr[kk * 33 + (lane & 31)] = W[(size_t)(k0 + kk) * ldw + col0 + (lane & 31)]; }
    LDS_WAIT();
    const int c = lane & 7;
#pragma unroll
    for (int j = 0; j < 4; ++j) { const int n = (lane >> 3) + 8 * j; const LAS float* s = scr + (8 * c) * 33 + n;
        u32x4 o; o.x = f2bf(s[0]) | (f2bf(s[33]) << 16); o.y = f2bf(s[2 * 33]) | (f2bf(s[3 * 33]) << 16); o.z = f2bf(s[4 * 33]) | (f2bf(s[5 * 33]) << 16); o.w = f2bf(s[6 * 33]) | (f2bf(s[7 * 33]) << 16);
        *(u32x4*)(WT + (size_t)(dstrow0 + n) * K + k0 + 8 * c) = o; }
    LDS_WAIT();
}

DI void gemv17(LAS float* A, LAS float* red, const float* W, int ldw, int col0, int ncols, float* out, int ldo, int oc0, const float* addv, int tid) {
    const int col = tid & 63, ks = tid >> 6;
    float acc[17];
#pragma unroll
    for (int b = 0; b < 17; ++b) acc[b] = 0.f;
    const float* wp = W + (size_t)(ks * 128) * ldw + col0 + (col < ncols ? col : 0);
#pragma unroll 4
    for (int k4 = 0; k4 < 32; ++k4) {
        const float w0 = wp[0], w1 = wp[ldw], w2 = wp[2 * (size_t)ldw], w3 = wp[3 * (size_t)ldw]; wp += 4 * (size_t)ldw;
#pragma unroll
        for (int b = 0; b < 17; ++b) { const f32x4 a = *(const LAS f32x4*)(A + b * 1024 + ks * 128 + k4 * 4); acc[b] += (a.x * w0 + a.y * w1) + (a.z * w2 + a.w * w3); }
    }
#pragma unroll
    for (int b = 0; b < 17; ++b) red[(ks * 17 + b) * 64 + col] = acc[b];
    __syncthreads();
    for (int o = tid; o < 17 * 64; o += 512) { const int b = o >> 6, cc = o & 63;
        if (cc < ncols) { float s = 0.f;
#pragma unroll
            for (int k = 0; k < 8; ++k) s += red[(k * 17 + b) * 64 + cc];
            if (addv) s += addv[cc];
            out[(size_t)b * ldo + oc0 + cc] = s; } }
    __syncthreads();
}

DI int swz128(int row, int piece) { return row * 128 + ((piece ^ ((row >> 1) & 7)) << 4); }
DI int tr64_st(int k, int c) { const int kk = (k & ~0xC) | ((k & 4) << 1) | ((k & 8) >> 1); return ((kk >> 3) * 2 + (c >> 5)) * 512 + ((kk & 7) * 32 + (c & 31)) * 2; }
DI int tr_rd_base(int lane) { return ((lane & 3) << 3) | (((lane >> 2) & 3) << 6) | (((lane >> 4) & 1) << 5) | (((lane >> 5) & 1) << 8); }
template <int OFF> DI s16x4 tr_read_g(int vb) { s16x4 r; asm volatile("ds_read_b64_tr_b16 %0, %1 offset:%2" : "=&v"(r) : "v"(vb), "i"(OFF) : "memory"); return r; }
#define PKV(L, H) (bf16x8){L[0], L[1], L[2], L[3], H[0], H[1], H[2], H[3]}
#define PK4G(P, BASE, OUT) do { unsigned a0 = cvt_pk_bf16(P[BASE + 0], P[BASE + 1]), a1 = cvt_pk_bf16(P[BASE + 2], P[BASE + 3]);   \
    unsigned b0 = cvt_pk_bf16(P[BASE + 4], P[BASE + 5]), b1 = cvt_pk_bf16(P[BASE + 6], P[BASE + 7]);                              \
    auto r0 = __builtin_amdgcn_permlane32_swap(a0, b0, false, false); auto r1 = __builtin_amdgcn_permlane32_swap(a1, b1, false, false); \
    u32x4 w = {r0[0], r1[0], r0[1], r1[1]}; OUT = __builtin_bit_cast(bf16x8, w); } while (0)

DI void rg_unit(const KA a, LAS unsigned char* lds, int l, int b, int hd, int half, int tid_in) {
    const int tid_u = launder(tid_in);
    const int lane_u = tid_u & 63, wid = __builtin_amdgcn_readfirstlane(tid_u >> 6);
    LAS unsigned char* XCT = lds;
    LAS float* AA = (LAS float*)(lds + 32768);
    LAS float* BX = (LAS float*)(lds + 65536);
    LAS bf16_t* GT = (LAS bf16_t*)(lds + 98304);
    LAS bf16_t* RT = (LAS bf16_t*)(lds + 114688);
    LAS float* SUB = (LAS float*)(lds + 131072);
    LAS float* START = SUB + 1024;
    LAS float* CARRY = START + 512;
    unsigned char* ws = a.ws();
    const bf16_t* U = (const bf16_t*)(ws + WS_U); const bf16_t* XC = (const bf16_t*)(ws + WS_XC); bf16_t* RGS = (bf16_t*)(ws + WS_RGS); bf16_t* MIX = (bf16_t*)(ws + WS_MIX);
    const int chb = hd * 64 + 32 * half;
    for (int dir = 0; dir < 2; ++dir) {
        const int cj = 32 * half + (lane_u & 31), hi0 = lane_u >> 5;
        const float* wa = a.in(I_RGWA) + (size_t)((l * 2 + dir) * 4 + hd) * 4096;
        const float* wx = a.in(I_RGWX) + (size_t)((l * 2 + dir) * 4 + hd) * 4096;
        bf16x8 wfa[4], wfx[4];
#pragma unroll
        for (int ks = 0; ks < 4; ++ks) {
            u32x4 pa, px;
#pragma unroll
            for (int jj = 0; jj < 4; ++jj) { const int i0 = 16 * ks + 8 * hi0 + 2 * jj;
                pa[jj] = f2bf(wa[i0 * 64 + cj]) | (f2bf(wa[(i0 + 1) * 64 + cj]) << 16);
                px[jj] = f2bf(wx[i0 * 64 + cj]) | (f2bf(wx[(i0 + 1) * 64 + cj]) << 16); }
            wfa[ks] = __builtin_bit_cast(bf16x8, pa); wfx[ks] = __builtin_bit_cast(bf16x8, px);
        }
        const float ba = a.in(I_RGBA)[(size_t)(l * 2 + dir) * 256 + hd * 64 + cj], bxb = a.in(I_RGBX)[(size_t)(l * 2 + dir) * 256 + hd * 64 + cj];
        const float sp8 = -8.0f * softplusf_(-a.in(I_RGLAM)[(size_t)(l * 2 + dir) * 256 + hd * 64 + cj]);
        if (tid_u < 32) CARRY[tid_u] = 0.f;
#define RG_ROWBASE(blk) ((blk) == 0 ? M_LAT + b * CTXL : b * SEQ + (dir ? 8 - (blk) : (blk) - 1) * 256)
#define RG_DMA_XC(blk) do { const int rb_ = RG_ROWBASE(blk); _Pragma("unroll") for (int k_ = 0; k_ < 4; ++k_) { const int row_ = 8 * (4 * wid + k_) + (lane >> 3), pc_ = (lane & 7) ^ ((row_ >> 1) & 7); \
            __builtin_amdgcn_global_load_lds((const unsigned*)(XC + (size_t)(rb_ + row_) * 256 + hd * 64 + 8 * pc_), (LAS unsigned*)(XCT + (4 * wid + k_) * 1024), 16, 0, 0); } } while (0)
        { const int lane = lane_u; RG_DMA_XC(0); }
        for (int blk = 0; blk < 9; ++blk) {
            const int lane = launder(lane_u), r32 = lane & 31, hi = lane >> 5, tid = wid * 64 + lane, c = tid & 31, s = tid >> 5;
            const int rowbase = RG_ROWBASE(blk);
            const bool need = (blk != 0) || (l == 0);
            asm volatile("s_waitcnt vmcnt(0)" ::: "memory"); __syncthreads();
            if (dir == 1 && need) {
#pragma unroll
                for (int k = 0; k < 2; ++k) { const int row = 16 * (2 * wid + k) + (lane >> 2), pc = lane & 3;
                    __builtin_amdgcn_global_load_lds((const unsigned*)(U + (size_t)(rowbase + row) * NU + C_RGG + chb + 8 * pc), (LAS unsigned*)((LAS unsigned char*)GT + (2 * wid + k) * 1024), 16, 0, 0);
                    __builtin_amdgcn_global_load_lds((const unsigned*)(RGS + (size_t)(rowbase + row) * 256 + chb + 8 * pc), (LAS unsigned*)((LAS unsigned char*)RT + (2 * wid + k) * 1024), 16, 0, 0); }
            }
            { f32x16 za = {}, zx = {}; const int row = 32 * wid + r32;
              bf16x8 af[4]; float xcv[16];
#pragma unroll
              for (int ks = 0; ks < 4; ++ks) af[ks] = *(const LAS bf16x8*)(XCT + swz128(row, 2 * ks + hi));
#pragma unroll
              for (int i = 0; i < 16; ++i) { const int tt = 32 * wid + crow(i, hi); xcv[i] = bf2f(*(const LAS bf16_t*)(XCT + swz128(tt, cj >> 3) + (cj & 7) * 2)); }
              LDS_WAIT(); __syncthreads();
              if (blk + 1 < 9) RG_DMA_XC(blk + 1);
#pragma unroll
              for (int ks = 0; ks < 4; ++ks) { za = __builtin_amdgcn_mfma_f32_32x32x16_bf16(af[ks], wfa[ks], za, 0, 0, 0); zx = __builtin_amdgcn_mfma_f32_32x32x16_bf16(af[ks], wfx[ks], zx, 0, 0, 0); }
#pragma unroll
              for (int i = 0; i < 16; ++i) { const int tt = 32 * wid + crow(i, hi);
                  const float r = sigmoidf_(za[i] + ba), ig = sigmoidf_(zx[i] + bxb);
                  const float la = sp8 * r;
                  const float av = __expf(la); AA[tt * 32 + r32] = av; BX[tt * 32 + r32] = __builtin_amdgcn_sqrtf(fmaxf(1.0f - av * av, 0.f)) * (ig * xcv[i]); } }
            __syncthreads();
            { float Ap = 1.f, Hh = 0.f;
#pragma unroll
              for (int k = 0; k < 16; ++k) { const int tt = 16 * s + (dir ? 15 - k : k); const float av = AA[tt * 32 + c], bv = BX[tt * 32 + c]; Hh = av * Hh + bv; Ap *= av; }
              SUB[(s * 32 + c) * 2] = Ap; SUB[(s * 32 + c) * 2 + 1] = Hh; }
            __syncthreads();
            if (tid < 32) { float carry = CARRY[tid];
#pragma unroll
                for (int si = 0; si < 16; ++si) { const int s2 = dir ? 15 - si : si; START[s2 * 32 + tid] = carry; carry = SUB[(s2 * 32 + tid) * 2] * carry + SUB[(s2 * 32 + tid) * 2 + 1]; }
                CARRY[tid] = carry; }
            if (blk + 1 < 9) asm volatile("s_waitcnt vmcnt(4)" ::: "memory"); else asm volatile("s_waitcnt vmcnt(0)" ::: "memory");
            __syncthreads();
            { float h = START[s * 32 + c];
#pragma unroll
              for (int k = 0; k < 16; ++k) { const int tt = 16 * s + (dir ? 15 - k : k); h = AA[tt * 32 + c] * h + BX[tt * 32 + c];
                  if (need) { const size_t row = (size_t)(rowbase + tt);
                      if (dir == 0) RGS[row * 256 + chb + c] = (bf16_t)f2bf(h);
                      else MIX[row * DM + chb + c] = (bf16_t)f2bf((bf2f(RT[tt * 32 + c]) + h) * gelu_tanh(bf2f(GT[tt * 32 + c]))); } } }
        }
        asm volatile("s_waitcnt vmcnt(0)" ::: "memory"); __syncthreads();
#undef RG_ROWBASE
#undef RG_DMA_XC
    }
}

DI void ssd_unit(const KA a, LAS unsigned char* lds, int l, int b, int head, int dir, int tid_in) {
    const int tid_u = launder(tid_in);
    const int lane_u = tid_u & 63, wid = __builtin_amdgcn_readfirstlane(tid_u >> 6);
    LAS unsigned char* BD = lds + 98304; LAS unsigned char* HL = lds + 114688;
    unsigned char* ws = a.ws();
    const bf16_t* XA = (const bf16_t*)(ws + WS_XBCA); const float* CS = (const float*)(ws + WS_CS); const float* DTS = (const float*)(ws + WS_DTS);
    float* YS = (float*)(ws + WS_HB) + (size_t)dir * M_ALL * 256;
    const int grp = head >> 1, j8 = dir * 4 + head;
    const int lb = wid >> 1, ph = wid & 1;
    const int pb = (wid >> 1) & 1, nb = wid & 1;
    f32x16 Hreg = {};
    for (int i = tid_u; i < 2048; i += 512) ((LAS unsigned*)HL)[i] = 0u;
#define SSD_CHUNK(c) ((c) < 2 ? 256 + b * 2 + (dir ? 1 - (c) : (c)) : b * 16 + (dir ? 17 - (c) : (c) - 2))
#define SSD_DMA(c, buf) do { const int ci_ = SSD_CHUNK(c); const int row0_ = 128 * ci_; LAS unsigned char* db_ = lds + (buf) * 49152; \
        _Pragma("unroll") for (int e_ = 0; e_ < 2; ++e_) { \
            { const int srow_ = 8 * (2 * wid + e_) + (lane >> 3), pc_ = (lane & 7) ^ ((srow_ >> 1) & 7); const int grow_ = dir ? row0_ + 127 - srow_ : row0_ + srow_; \
              const bf16_t* src_ = XA + (size_t)grow_ * 512 + 256 + grp * 64 + 8 * pc_; \
              __builtin_amdgcn_global_load_lds((const unsigned*)src_, (LAS unsigned*)(db_ + (2 * wid + e_) * 1024), 16, 0, 0); \
              __builtin_amdgcn_global_load_lds((const unsigned*)(src_ + 128), (LAS unsigned*)(db_ + 16384 + (2 * wid + e_) * 1024), 16, 0, 0); } \
            { const int kk_ = 8 * (2 * wid + e_) + ((lane & 31) >> 2), k_ = (kk_ & ~0xC) | ((kk_ & 4) << 1) | ((kk_ & 8) >> 1), col_ = (lane >> 5) * 32 + (lane & 3) * 8; \
              const int grow_ = dir ? row0_ + 127 - k_ : row0_ + k_; \
              __builtin_amdgcn_global_load_lds((const unsigned*)(XA + (size_t)grow_ * 512 + head * 64 + col_), (LAS unsigned*)(db_ + 32768 + (2 * wid + e_) * 1024), 16, 0, 0); } } \
        if (wid < 4) { const float* sp_ = (wid < 2 ? CS : DTS) + ((size_t)ci_ * 8 + j8) * 128 + 64 * (wid & 1) + lane; \
            __builtin_amdgcn_global_load_lds((const unsigned*)sp_, (LAS unsigned*)(lds + 122880 + (buf) * 1024 + (wid >> 1) * 512 + (wid & 1) * 256), 4, 0, 0); } } while (0)
    { const int lane = lane_u; SSD_DMA(0, 0); }
    for (int c = 0; c < 18; ++c) {
        const int lane = launder(lane_u), r32 = lane & 31, hi = lane >> 5, tid = wid * 64 + lane;
        const int buf = c & 1;
        asm volatile("s_waitcnt vmcnt(0)" ::: "memory"); __syncthreads();
        if (c + 1 < 18) SSD_DMA(c + 1, buf ^ 1);
        LAS unsigned char* BT = lds + buf * 49152; LAS unsigned char* CT = BT + 16384; LAS unsigned char* XT = BT + 32768;
        const LAS float* CSL = (const LAS float*)(lds + 122880 + buf * 1024); const LAS float* DTL = CSL + 128;
        const int row0 = 128 * SSD_CHUNK(c);
        const float cs_end = CSL[127];
#pragma unroll
        for (int e = 0; e < 2; ++e) { const int q = tid + 512 * e, sr = q >> 3, p8 = q & 7;
            const u32x4 x = *(const LAS u32x4*)(BT + swz128(sr, p8)); const float f = __expf(cs_end - CSL[sr]) * DTL[sr];
            u32x4 w;
#pragma unroll
            for (int t = 0; t < 4; ++t) w[t] = cvt_pk_bf16(bflo(x[t]) * f, bfhi(x[t]) * f);
            *(LAS u32x4*)(BD + tr64_st(sr, 8 * p8)) = w; }
        __syncthreads();
        {
            f32x16 accy = {}, acco = {};
            const float cs_l = CSL[32 * lb + r32];
            const int xb = (int)(uintptr_t)XT + tr_rd_base(lane) + ph * 512;
            for (int sb = 0; sb <= lb; ++sb) {
                f32x16 g = {};
#pragma unroll
                for (int ks = 0; ks < 4; ++ks) { const bf16x8 bf = *(const LAS bf16x8*)(BT + swz128(32 * sb + r32, 2 * ks + hi)); const bf16x8 cf = *(const LAS bf16x8*)(CT + swz128(32 * lb + r32, 2 * ks + hi));
                    g = __builtin_amdgcn_mfma_f32_32x32x16_bf16(bf, cf, g, 0, 0, 0); }
#pragma unroll
                for (int r = 0; r < 16; ++r) { const int sl = crow(r, hi); const float f = __expf(cs_l - CSL[32 * sb + sl]) * DTL[32 * sb + sl];
                    g[r] = (sb < lb || sl <= r32) ? g[r] * f : 0.f; }
                bf16x8 pa0, pa1; PK4G(g, 0, pa0); PK4G(g, 8, pa1);
                const int xs = xb + sb * 4096;
                const s16x4 l0 = tr_read_g<0>(xs), h0 = tr_read_g<1024>(xs), l1 = tr_read_g<2048>(xs), h1 = tr_read_g<3072>(xs);
                asm volatile("s_waitcnt lgkmcnt(0)" ::: "memory"); __builtin_amdgcn_sched_barrier(0);
                accy = __builtin_amdgcn_mfma_f32_32x32x16_bf16(pa0, PKV(l0, h0), accy, 0, 0, 0);
                accy = __builtin_amdgcn_mfma_f32_32x32x16_bf16(pa1, PKV(l1, h1), accy, 0, 0, 0);
            }
#pragma unroll
            for (int ks = 0; ks < 4; ++ks) { const bf16x8 cf = *(const LAS bf16x8*)(CT + swz128(32 * lb + r32, 2 * ks + hi)); const bf16x8 hf = *(const LAS bf16x8*)(HL + swz128(32 * ph + r32, 2 * ks + hi));
                acco = __builtin_amdgcn_mfma_f32_32x32x16_bf16(cf, hf, acco, 0, 0, 0); }
            if (c >= 2 || l == 0) {
#pragma unroll
                for (int r = 0; r < 16; ++r) { const int ll = 32 * lb + crow(r, hi); const int grow = dir ? row0 + 127 - ll : row0 + ll;
                    YS[(size_t)grow * 256 + head * 64 + 32 * ph + r32] = accy[r] + __expf(CSL[ll]) * acco[r]; }
            }
        }
        if (wid < 4) {
            f32x16 sacc = {};
            const int xa = (int)(uintptr_t)XT + tr_rd_base(lane) + pb * 512, xbd = (int)(uintptr_t)BD + tr_rd_base(lane) + nb * 512;
#pragma unroll
            for (int kq = 0; kq < 4; ++kq) {
                const s16x4 al0 = tr_read_g<0>(xa + kq * 4096), ah0 = tr_read_g<1024>(xa + kq * 4096), al1 = tr_read_g<2048>(xa + kq * 4096), ah1 = tr_read_g<3072>(xa + kq * 4096);
                const s16x4 bl0 = tr_read_g<0>(xbd + kq * 4096), bh0 = tr_read_g<1024>(xbd + kq * 4096), bl1 = tr_read_g<2048>(xbd + kq * 4096), bh1 = tr_read_g<3072>(xbd + kq * 4096);
                asm volatile("s_waitcnt lgkmcnt(0)" ::: "memory"); __builtin_amdgcn_sched_barrier(0);
                sacc = __builtin_amdgcn_mfma_f32_32x32x16_bf16(PKV(al0, ah0), PKV(bl0, bh0), sacc, 0, 0, 0);
                sacc = __builtin_amdgcn_mfma_f32_32x32x16_bf16(PKV(al1, ah1), PKV(bl1, bh1), sacc, 0, 0, 0);
            }
            const float e_end = __expf(cs_end);
#pragma unroll
            for (int r = 0; r < 16; ++r) Hreg[r] = e_end * Hreg[r] + sacc[r];
        }
        __syncthreads();
        if (wid < 4) { const int n = 32 * nb + r32;
#pragma unroll
            for (int r = 0; r < 16; ++r) { const int p = 32 * pb + crow(r, hi); *(LAS bf16_t*)(HL + swz128(p, n >> 3) + (n & 7) * 2) = (bf16_t)f2bf(Hreg[r]); } }
    }
    asm volatile("s_waitcnt vmcnt(0)" ::: "memory"); __syncthreads();
#undef SSD_CHUNK
#undef SSD_DMA
}

template <int R> DI void ssd_combine_rows(const KA a, int l, int row0, int rstep, int nrows, int lane) {
    unsigned char* ws = a.ws();
    const bf16_t* U = (const bf16_t*)(ws + WS_U); const bf16_t* XA = (const bf16_t*)(ws + WS_XBCA); const float* YS = (const float*)(ws + WS_HB); bf16_t* MIX = (bf16_t*)(ws + WS_MIX);
    const int ch = 4 * lane, head = lane >> 4;
    u32x2 xx[R], zz[R]; f32x4 yf[R], yb[R];
#pragma unroll
    for (int r = 0; r < R; ++r) { const int row = row0 + r * rstep; if (row < nrows) {
        xx[r] = *(const u32x2*)(XA + (size_t)row * 512 + ch); zz[r] = *(const u32x2*)(U + (size_t)row * NU + C_SZ + ch);
        yf[r] = *(const f32x4*)(YS + (size_t)row * 256 + ch); yb[r] = *(const f32x4*)(YS + (size_t)M_ALL * 256 + (size_t)row * 256 + ch); } }
    const float dsk = a.in(I_SD)[l * 4 + head];
    const f32x4 g = *(const f32x4*)(a.in(I_SNG) + (size_t)l * 256 + ch);
#pragma unroll
    for (int r = 0; r < R; ++r) { const int row = row0 + r * rstep; if (row < nrows) {
        const float xv[4] = {bflo(xx[r][0]), bfhi(xx[r][0]), bflo(xx[r][1]), bfhi(xx[r][1])};
        const float z[4] = {bflo(zz[r][0]), bfhi(zz[r][0]), bflo(zz[r][1]), bfhi(zz[r][1])};
        float o[4]; float ss = 0.f;
#pragma unroll
        for (int e = 0; e < 4; ++e) { const float y = xv[e] * dsk + yf[r][e] + yb[r][e]; o[e] = y * siluf_(z[e]); ss += o[e] * o[e]; }
#pragma unroll
        for (int sft = 1; sft < 32; sft <<= 1) ss += __shfl_xor(ss, sft);
        const float rs = __builtin_amdgcn_rsqf(ss * (1.0f / 128.0f) + EPS);
        u32x2 w; w.x = cvt_pk_bf16(o[0] * rs * g[0], o[1] * rs * g[1]); w.y = cvt_pk_bf16(o[2] * rs * g[2], o[3] * rs * g[3]);
        *(u32x2*)(MIX + (size_t)row * DM + 256 + ch) = w; } }
}

DI void preconv_rows(const KA a, int l, int gw, int NGW, int lane) {
    unsigned char* ws = a.ws();
    const bf16_t* U = (const bf16_t*)(ws + WS_U); bf16_t* XA = (bf16_t*)(ws + WS_XBCA); bf16_t* XC = (bf16_t*)(ws + WS_XC);
    float ws8[4][8], bs8[8], wr4[4][4], br4[4];
#pragma unroll
    for (int j = 0; j < 4; ++j) { const f32x4 w0 = *(const f32x4*)(a.in(I_SCW) + (size_t)l * 2048 + j * 512 + 8 * lane), w1 = *(const f32x4*)(a.in(I_SCW) + (size_t)l * 2048 + j * 512 + 8 * lane + 4);
        const f32x4 r0 = *(const f32x4*)(a.in(I_RGCW) + (size_t)l * 1024 + j * 256 + 4 * lane);
#pragma unroll
        for (int e = 0; e < 4; ++e) { ws8[j][e] = w0[e]; ws8[j][4 + e] = w1[e]; wr4[j][e] = r0[e]; } }
    { const f32x4 b0 = *(const f32x4*)(a.in(I_SCB) + (size_t)l * 512 + 8 * lane), b1 = *(const f32x4*)(a.in(I_SCB) + (size_t)l * 512 + 8 * lane + 4), r0 = *(const f32x4*)(a.in(I_RGCB) + (size_t)l * 256 + 4 * lane);
#pragma unroll
      for (int e = 0; e < 4; ++e) { bs8[e] = b0[e]; bs8[4 + e] = b1[e]; br4[e] = r0[e]; } }
    for (int row0 = gw; row0 < M_ALL; row0 += 2 * NGW) {
        u32x4 x[2][4]; u32x2 y[2][4];
#pragma unroll
        for (int q = 0; q < 2; ++q) { const int row = row0 + q * NGW; if (row < M_ALL) {
            const bool isctx = row >= M_LAT; const int t = isctx ? (row - M_LAT) & (CTXL - 1) : row & (SEQ - 1); const int seglen = isctx ? CTXL : SEQ;
#pragma unroll
            for (int j = 0; j < 4; ++j) { const int ts = t + j - 2; x[q][j] = (u32x4){0u, 0u, 0u, 0u}; y[q][j] = (u32x2){0u, 0u};
                if (ts >= 0 && ts < seglen) { const bf16_t* up = U + (size_t)(row + j - 2) * NU; x[q][j] = *(const u32x4*)(up + C_XBC + 8 * lane); y[q][j] = *(const u32x2*)(up + C_RGX + 4 * lane); } } } }
#pragma unroll
        for (int q = 0; q < 2; ++q) { const int row = row0 + q * NGW; if (row < M_ALL) {
            float v[8], r[4];
#pragma unroll
            for (int e = 0; e < 8; ++e) v[e] = bs8[e];
#pragma unroll
            for (int e = 0; e < 4; ++e) r[e] = br4[e];
#pragma unroll
            for (int j = 0; j < 4; ++j) {
#pragma unroll
                for (int e = 0; e < 4; ++e) { v[2 * e] += ws8[j][2 * e] * bflo(x[q][j][e]); v[2 * e + 1] += ws8[j][2 * e + 1] * bfhi(x[q][j][e]); }
                r[0] += wr4[j][0] * bflo(y[q][j][0]); r[1] += wr4[j][1] * bfhi(y[q][j][0]); r[2] += wr4[j][2] * bflo(y[q][j][1]); r[3] += wr4[j][3] * bfhi(y[q][j][1]); }
            u32x4 w;
#pragma unroll
            for (int e = 0; e < 4; ++e) w[e] = cvt_pk_bf16(siluf_(v[2 * e]), siluf_(v[2 * e + 1]));
            *(u32x4*)(XA + (size_t)row * 512 + 8 * lane) = w;
            u32x2 w2; w2.x = cvt_pk_bf16(r[0], r[1]); w2.y = cvt_pk_bf16(r[2], r[3]);
            *(u32x2*)(XC + (size_t)row * 256 + 4 * lane) = w2; } }
    }
}
DI void ssd_chunk_scan(const KA a, int l, int ci, int lane) {
    unsigned char* ws = a.ws();
    const float* DT = (const float*)(ws + WS_DT); float* CS = (float*)(ws + WS_CS); float* DTS = (float*)(ws + WS_DTS);
    const int row0 = 128 * ci;
    const f32x4 d00 = *(const f32x4*)(DT + (size_t)(row0 + 2 * lane) * 8), d01 = *(const f32x4*)(DT + (size_t)(row0 + 2 * lane) * 8 + 4);
    const f32x4 d10 = *(const f32x4*)(DT + (size_t)(row0 + 2 * lane + 1) * 8), d11 = *(const f32x4*)(DT + (size_t)(row0 + 2 * lane + 1) * 8 + 4);
    const float dt0[8] = {d00[0], d00[1], d00[2], d00[3], d01[0], d01[1], d01[2], d01[3]}, dt1[8] = {d10[0], d10[1], d10[2], d10[3], d11[0], d11[1], d11[2], d11[3]};
#pragma unroll
    for (int j = 0; j < 8; ++j) {
        const float an = -__expf(a.in(I_SALOG)[l * 8 + j]);
        const float a0 = dt0[j] * an, a1 = dt1[j] * an;
        float incl = a0 + a1;
#pragma unroll
        for (int d = 1; d < 64; d <<= 1) { const float o = __shfl_up(incl, d); if (lane >= d) incl += o; }
        const float excl = incl - (a0 + a1);
        float* cs = CS + ((size_t)ci * 8 + j) * 128; float* ds = DTS + ((size_t)ci * 8 + j) * 128;
        if (j < 4) { cs[2 * lane] = excl + a0; cs[2 * lane + 1] = incl; ds[2 * lane] = dt0[j]; ds[2 * lane + 1] = dt1[j]; }
        else { const float tot = __shfl(incl, 63);
            cs[127 - 2 * lane] = tot - excl; cs[126 - 2 * lane] = tot - excl - a0; ds[127 - 2 * lane] = dt0[j]; ds[126 - 2 * lane] = dt1[j]; }
    }
}

namespace att {
constexpr int SHM_V = 16384, SHM_K = 16384;
constexpr float THR = 8.0f;
#define KSWZ(row, colB) ((row) * 256 + ((colB) ^ (((row) & 7) << 4)))
#define SBAR() __builtin_amdgcn_sched_barrier(0)
DI int v_st(int k, int c) { const int kk = (k & ~0xC) | ((k & 4) << 1) | ((k & 8) >> 1); return ((kk >> 3) * 4 + (c >> 5)) * 512 + ((kk & 7) * 32 + (c & 31)) * 2; }
DI int v_rd_base(int lane) { return ((lane & 3) << 3) | (((lane >> 2) & 3) << 6) | (((lane >> 4) & 1) << 5) | (((lane >> 5) & 1) << 8); }
constexpr int v_rd_off(int d0, int ks, int half) { return d0 * 512 + ks * 4096 + half * 2048; }
template <int OFF> DI s16x4 tr_read(int vb) { s16x4 r; asm volatile("ds_read_b64_tr_b16 %0, %1 offset:%2" : "=&v"(r) : "v"(vb), "i"(OFF) : "memory"); return r; }

template <int C> DI void qkt(f32x16& p0, f32x16& p1, const LAS char* Ks, const LAS char* Qs, int r32, int hi) {
    p0 = f32x16{}; p1 = f32x16{};
#pragma unroll
    for (int d = 0; d < 4; ++d) { const int d0 = 4 * C + d; const int cb = (d0 * 16 + hi * 8) * 2;
        const bf16x8 b0 = *(const LAS bf16x8*)(Ks + KSWZ(r32, cb));
        const bf16x8 b1 = *(const LAS bf16x8*)(Ks + KSWZ(32 + r32, cb));
        const bf16x8 q = *(const LAS bf16x8*)(Qs + KSWZ(r32, cb));
        p0 = __builtin_amdgcn_mfma_f32_32x32x16_bf16(b0, q, p0, 0, 0, 0);
        p1 = __builtin_amdgcn_mfma_f32_32x32x16_bf16(b1, q, p1, 0, 0, 0); }
}
DI void softmax_tile(f32x16& p0, f32x16& p1, float& m_reg, float& l_reg, float& alpha, bf16x8& pa0, bf16x8& pa1, bf16x8& pa2, bf16x8& pa3) {
    float pmax = p0[0];
#pragma unroll
    for (int r = 1; r < 16; ++r) pmax = fmaxf(pmax, p0[r]);
#pragma unroll
    for (int r = 0; r < 16; ++r) pmax = fmaxf(pmax, p1[r]);
    { auto rr = __builtin_amdgcn_permlane32_swap(__float_as_uint(pmax), __float_as_uint(pmax), false, false); pmax = fmaxf(__uint_as_float(rr[0]), __uint_as_float(rr[1])); }
    if (__builtin_expect(__all(pmax - m_reg <= THR), 1)) { alpha = 1.f; }
    else { const float mn = fmaxf(m_reg, pmax); alpha = __builtin_amdgcn_exp2f(m_reg - mn); m_reg = mn; }
    float ps = 0.f;
#pragma unroll
    for (int r = 0; r < 16; ++r) { p0[r] = __builtin_amdgcn_exp2f(p0[r] - m_reg); ps += p0[r]; }
#pragma unroll
    for (int r = 0; r < 16; ++r) { p1[r] = __builtin_amdgcn_exp2f(p1[r] - m_reg); ps += p1[r]; }
    { auto rr = __builtin_amdgcn_permlane32_swap(__float_as_uint(ps), __float_as_uint(ps), false, false); ps = __uint_as_float(rr[0]) + __uint_as_float(rr[1]); }
    l_reg = l_reg * alpha + ps;
#define PK4(P, BASE, OUT) do { unsigned a0 = cvt_pk_bf16(P[BASE + 0], P[BASE + 1]), a1 = cvt_pk_bf16(P[BASE + 2], P[BASE + 3]);   \
    unsigned b0 = cvt_pk_bf16(P[BASE + 4], P[BASE + 5]), b1 = cvt_pk_bf16(P[BASE + 6], P[BASE + 7]);                              \
    auto r0 = __builtin_amdgcn_permlane32_swap(a0, b0, false, false); auto r1 = __builtin_amdgcn_permlane32_swap(a1, b1, false, false); \
    u32x4 w = {r0[0], r1[0], r0[1], r1[1]}; OUT = __builtin_bit_cast(bf16x8, w); } while (0)
    PK4(p0, 0, pa0); PK4(p0, 8, pa1); PK4(p1, 0, pa2); PK4(p1, 8, pa3);
#undef PK4
}
template <int D0> DI void pv_one(f32x16& oa, f32x16& ob, int vb, const bf16x8 (&pa)[4], const bf16x8 (&pb)[4]) {
    const s16x4 l0 = tr_read<v_rd_off(D0, 0, 0)>(vb), h0 = tr_read<v_rd_off(D0, 0, 1)>(vb), l1 = tr_read<v_rd_off(D0, 1, 0)>(vb), h1 = tr_read<v_rd_off(D0, 1, 1)>(vb);
    const s16x4 l2 = tr_read<v_rd_off(D0, 2, 0)>(vb), h2 = tr_read<v_rd_off(D0, 2, 1)>(vb), l3 = tr_read<v_rd_off(D0, 3, 0)>(vb), h3 = tr_read<v_rd_off(D0, 3, 1)>(vb);
    asm volatile("s_waitcnt lgkmcnt(0)" ::: "memory"); SBAR();
#define PK(L, H) (bf16x8){L[0], L[1], L[2], L[3], H[0], H[1], H[2], H[3]}
    const bf16x8 v0 = PK(l0, h0), v1 = PK(l1, h1), v2 = PK(l2, h2), v3 = PK(l3, h3);
    oa = __builtin_amdgcn_mfma_f32_32x32x16_bf16(pa[0], v0, oa, 0, 0, 0); ob = __builtin_amdgcn_mfma_f32_32x32x16_bf16(pb[0], v0, ob, 0, 0, 0);
    oa = __builtin_amdgcn_mfma_f32_32x32x16_bf16(pa[1], v1, oa, 0, 0, 0); ob = __builtin_amdgcn_mfma_f32_32x32x16_bf16(pb[1], v1, ob, 0, 0, 0);
    oa = __builtin_amdgcn_mfma_f32_32x32x16_bf16(pa[2], v2, oa, 0, 0, 0); ob = __builtin_amdgcn_mfma_f32_32x32x16_bf16(pb[2], v2, ob, 0, 0, 0);
    oa = __builtin_amdgcn_mfma_f32_32x32x16_bf16(pa[3], v3, oa, 0, 0, 0); ob = __builtin_amdgcn_mfma_f32_32x32x16_bf16(pb[3], v3, ob, 0, 0, 0);
#undef PK
}

DI void attn_unit(LAS unsigned char* lds, const bf16_t* __restrict__ U, bf16_t* __restrict__ MIX, int qrow0, int lat0, int nlat, int ctx0, int nctx, int h,
                  float lam, float outscale, const float* __restrict__ subg, int tid_in) {
    const int tid = launder(tid_in);
    const int wid = __builtin_amdgcn_readfirstlane(tid >> 6), lane = tid & 63, r32 = lane & 31, hi = lane >> 5;
    LAS char* V_lds = (LAS char*)lds; LAS char* K_lds = (LAS char*)lds + 2 * SHM_V;
    LAS float* wsf = (LAS float*)(lds + 2 * SHM_V + 2 * SHM_K) + wid * 128;
    LAS char* Qs = (LAS char*)lds + 2 * SHM_V + 2 * SHM_K + 4096 + wid * 8192;
    float mA = -1e30f, lA = 0.f, mB = -1e30f, lB = 0.f;
    f32x16 oA[4] = {}, oB[4] = {};
    { const bf16_t* Qw = U + (size_t)(qrow0 + wid * 32 + r32) * NU + C_Q + h * 128 + hi * 8;
#pragma unroll
      for (int d0 = 0; d0 < 8; ++d0) *(LAS bf16x8*)(Qs + KSWZ(r32, (d0 * 16 + hi * 8) * 2)) = *(const bf16x8*)(Qw + d0 * 16); }
    const int vb0 = (int)(uintptr_t)V_lds + v_rd_base(lane);
    const int NT = nlat + nctx;
    unsigned offK[2], offV[2];
#pragma unroll
    for (int e = 0; e < 2; ++e) { const int row = 8 * wid + 4 * e + (lane >> 4), p = (lane & 15) ^ (row & 7); offK[e] = (unsigned)(row * NU + p * 8) * 2u;
        const int kk = 8 * wid + ((lane & 31) >> 2), k = (kk & ~0xC) | ((kk & 4) << 1) | ((kk & 8) >> 1), col = (2 * e + (lane >> 5)) * 32 + (lane & 3) * 8; offV[e] = (unsigned)(k * NU + col) * 2u; }
    const char* Ubase = (const char*)U + (size_t)h * 256;
#define KROW(j) ((j) < nlat ? lat0 + 64 * (j) : ctx0 + 64 * ((j) - nlat))
#define DMA_TILE(j, bsel) do { const char* tb_ = Ubase + (size_t)KROW(j) * (NU * 2); \
        _Pragma("unroll") for (int e_ = 0; e_ < 2; ++e_) { \
            __builtin_amdgcn_global_load_lds((const unsigned*)(tb_ + C_K * 2 + offK[e_]), (LAS unsigned*)(K_lds + (bsel) * SHM_K + (2 * wid + e_) * 1024), 16, 0, 0); \
            __builtin_amdgcn_global_load_lds((const unsigned*)(tb_ + C_V * 2 + offV[e_]), (LAS unsigned*)(V_lds + (bsel) * SHM_V + (2 * wid + e_) * 1024), 16, 0, 0); } } while (0)
    DMA_TILE(0, 0);
    asm volatile("s_waitcnt vmcnt(0)" ::: "memory"); __syncthreads();
    for (int j = 0; j < NT; ++j) {
        const int bsel = j & 1;
        if (j + 1 < NT) DMA_TILE(j + 1, bsel ^ 1);
        const LAS char* Ks = K_lds + bsel * SHM_K;
        f32x16 p0, p1; bf16x8 pa[4], pb[4]; float alA, alB;
        qkt<0>(p0, p1, Ks, Qs, r32, hi); softmax_tile(p0, p1, mA, lA, alA, pa[0], pa[1], pa[2], pa[3]);
        qkt<1>(p0, p1, Ks, Qs, r32, hi); softmax_tile(p0, p1, mB, lB, alB, pb[0], pb[1], pb[2], pb[3]);
        if (__any(alA < 1.f || alB < 1.f)) {
            if (hi == 0) { wsf[r32] = alA; wsf[32 + r32] = alB; }
            LDS_WAIT();
#pragma unroll
            for (int r = 0; r < 16; ++r) { const float fa = wsf[crow(r, hi)], fb = wsf[32 + crow(r, hi)];
#pragma unroll
                for (int d = 0; d < 4; ++d) { oA[d][r] *= fa; oB[d][r] *= fb; } }
        }
        const int vb = vb0 + bsel * SHM_V;
        pv_one<0>(oA[0], oB[0], vb, pa, pb); pv_one<1>(oA[1], oB[1], vb, pa, pb); pv_one<2>(oA[2], oB[2], vb, pa, pb); pv_one<3>(oA[3], oB[3], vb, pa, pb);
        asm volatile("s_waitcnt vmcnt(0)" ::: "memory"); __syncthreads();
    }
#undef KROW
#undef DMA_TILE
    if (hi == 0) { wsf[64 + r32] = lA; wsf[96 + r32] = lB; }
    LDS_WAIT();
    float ssq[16];
#pragma unroll
    for (int r = 0; r < 16; ++r) { const float ra = __builtin_amdgcn_rcpf(wsf[64 + crow(r, hi)]), rb = lam * __builtin_amdgcn_rcpf(wsf[96 + crow(r, hi)]);
        float s = 0.f;
#pragma unroll
        for (int d = 0; d < 4; ++d) { const float o = oA[d][r] * ra - oB[d][r] * rb; oA[d][r] = o; s += o * o; }
        ssq[r] = s; }
#pragma unroll
    for (int r = 0; r < 16; ++r) {
#pragma unroll
        for (int s = 1; s < 32; s <<= 1) ssq[r] += __shfl_xor(ssq[r], s);
    }
    float gsub[4];
#pragma unroll
    for (int d = 0; d < 4; ++d) gsub[d] = subg[32 * d + r32] * outscale;
#pragma unroll
    for (int r = 0; r < 16; ++r) { const float rs = __builtin_amdgcn_rsqf(ssq[r] * (1.0f / 128.0f) + EPS);
        bf16_t* op = MIX + (size_t)(qrow0 + wid * 32 + crow(r, hi)) * DM + 512 + h * 128 + r32;
#pragma unroll
        for (int d = 0; d < 4; ++d) op[32 * d] = (bf16_t)f2bf(oA[d][r] * rs * gsub[d]); }
    __syncthreads();
}
#undef KSWZ
#undef SBAR
}

#define XB_TMO      128
#define XB_XCNT(j)  (256  + 64 * (j))
#define XB_XSUB(j)  (1280 + 64 * (j))
#define XB_XGEN(j)  (2304 + 64 * (j))
#define XB_TOP      3328
#define XB_TOPGEN   3392
#define XCD_BAR_WORDS 3456
#define XB_SPIN_CAP (1u << 20)
DI unsigned xb_ld(unsigned* p)              { return __hip_atomic_load(p, __ATOMIC_RELAXED, __HIP_MEMORY_SCOPE_AGENT); }
DI unsigned xb_add(unsigned* p, unsigned v) { return __hip_atomic_fetch_add(p, v, __ATOMIC_RELAXED, __HIP_MEMORY_SCOPE_AGENT); }
DI unsigned xb_xcc_id() { return (unsigned)__builtin_amdgcn_s_getreg((3 << 11) | 20) & 0xFu; }
#define XB_SPIN(cond, bar) do { unsigned _sp = 0; while (cond) { __builtin_amdgcn_s_sleep(1); \
    if ((++_sp & 255u) == 0u) { if (xb_ld(&(bar)[XB_TMO])) break; if (_sp > XB_SPIN_CAP) { atomicAdd(&(bar)[XB_TMO], 1u); break; } } } } while (0)
struct XcdBarrier { unsigned* bar; unsigned x; volatile LAS unsigned* st; };
DI void xcd_barrier_complete(unsigned* bar, unsigned x, unsigned& nloc, unsigned& nx) {
    const unsigned G = gridDim.x;
    unsigned sum, cnt, mine, sp = 0u;
    for (;;) {
        sum = 0u; cnt = 0u; mine = 0u;
#pragma unroll
        for (unsigned j = 0; j < 16; ++j) { const unsigned c = xb_ld(&bar[XB_XCNT(j)]); sum += c; cnt += (c > 0u) ? 1u : 0u; mine = (j == x) ? c : mine; }
        if (sum == G) break;
        __builtin_amdgcn_s_sleep(1);
        if ((++sp & 255u) == 0u) { if (xb_ld(&bar[XB_TMO])) break; if (sp > XB_SPIN_CAP) { atomicAdd(&bar[XB_TMO], 1u); break; } }
    }
    nloc = mine > 0u ? mine : 1u; nx = cnt > 0u ? cnt : 1u;
}
DI void xcd_barrier(const XcdBarrier& b, int tid) {
    asm volatile("s_waitcnt vmcnt(0)" ::: "memory");
    __syncthreads();
    if (tid == 0) {
        unsigned* bar = b.bar;
        __builtin_amdgcn_s_waitcnt(0);
        unsigned nloc = b.st[0], nx = b.st[1];
        if (nloc == 0u) { xcd_barrier_complete(bar, b.x, nloc, nx); b.st[0] = nloc; b.st[1] = nx; }
        const unsigned old = xb_add(&bar[XB_XSUB(b.x)], 1u);
        const unsigned gen = old / nloc;
        if (old + 1u == (gen + 1u) * nloc) {
            __builtin_amdgcn_fence(__ATOMIC_RELEASE, "agent");
            asm volatile("s_waitcnt vmcnt(0)" ::: "memory");
            const unsigned og = xb_add(&bar[XB_TOP], 1u);
            const unsigned tg = og / nx;
            if (og + 1u == (tg + 1u) * nx) xb_add(&bar[XB_TOPGEN], 1u);
            else XB_SPIN(xb_ld(&bar[XB_TOPGEN]) == tg, bar);
            __builtin_amdgcn_fence(__ATOMIC_ACQUIRE, "agent");
            xb_add(&bar[XB_XGEN(b.x)], 1u);
            asm volatile("s_waitcnt vmcnt(0)" ::: "memory");
        } else {
            XB_SPIN(xb_ld(&bar[XB_XGEN(b.x)]) == gen, bar);
            __builtin_amdgcn_fence(__ATOMIC_ACQUIRE, "agent");
            asm volatile("s_waitcnt vmcnt(0)" ::: "memory");
        }
    }
    __syncthreads();
}

DI void convert_weights(const KA a, int l, int widx, int nw, int lane, LAS float* scr) {
    unsigned char* wl = a.ws() + WS_W + (size_t)l * W_LAYER;
    for (int it = widx; it < 6144; it += nw) { int r = it;
        if (r < 1408) { const int kb = r / 88, nb = r % 88, n0 = 32 * nb; transpose_item(a.in(I_WIN) + (size_t)l * 1024 * DIN, DIN, n0 < 1280 ? n0 : n0 + 8, (bf16_t*)(wl + W_IN), 1024, n0, 64 * kb, scr, lane); continue; } r -= 1408;
        if (r < 512) { const int kb = r / 32, nb = r % 32; transpose_item(a.in(I_WOUT) + (size_t)l * 1024 * 1024, 1024, 32 * nb, (bf16_t*)(wl + W_OUT), 1024, 32 * nb, 64 * kb, scr, lane); continue; } r -= 512;
        if (r < 2816) { const int kb = r / 176, nb = r % 176, n0 = 32 * nb, pn = n0 >> 8, bj = (n0 >> 7) & 1, j = n0 & 127;
            transpose_item((bj ? a.in(I_WUP) : a.in(I_WGATE)) + (size_t)l * 1024 * DFF, DFF, 128 * pn + j, (bf16_t*)(wl + W_GU), 1024, n0, 64 * kb, scr, lane); continue; } r -= 2816;
        { const int kb = r / 32, nb = r % 32; transpose_item(a.in(I_WDOWN) + (size_t)l * DFF * 1024, 1024, 32 * nb, (bf16_t*)(wl + W_DOWN), DFF, 32 * nb, 64 * kb, scr, lane); }
    }
}
DI void bias_items(const KA a, int l, int bidx, int nb, int tid, LAS unsigned char* lds) {
    unsigned char* ws = a.ws();
    const float* MOD = (const float*)(ws + WS_MOD); float* BIAS_IN = (float*)(ws + WS_BIAS_IN); float* BIAS_DT = (float*)(ws + WS_BIAS_DT); float* BIAS_GU = (float*)(ws + WS_BIAS_GU);
    LAS float* A = (LAS float*)lds; LAS float* red = (LAS float*)(lds + 73728);
    for (int r = bidx; r < 133; r += nb) { const int chunk = r < 45 ? 0 : 3;
#pragma unroll
        for (int q = 0; q < 9; ++q) { const int i4 = tid + 512 * q; if (i4 < 17 * 256) { const int b = i4 >> 8, k = (i4 & 255) * 4;
            *(LAS f32x4*)(A + i4 * 4) = *(const f32x4*)(MOD + (size_t)l * 17 * 6144 + (size_t)b * 6144 + chunk * 1024 + k); } }
        __syncthreads();
        if (r < 44) gemv17(A, red, a.in(I_WIN) + (size_t)l * 1024 * DIN, DIN, (64 * r < 1280 ? 64 * r : 64 * r + 8), 64, BIAS_IN + (size_t)l * 17 * NU, NU, 64 * r, nullptr, tid);
        else if (r == 44) gemv17(A, red, a.in(I_WIN) + (size_t)l * 1024 * DIN, DIN, 1280, 8, BIAS_DT + (size_t)l * 17 * 8, 8, 0, nullptr, tid);
        else { const int n0 = 64 * (r - 45), pn = n0 >> 8, bj = (n0 >> 7) & 1, j = n0 & 127;
            gemv17(A, red, (bj ? a.in(I_WUP) : a.in(I_WGATE)) + (size_t)l * 1024 * DFF, DFF, 128 * pn + j, 64, BIAS_GU + (size_t)l * 17 * NGU, NGU, n0, nullptr, tid); }
    }
}

__global__ void __launch_bounds__(512) hybrid_fwd(Args args_unused) {
    extern __shared__ __attribute__((aligned(16))) unsigned char lds_raw[];
    LAS unsigned char* lds = (LAS unsigned char*)lds_raw;
    const int wave0 = __builtin_amdgcn_readfirstlane((int)threadIdx.x >> 6);
    const int G = gridDim.x, bid = blockIdx.x;
    const int vcu = (G % 8 == 0) ? (bid % 8) * (G / 8) + bid / 8 : bid;
    const int NGW = G * 8;
    const bool vcu_is_bid = true;
#define PHASE_IDS() const KA a = ka_fresh(); unsigned char* const ws = a.ws(); const int lane = lane_fresh(), wave = launder_s(wave0), tid = wave * 64 + lane, gw = vcu * 8 + wave; (void)tid; (void)gw; (void)ws
    {
        const KA a = ka_fresh(); unsigned* bar = (unsigned*)a.ws(); const unsigned x = (unsigned)__builtin_amdgcn_readfirstlane((int)xb_xcc_id());
        volatile LAS unsigned* st = (volatile LAS unsigned*)(lds + 143360);
        if (threadIdx.x == 0) { st[0] = 0u; st[1] = 0u; (void)xb_add(&bar[XB_XCNT(x)], 1u); }
        __syncthreads();
    }
#define GRID_BAR() do { const KA a_ = ka_fresh(); XcdBarrier xb_; xb_.bar = (unsigned*)a_.ws(); xb_.x = (unsigned)__builtin_amdgcn_readfirstlane((int)xb_xcc_id()); xb_.st = (volatile LAS unsigned*)(lds + 143360); \
        xcd_barrier(xb_, launder_s(wave0) * 64 + lane_fresh()); } while (0)

    for (int rep0 = 0; rep0 < REP_P0; ++rep0) {
    {
        PHASE_IDS();
        float* MOD = (float*)(ws + WS_MOD); float* ROPE = (float*)(ws + WS_ROPE); float* WDT = (float*)(ws + WS_WDT);
        LAS float* A = (LAS float*)lds; LAS float* red = (LAS float*)(lds + 73728);
        for (int it = bid; it < 2 * 96; it += G) { const int l = it / 96, cb = it % 96;
#pragma unroll
            for (int q = 0; q < 9; ++q) { const int i4 = tid + 512 * q; if (i4 < 17 * 256) { const int b = i4 >> 8, k = (i4 & 255) * 4; const f32x4 cv = *(const f32x4*)(b < 16 ? a.in(I_C) + b * 1024 + k : a.in(I_CCTX) + k);
                *(LAS f32x4*)(A + i4 * 4) = (f32x4){siluf_(cv.x), siluf_(cv.y), siluf_(cv.z), siluf_(cv.w)}; } }
            __syncthreads();
            gemv17(A, red, a.in(I_WMOD) + (size_t)l * 1024 * 6144, 6144, cb * 64, 64, MOD + (size_t)l * 17 * 6144, 6144, cb * 64, a.in(I_BMOD) + (size_t)l * 6144 + cb * 64, tid);
        }
        convert_weights(a, 0, gw, NGW, lane, (LAS float*)(lds + wave * 16384));
        const int gt = bid * 512 + tid;
        if (gt < 2 * 8192) { const int l = gt >> 13, j = (gt >> 10) & 7, k = gt & 1023; WDT[gt] = a.in(I_WIN)[(size_t)l * 1024 * DIN + (size_t)k * DIN + 1280 + j]; }
        if (gt < 1024) { const int pos = gt >> 4, j = gt & 15; const float invf = __builtin_amdgcn_exp2f(-(float)j * 0.8304820237218406f); const float ang = (float)pos * invf; ROPE[gt * 2] = __cosf(ang); ROPE[gt * 2 + 1] = __sinf(ang); }
    }
    cg::this_grid().sync();
    {
        PHASE_IDS();
        float* MOD = (float*)(ws + WS_MOD); float* BIAS_IN = (float*)(ws + WS_BIAS_IN); float* BIAS_DT = (float*)(ws + WS_BIAS_DT); float* BIAS_GU = (float*)(ws + WS_BIAS_GU);
        float* ROWPART = (float*)(ws + WS_ROWPART); bf16_t* HB = (bf16_t*)(ws + WS_HB);
        bias_items(a, 0, bid, G, tid, lds);
        const int nheavy = 0;
        const int gwx = (vcu_is_bid ? (bid - nheavy) * 8 + wave : gw), NGWX = vcu_is_bid ? (G - nheavy) * 8 : NGW;
        if (!vcu_is_bid || bid >= nheavy)
        for (int row0 = gwx; row0 < M_ALL; row0 += 3 * NGWX) {
            f32x4 xv[3][4];
#pragma unroll
            for (int q = 0; q < 3; ++q) { const int row = row0 + q * NGWX; if (row < M_ALL) { const bool isctx = row >= M_LAT;
                const float* xr = isctx ? a.in(I_CTX) + (size_t)(row - M_LAT) * DM : a.in(I_X) + (size_t)row * DM;
#pragma unroll
                for (int j = 0; j < 4; ++j) xv[q][j] = *(const f32x4*)(xr + (lane + 64 * j) * 4); } }
#pragma unroll
            for (int q = 0; q < 3; ++q) { const int row = row0 + q * NGWX; if (row < M_ALL) { const bool isctx = row >= M_LAT; const int b = isctx ? 16 : row >> 11;
                const float* g = a.in(I_N1G); const float* sc = MOD + (size_t)b * 6144 + 1024;
                float ss = 0.f;
#pragma unroll
                for (int j = 0; j < 4; ++j) { const int col = (lane + 64 * j) * 4; const f32x4 v = xv[q][j]; const f32x4 gg = *(const f32x4*)(g + col), s4 = *(const f32x4*)(sc + col);
                    ss += (v.x * v.x + v.y * v.y) + (v.z * v.z + v.w * v.w); const f32x4 p = v * (gg * (s4 + 1.0f));
                    u32x2 w; w.x = cvt_pk_bf16(p.x, p.y); w.y = cvt_pk_bf16(p.z, p.w); *(u32x2*)(HB + (size_t)row * DM + col) = w; }
                ss = wave_sum(ss);
                if (lane < 4) { f32x4 o = {0.f, 0.f, 0.f, 0.f}; if (lane == 0) o.x = ss; *(f32x4*)(ROWPART + (size_t)row * 16 + lane * 4) = o; } } }
        }
    }
    GRID_BAR();
    }

    for (int l = 0; l < 2; ++l) {
        const int nM = (l == 0) ? 144 : 128;
        for (int rep = 0; rep < REP_P1; ++rep) {
            if (rep) GRID_BAR();
            PHASE_IDS();
            bf16_t* HB = (bf16_t*)(ws + WS_HB); float* rp1 = (float*)(ws + WS_ROWPART) + (size_t)(2 * l) * ROWPART_STRIDE;
            pg8::Gemm g{HB, (const bf16_t*)(ws + WS_W + (size_t)l * W_LAYER + W_IN), 1024}; pg8::TileOrder S; S.init(nM, 11, G, bid, l == 0 ? 0 : 112);
            pg8::EpiIn E{(bf16_t*)(ws + WS_U), rp1, (const float*)(ws + WS_BIAS_IN) + (size_t)l * 17 * NU, (const float*)(ws + WS_ROPE)};
            pg8::gemm_phase<pg8::EpiIn, true>(lds, g, S, E, wave0);
            LAS float* WT = (LAS float*)lds;
            const float* WDT = (const float*)(ws + WS_WDT); const float* BIAS_DT = (const float*)(ws + WS_BIAS_DT); float* DT = (float*)(ws + WS_DT);
            for (int i = tid; i < 8192; i += 512) WT[i] = WDT[l * 8192 + i];
            __syncthreads();
            for (int row0 = gw; row0 < M_ALL; row0 += NGW) {
                u32x4 xr[1][2];
#pragma unroll
                for (int q = 0; q < 1; ++q) { const int row = row0 + q * NGW; if (row < M_ALL) { xr[q][0] = *(const u32x4*)(HB + (size_t)row * DM + 8 * lane); xr[q][1] = *(const u32x4*)(HB + (size_t)row * DM + 8 * lane + 512); } }
#pragma unroll
                for (int q = 0; q < 1; ++q) { const int row = row0 + q * NGW; if (row < M_ALL) {
                    const bool isctx = row >= M_LAT; const int b = isctx ? 16 : row >> 11;
                    float acc[8];
#pragma unroll
                    for (int j = 0; j < 8; ++j) acc[j] = 0.f;
#pragma unroll
                    for (int kk = 0; kk < 2; ++kk) { const u32x4 x = xr[q][kk];
                        const float xf[8] = {bflo(x[0]), bfhi(x[0]), bflo(x[1]), bfhi(x[1]), bflo(x[2]), bfhi(x[2]), bflo(x[3]), bfhi(x[3])};
#pragma unroll
                        for (int j = 0; j < 8; ++j) { const f32x4 w0 = *(const LAS f32x4*)(WT + j * 1024 + 8 * lane + 512 * kk), w1 = *(const LAS f32x4*)(WT + j * 1024 + 8 * lane + 512 * kk + 4);
                            acc[j] += (xf[0] * w0[0] + xf[1] * w0[1]) + (xf[2] * w0[2] + xf[3] * w0[3]) + (xf[4] * w1[0] + xf[5] * w1[1]) + (xf[6] * w1[2] + xf[7] * w1[3]); } }
#pragma unroll
                    for (int j = 0; j < 8; ++j) acc[j] = wave_sum(acc[j]);
                    const float rstd = pg8::row_rstd(rp1, row);
                    float mine = acc[0];
#pragma unroll
                    for (int j = 1; j < 8; ++j) mine = (lane == j) ? acc[j] : mine;
                    if (lane < 8) { const float raw = mine * rstd + BIAS_DT[(size_t)l * 17 * 8 + b * 8 + lane] + a.in(I_SDTB)[l * 8 + lane]; DT[(size_t)row * 8 + lane] = softplusf_(raw); } } }
            }
        }
        GRID_BAR();
        {
            PHASE_IDS();
            for (int ci = gw; ci < M_ALL / 128; ci += NGW) ssd_chunk_scan(a, l, ci, lane);
            preconv_rows(a, l, gw, NGW, lane);
        }
        GRID_BAR();
        for (int rep = 0; rep < REP_P2; ++rep) {
            if (rep) GRID_BAR();
            PHASE_IDS();
            const bf16_t* U = (const bf16_t*)(ws + WS_U); bf16_t* MIX = (bf16_t*)(ws + WS_MIX);
            float lam, lam_init;
            { const float* lv = a.in(I_DALAM) + (size_t)l * 256; const float s1 = wave_sum(lv[lane] * lv[64 + lane]), s2 = wave_sum(lv[128 + lane] * lv[192 + lane]);
              lam_init = 0.8f - 0.6f * __expf(-0.3f * (float)l); lam = uniformf(__expf(s1) - __expf(s2) + lam_init); lam_init = uniformf(lam_init); }
            const float* subg = a.in(I_DASG) + (size_t)l * 128;
            for (int u = vcu; u < 1024; u += G) {
                if (u < 128) { if (!(rep && P2_SKIP_SSD_ON_REP)) ssd_unit(a, lds, l, u >> 3, (u >> 1) & 3, u & 1, tid); }
                else if (u < 256) { if (!(rep && P2_SKIP_RG_ON_REP)) rg_unit(a, lds, l, (u - 128) >> 3, ((u - 128) >> 1) & 3, (u - 128) & 1, tid); }
                else if (u < 320) { if (l == 0 && !(rep && P2_SKIP_ATT_ON_REP)) { const int b = (u - 256) >> 2, h = (u - 256) & 3; att::attn_unit(lds, U, MIX, M_LAT + b * CTXL, 0, 0, M_LAT + b * CTXL, 4, h, lam, 1.0f - lam_init, subg, tid); } }
                else if (u >= 512 && !(rep && P2_SKIP_ATT_ON_REP)) { const int aidx = u - 512, bh = aidx >> 3, qb = aidx & 7, b = bh >> 2, h = bh & 3;
                    att::attn_unit(lds, U, MIX, b * SEQ + qb * 256, b * SEQ, 32, M_LAT + b * CTXL, 4, h, lam, 1.0f - lam_init, subg, tid); }
                __syncthreads();
            }
        }
        GRID_BAR();
        {
            PHASE_IDS();
            const int nrows = (l == 0) ? M_ALL : M_LAT;
            for (int row = gw; row < nrows; row += 3 * NGW) ssd_combine_rows<3>(a, l, row, NGW, nrows, lane);
        }
        GRID_BAR();
        {
            PHASE_IDS();
            const float* modl = (const float*)(ws + WS_MOD) + (size_t)l * 17 * 6144; float* HCTX = (float*)(ws + WS_HCTX);
            pg8::Gemm g{(const bf16_t*)(ws + WS_MIX), (const bf16_t*)(ws + WS_W + (size_t)l * W_LAYER + W_OUT), 1024}; pg8::TileOrder S; S.init(nM, 4, G, bid, 0);
            pg8::EpiRes E{l == 0 ? a.in(I_X) : (const float*)a.out(), l == 0 ? a.in(I_CTX) : (const float*)HCTX, a.out(), HCTX, modl + 2 * 1024, (bf16_t*)(ws + WS_HB), a.in(I_N2G) + (size_t)l * 1024, modl + 4 * 1024,
                          (float*)(ws + WS_ROWPART) + (size_t)(2 * l + 1) * ROWPART_STRIDE};
            pg8::gemm_phase<pg8::EpiRes, true>(lds, g, S, E, wave0);
            if (l == 0) {
                const int nwg = nM * 4, nh3 = (nwg > 2 * G) ? ((nwg - 2 * G) < G ? (nwg - 2 * G) : G) : 0, nl = (G - nh3) > 0 ? (G - nh3) : G, li = (G - nh3) > 0 ? bid - nh3 : bid;
                if (li >= 0) convert_weights(a, 1, li * 8 + wave, nl * 8, lane, (LAS float*)(lds + wave * 16384));
            }
        }
        GRID_BAR();
        for (int rep = 0; rep < REP_P4; ++rep) {
            if (rep) GRID_BAR();
            PHASE_IDS();
            pg8::Gemm g{(const bf16_t*)(ws + WS_HB), (const bf16_t*)(ws + WS_W + (size_t)l * W_LAYER + W_GU), 1024}; pg8::TileOrder S; S.init(nM, 22, G, bid, 0);
            pg8::EpiGLU E{(bf16_t*)(ws + WS_U), (const float*)(ws + WS_ROWPART) + (size_t)(2 * l + 1) * ROWPART_STRIDE, (const float*)(ws + WS_BIAS_GU) + (size_t)l * 17 * NGU};
            pg8::gemm_phase<pg8::EpiGLU, true>(lds, g, S, E, wave0);
        }
        GRID_BAR();
        {
            PHASE_IDS();
            const float* MOD = (const float*)(ws + WS_MOD); float* HCTX = (float*)(ws + WS_HCTX);
            pg8::Gemm g{(const bf16_t*)(ws + WS_U), (const bf16_t*)(ws + WS_W + (size_t)l * W_LAYER + W_DOWN), DFF}; pg8::TileOrder S; S.init(nM, 4, G, bid, 0);
            pg8::EpiRes E{(const float*)a.out(), (const float*)HCTX, a.out(), HCTX, MOD + (size_t)l * 17 * 6144 + 5 * 1024, l == 0 ? (bf16_t*)(ws + WS_HB) : nullptr, a.in(I_N1G) + 1024, MOD + (size_t)17 * 6144 + 1024,
                          (float*)(ws + WS_ROWPART) + (size_t)(2 * l + 2) * ROWPART_STRIDE};
            pg8::gemm_phase<pg8::EpiRes, true>(lds, g, S, E, wave0);
            if (l == 0) {
                const int nwg = nM * 4, nh3 = (nwg > 2 * G) ? ((nwg - 2 * G) < G ? (nwg - 2 * G) : G) : 0, nl = (G - nh3) > 0 ? (G - nh3) : G, li = (G - nh3) > 0 ? bid - nh3 : bid;
                if (li >= 0) bias_items(a, 1, li, nl, tid, lds);
            }
        }
        GRID_BAR();
    }
    {
        PHASE_IDS();
        const float* rpf = (const float*)(ws + WS_ROWPART) + (size_t)4 * ROWPART_STRIDE; const float* g = a.in(I_FNG); float* outp = a.out();
        for (int row0 = gw; row0 < M_LAT; row0 += 3 * NGW) {
            f32x4 xv[3][4]; float rstd[3];
#pragma unroll
            for (int q = 0; q < 3; ++q) { const int row = row0 + q * NGW; if (row < M_LAT) { rstd[q] = pg8::row_rstd(rpf, row);
#pragma unroll
                for (int j = 0; j < 4; ++j) xv[q][j] = *(const f32x4*)(outp + (size_t)row * DM + (lane + 64 * j) * 4); } }
#pragma unroll
            for (int q = 0; q < 3; ++q) { const int row = row0 + q * NGW; if (row < M_LAT) {
#pragma unroll
                for (int j = 0; j < 4; ++j) { const int col = (lane + 64 * j) * 4; const f32x4 gg = *(const f32x4*)(g + col); *(f32x4*)(outp + (size_t)row * DM + col) = xv[q][j] * rstd[q] * gg; } } }
        }
    }
}

extern "C" void kernel_launch(void* const* d_in, const int* in_sizes, int n_in, void* d_out, int out_size, void* d_ws, size_t ws_size, hipStream_t stream) {
    static int grid = 0;
    if (grid == 0) {
        if (n_in != N_IN || in_sizes[0] != M_LAT * DM || out_size != M_LAT * DM || ws_size < WS_END) {
            fprintf(stderr, "kernel_launch: unexpected shapes (n_in %d, in0 %d, out %d, ws %zu); nothing launched\n", n_in, n_in > 0 ? in_sizes[0] : -1, out_size, ws_size); grid = -1; return; }
        int dev = 0, cus = 0, per_cu = 0;
        if (hipGetDevice(&dev) != hipSuccess || hipDeviceGetAttribute(&cus, hipDeviceAttributeMultiprocessorCount, dev) != hipSuccess) { grid = -1; return; }
        if (hipFuncSetAttribute((const void*)hybrid_fwd, hipFuncAttributeMaxDynamicSharedMemorySize, LDS_BYTES) != hipSuccess) { fprintf(stderr, "kernel_launch: hipFuncSetAttribute failed\n"); grid = -1; return; }
        if (hipOccupancyMaxActiveBlocksPerMultiprocessor(&per_cu, (const void*)hybrid_fwd, 512, LDS_BYTES) != hipSuccess || per_cu < 1) { fprintf(stderr, "kernel_launch: occupancy query says %d\n", per_cu); (void)hipGetLastError(); grid = -1; return; }
        grid = cus * (per_cu < 1 ? 1 : 1);
    }
    if (grid < 0) return;
    if (hipMemsetAsync(d_ws, 0, 65536, stream) != hipSuccess) { fprintf(stderr, "kernel_launch: memset failed\n"); return; }
    Args a{};
    for (int i = 0; i < N_IN; ++i) a.in[i] = (const float*)d_in[i];
    a.out = (float*)d_out; a.ws = (unsigned char*)d_ws;
    void* args[] = {&a};
    hipError_t e = hipLaunchCooperativeKernel((const void*)hybrid_fwd, dim3(grid), dim3(512), args, LDS_BYTES, stream);
    if (e != hipSuccess) fprintf(stderr, "kernel_launch: cooperative launch failed: %s (grid %d)\n", hipGetErrorString(e), grid);
}
```

```cpp
#include <hip/hip_runtime.h>
#include <hip/hip_cooperative_groups.h>
#include <cstdio>
#include <cstdint>
namespace cg = cooperative_groups;

#define LAS __attribute__((address_space(3)))
#define DI __device__ __forceinline__
typedef unsigned short bf16_t;
typedef short bf16x8 __attribute__((ext_vector_type(8)));
typedef short s16x4 __attribute__((ext_vector_type(4)));
typedef float f32x4 __attribute__((ext_vector_type(4)));
typedef float f32x2 __attribute__((ext_vector_type(2)));
typedef float f32x16 __attribute__((ext_vector_type(16)));
typedef unsigned u32x4 __attribute__((ext_vector_type(4)));
typedef unsigned u32x2 __attribute__((ext_vector_type(2)));

constexpr int DM = 1024, NB = 16, SEQ = 2048, CTXL = 256;
constexpr int M_LAT = NB * SEQ, M_CTX = NB * CTXL, M_ALL = M_LAT + M_CTX;
constexpr int NU = 2816, DFF = 2816, NGU = 5632, DIN = 2824;
constexpr int C_RGX = 0, C_RGG = 256, C_SZ = 512, C_XBC = 768, C_Q = 1280, C_K = 1792, C_V = 2304;
constexpr float EPS = 1e-6f;
constexpr float QSCALE = 0.125f * 1.4426950408889634f;
enum { I_X = 0, I_C, I_CTX, I_CCTX, I_WMOD, I_BMOD, I_N1G, I_WIN, I_RGCW, I_RGCB, I_RGWA, I_RGBA, I_RGWX, I_RGBX, I_RGLAM, I_SCW, I_SCB, I_SDTB, I_SALOG,
       I_SD, I_SNG, I_DALAM, I_DASG, I_WOUT, I_N2G, I_WGATE, I_WUP, I_WDOWN, I_FNG, N_IN };

constexpr size_t MiB = 1u << 20;
constexpr size_t WS_SSDCNT = 16384;
constexpr size_t WS_MOD = 1 * MiB;
constexpr size_t WS_BIAS_IN = 2 * MiB;
constexpr size_t WS_BIAS_DT = 2 * MiB + 512 * 1024;
constexpr size_t WS_BIAS_GU = 3 * MiB;
constexpr size_t WS_ROPE = 4 * MiB;
constexpr size_t WS_WDT = 4 * MiB + 64 * 1024;
constexpr size_t WS_DT = 5 * MiB;
constexpr size_t WS_ROWPART = 8 * MiB;
constexpr size_t ROWPART_STRIDE = (size_t)M_ALL * 16;
constexpr size_t WS_W = 20 * MiB;
constexpr size_t W_LAYER = 24 * MiB, W_IN = 0, W_OUT = 5 * MiB + 512 * 1024, W_GU = 7 * MiB + 512 * 1024, W_DOWN = 18 * MiB + 512 * 1024;
constexpr size_t WS_CS = 68 * MiB;
constexpr size_t WS_DTS = 70 * MiB;
constexpr size_t WS_HCTX = 426 * MiB;
constexpr size_t WS_HB = 84 * MiB;
constexpr size_t WS_U = 156 * MiB;
constexpr size_t WS_MIX = 354 * MiB;
constexpr size_t WS_RGS = 426 * MiB;
constexpr size_t WS_XBCA = 444 * MiB;
constexpr size_t WS_XC = 480 * MiB;
constexpr size_t WS_END = 498 * MiB;
constexpr int LDS_BYTES = 147456;
constexpr unsigned PROBE_MASK = 0u; constexpr int PROBE_COLS = 256; constexpr int PROBE_SEC_A = 0, PROBE_SEC_B = 0, PROBE_BLOCK = 0;
constexpr int REP_P0 = 1, REP_P1 = 1, REP_P2 = 1, REP_P4 = 1; constexpr bool P2_SKIP_SSD_ON_REP = false, P2_SKIP_ATT_ON_REP = false, P2_SKIP_RG_ON_REP = false;

struct Args { const float* in[N_IN]; float* out; unsigned char* ws; };
typedef const unsigned char __attribute__((address_space(4)))* kptr_t;
struct KA {
    kptr_t kb;
    __device__ __forceinline__ const float* in(int i) const { return *(const float* const __attribute__((address_space(4)))*)(kb + 8 * i); }
    __device__ __forceinline__ float* out() const { return *(float* const __attribute__((address_space(4)))*)(kb + 8 * N_IN); }
    __device__ __forceinline__ unsigned char* ws() const { return *(unsigned char* const __attribute__((address_space(4)))*)(kb + 8 * (N_IN + 1)); }
};
__device__ __forceinline__ KA ka_fresh() { kptr_t p = (kptr_t)__builtin_amdgcn_kernarg_segment_ptr(); asm volatile("" : "+s"(p)); return KA{p}; }

DI unsigned cvt_pk_bf16(float lo, float hi) { unsigned r; asm volatile("v_cvt_pk_bf16_f32 %0, %1, %2" : "=v"(r) : "v"(lo), "v"(hi)); return r; }
DI unsigned f2bf(float f) { unsigned u = __builtin_bit_cast(unsigned, f); return (u + 0x7fffu + ((u >> 16) & 1u)) >> 16; }
DI float bf2f(unsigned v) { return __builtin_bit_cast(float, v << 16); }
DI float bflo(unsigned w) { return __builtin_bit_cast(float, w << 16); }
DI float bfhi(unsigned w) { return __builtin_bit_cast(float, w & 0xffff0000u); }
DI float rcpf_(float x) { return __builtin_amdgcn_rcpf(x); }
DI float sigmoidf_(float x) { return rcpf_(1.0f + __expf(-x)); }
DI float siluf_(float x) { return x * rcpf_(1.0f + __expf(-x)); }
DI float log1p_small(float e) { return e < 1e-3f ? e * (1.0f - 0.5f * e) : __logf(1.0f + e); }
DI float softplusf_(float x) { return fmaxf(x, 0.f) + log1p_small(__expf(-fabsf(x))); }
DI float neg_expm1(float x) { return x > -0.02f ? -x * (1.0f + x * (0.5f + x * 0.16666667f)) : 1.0f - __expf(x); }
DI float gelu_tanh(float x) { const float u = 0.7978845608028654f * (x + 0.044715f * x * x * x); return x * rcpf_(1.0f + __expf(-2.0f * u)); }
DI float uniformf(float v) { return __builtin_bit_cast(float, __builtin_amdgcn_readfirstlane(__builtin_bit_cast(int, v))); }
template <int M> DI float swz_xor(float v) { return __builtin_bit_cast(float, __builtin_amdgcn_ds_swizzle(__builtin_bit_cast(int, v), (M << 10) | 0x1f)); }
DI float half_sum(float v) { auto r = __builtin_amdgcn_permlane32_swap(__float_as_uint(v), __float_as_uint(v), false, false); return __uint_as_float(r[0]) + __uint_as_float(r[1]); }
DI float wave_sum(float v) { v += swz_xor<1>(v); v += swz_xor<2>(v); v += swz_xor<4>(v); v += swz_xor<8>(v); v += swz_xor<16>(v); return half_sum(v); }
DI float sum32(float v) { v += swz_xor<1>(v); v += swz_xor<2>(v); v += swz_xor<4>(v); v += swz_xor<8>(v); v += swz_xor<16>(v); return v; }
DI int crow(int r, int hi) { return (r & 3) + 8 * (r >> 2) + 4 * hi; }
#define LDS_WAIT() asm volatile("s_waitcnt lgkmcnt(0)" ::: "memory")
DI int lane_fresh() { int r; asm volatile("v_mbcnt_lo_u32_b32 %0, -1, 0\n\tv_mbcnt_hi_u32_b32 %0, -1, %0" : "=v"(r)); return r; }
DI int launder_s(int x) { asm volatile("" : "+s"(x)); return x; }
DI int launder(int x) { asm volatile("" : "+v"(x)); return x; }

namespace pg8 {
#define PG8_LAS __attribute__((address_space(3)))
constexpr int BM = 256, BK = 64, HALF = 128, HTB = HALF * BK * 2, STAGE_BYTES = 8 * HTB, NXCD = 8, WGM = 8;
__host__ __device__ __forceinline__ int lds_byte(int r, int c) { const int st = (r >> 4) * 2 + (c >> 5), rr = r & 15, cc = c & 31, ob = rr * 64 + cc * 2; return st * 1024 + (ob ^ (((ob >> 9) & 1) << 5)); }
__host__ __device__ __forceinline__ void stage_rc(int b, int& R, int& C) { const int st = b / 1024, sb = b % 1024, swz = sb ^ (((sb >> 9) & 1) << 5); R = (st >> 1) * 16 + swz / 64; C = (st & 1) * 32 + (swz % 64) / 2; }
__host__ __device__ __forceinline__ int perm32(int rho) { const int n = rho >> 4, i = rho & 15; return 8 * (i >> 2) + 4 * n + (i & 3); }
struct Unit { int pm, pn; };
struct Gemm { const bf16_t* A; const bf16_t* Bt; int K; };

struct TileOrder {
    int nM, nN, nwg, G, c, n2, L0, Lend, pm0;
    __device__ void init(int nM_, int nN_, int G_, int c_, int n2_, int L0_ = 0, int Lend_ = 1 << 30, int pm0_ = 0) { nM = nM_; nN = nN_; nwg = nM * nN; G = G_; c = c_; n2 = n2_; L0 = L0_; Lend = Lend_; pm0 = pm0_; }
    __device__ bool next(int i, Unit& u) const {
        if (c < 0) return false;
        const int L = L0 + i * G + c;
        if (L >= Lend) return false;
        if (L < nwg) {
            int wgid = L; { const int q = nwg / NXCD, r = nwg % NXCD, xcd = wgid % NXCD, off = wgid / NXCD; wgid = (xcd < r ? xcd * (q + 1) : r * (q + 1) + (xcd - r) * q) + off; }
            const int nig = WGM * nN, gid = wgid / nig, fm = gid * WGM, gsz = (nM - fm) < WGM ? (nM - fm) : WGM;
            u.pm = pm0 + fm + ((wgid % nig) % gsz); u.pn = (wgid % nig) / gsz; return true;
        }
        const int L2 = L - nwg;
        if (L2 < n2) { u.pm = 128 + (L2 & 15); const int ci = L2 >> 4; u.pn = ci == 0 ? 0 : (ci < 3 ? ci + 2 : ci + 4); return true; }
        return false;
    }
};

template <class Epi, bool ALIGN_EPI>
__device__ __forceinline__ void gemm_phase(PG8_LAS unsigned char* lds, const Gemm g, const TileOrder& S, const Epi& E, const int wave_id) {
    const int lane = lane_fresh(), wid = launder_s(wave_id), tid = wid * 64 + lane, wr = wid >> 2, wc = wid & 3, fr = lane & 15, fq = lane >> 4;
    const int K = g.K, nt = K / BK;
    unsigned voffA[2], voffB[2];
#pragma unroll
    for (int i = 0; i < 2; ++i) { int R, C; stage_rc(tid * 16 + i * 8192, R, C); const int Rb = (R & ~31) + perm32(R & 31);
        voffA[i] = (unsigned)(R * K + C) * 2u; voffB[i] = (unsigned)(Rb * K + C) * 2u; }
    const size_t kstep = (size_t)(BK * 2);
    const size_t hstep = (size_t)HALF * K * 2;
    const size_t tstep = 2 * hstep;
    const unsigned ldsw = (unsigned)wid * 1024u;
    const int aoff = lds_byte(wr * 64 + fr, fq * 8), boff = lds_byte(wc * 32 + fr, fq * 8);
#define PG8_SA(b, h) (((b) * 2 + (h)) * HTB)
#define PG8_SB(b, h) ((4 + (b) * 2 + (h)) * HTB)
#define PG8_STAGE(bufoff, gbase, voff) do { _Pragma("unroll") for (int _i = 0; _i < 2; ++_i) \
        __builtin_amdgcn_global_load_lds((const unsigned*)((const char*)(gbase) + (voff)[_i]), (PG8_LAS unsigned*)(lds + (bufoff) + ldsw + _i * 8192), 16, 0, 0); } while (0)
#define PG8_LDA(dst, b, h) do { _Pragma("unroll") for (int m = 0; m < 4; ++m) _Pragma("unroll") for (int k = 0; k < 2; ++k) dst[m][k] = *(const PG8_LAS bf16x8*)(lds + PG8_SA(b, h) + aoff + m * 2048 + k * 1024); } while (0)
#define PG8_LDB(dst, b, h) do { _Pragma("unroll") for (int n = 0; n < 2; ++n) _Pragma("unroll") for (int k = 0; k < 2; ++k) dst[n][k] = *(const PG8_LAS bf16x8*)(lds + PG8_SB(b, h) + boff + n * 2048 + k * 1024); } while (0)
#define PG8_MMA(ai, bj, At, Bt) do { __builtin_amdgcn_s_setprio(1); _Pragma("unroll") for (int m = 0; m < 4; ++m) _Pragma("unroll") for (int n = 0; n < 2; ++n) _Pragma("unroll") for (int k = 0; k < 2; ++k) \
        acc[ai][bj][m][n] = __builtin_amdgcn_mfma_f32_16x16x32_bf16(Bt[n][k], At[m][k], acc[ai][bj][m][n], 0, 0, 0); __builtin_amdgcn_s_setprio(0); } while (0)
#define PG8_WAIT_V(n) asm volatile("s_waitcnt vmcnt(" #n ")" ::: "memory")
#define PG8_WAIT_L(n) asm volatile("s_waitcnt lgkmcnt(" #n ")" ::: "memory")
#define PG8_BAR __builtin_amdgcn_s_barrier()
#define PG8_SCHED __builtin_amdgcn_sched_barrier(0)
    Unit cur, nxt; int ui = 0;
    if (!S.next(0, cur)) return;
    f32x4 acc[2][2][4][2];
#pragma unroll
    for (int a = 0; a < 2; ++a)
#pragma unroll
        for (int b = 0; b < 2; ++b)
#pragma unroll
            for (int m = 0; m < 4; ++m)
#pragma unroll
                for (int n = 0; n < 2; ++n) acc[a][b][m][n] = (f32x4){0.f, 0.f, 0.f, 0.f};
    bf16x8 At[4][2], B0[2][2], B1[2][2];
    const char* cA = (const char*)g.A + (size_t)cur.pm * tstep; const char* cB = (const char*)g.Bt + (size_t)cur.pn * tstep;
    PG8_STAGE(PG8_SB(0, 0), cB, voffB); PG8_STAGE(PG8_SB(0, 1), cB + hstep, voffB); PG8_STAGE(PG8_SA(0, 0), cA, voffA); PG8_STAGE(PG8_SA(0, 1), cA + hstep, voffA);
    if (wr == 1) PG8_BAR;
    PG8_WAIT_V(2); PG8_BAR;
    PG8_STAGE(PG8_SB(1, 0), cB + kstep, voffB); PG8_STAGE(PG8_SA(1, 0), cA + kstep, voffA); PG8_STAGE(PG8_SB(1, 1), cB + hstep + kstep, voffB);
    PG8_WAIT_V(6); PG8_BAR;
    for (;;) {
        const bool has_next = S.next(ui + 1, nxt);
        const char* nA = has_next ? (const char*)g.A + (size_t)nxt.pm * tstep : cA; const char* nB = has_next ? (const char*)g.Bt + (size_t)nxt.pn * tstep : cB;
        for (int t = 0; t < nt; t += 2) {
            const bool last = (t == nt - 2);
            const char* a1 = cA + (size_t)(t + 1) * kstep;
            const char* a2 = last ? nA : cA + (size_t)(t + 2) * kstep; const char* b2 = last ? nB : cB + (size_t)(t + 2) * kstep;
            const char* a3 = a2 + kstep; const char* b3 = b2 + kstep;
            PG8_LDB(B0, 0, 0); PG8_LDB(B1, 0, 1); PG8_SCHED; PG8_LDA(At, 0, 0); PG8_STAGE(PG8_SA(1, 1), a1 + hstep, voffA);
            PG8_WAIT_V(8); PG8_WAIT_L(0); PG8_BAR; PG8_MMA(0, 0, At, B0); PG8_MMA(0, 1, At, B1); PG8_BAR; PG8_SCHED;
            PG8_LDA(At, 0, 1); PG8_STAGE(PG8_SB(0, 0), b2, voffB); PG8_STAGE(PG8_SB(0, 1), b2 + hstep, voffB); PG8_STAGE(PG8_SA(0, 0), a2, voffA);
            PG8_WAIT_V(8); PG8_WAIT_L(0); PG8_BAR; PG8_MMA(1, 0, At, B0); PG8_MMA(1, 1, At, B1); PG8_BAR; PG8_SCHED;
            PG8_LDB(B0, 1, 0); PG8_LDB(B1, 1, 1); PG8_SCHED; PG8_LDA(At, 1, 0); PG8_STAGE(PG8_SA(0, 1), a2 + hstep, voffA);
            PG8_WAIT_V(8); PG8_WAIT_L(0); PG8_BAR; PG8_MMA(0, 0, At, B0); PG8_MMA(0, 1, At, B1); PG8_BAR; PG8_SCHED;
            PG8_LDA(At, 1, 1); PG8_STAGE(PG8_SB(1, 0), b3, voffB); PG8_STAGE(PG8_SB(1, 1), b3 + hstep, voffB); PG8_STAGE(PG8_SA(1, 0), a3, voffA);
            PG8_WAIT_V(8); PG8_WAIT_L(0); PG8_BAR; PG8_MMA(1, 0, At, B0); PG8_MMA(1, 1, At, B1); PG8_BAR; PG8_SCHED;
        }
        if constexpr (ALIGN_EPI) { if (wr == 0) PG8_BAR; }
        E(acc, cur, wr, wc, fr, fq);
        if (!has_next) break;
#pragma unroll
        for (int a = 0; a < 2; ++a)
#pragma unroll
            for (int b = 0; b < 2; ++b)
#pragma unroll
                for (int m = 0; m < 4; ++m)
#pragma unroll
                    for (int n = 0; n < 2; ++n) acc[a][b][m][n] = (f32x4){0.f, 0.f, 0.f, 0.f};
        cur = nxt; cA = nA; cB = nB; ++ui;
        if constexpr (ALIGN_EPI) { if (wr == 1) PG8_BAR; }
    }
    PG8_WAIT_V(0);
    if constexpr (!ALIGN_EPI) { if (wr == 0) PG8_BAR; }
    PG8_BAR;
#undef PG8_SA
#undef PG8_SB
#undef PG8_STAGE
#undef PG8_LDA
#undef PG8_LDB
#undef PG8_MMA
#undef PG8_WAIT_V
#undef PG8_WAIT_L
#undef PG8_BAR
#undef PG8_SCHED
}

DI float row_rstd(const float* rowpart, int row) {
    const f32x4* rp = (const f32x4*)(rowpart + (size_t)row * 16);
    const f32x4 a = rp[0], b = rp[1], c = rp[2], d = rp[3];
    const float s = ((a.x + a.y) + (a.z + a.w)) + ((b.x + b.y) + (b.z + b.w)) + ((c.x + c.y) + (c.z + c.w)) + ((d.x + d.y) + (d.z + d.w));
    return __builtin_amdgcn_rsqf(s * (1.0f / DM) + EPS);
}
DI void row_rstd8(const float* rowpart, int row0, int fq, float (&rs)[2][4]) {
    f32x4 p[2][4];
#pragma unroll
    for (int ai = 0; ai < 2; ++ai)
#pragma unroll
        for (int m = 0; m < 4; ++m) p[ai][m] = *(const f32x4*)(rowpart + (size_t)(row0 + ai * HALF + m * 16) * 16 + 4 * fq);
#pragma unroll
    for (int ai = 0; ai < 2; ++ai)
#pragma unroll
        for (int m = 0; m < 4; ++m) { float s = (p[ai][m].x + p[ai][m].y) + (p[ai][m].z + p[ai][m].w); s += swz_xor<16>(s); s = half_sum(s); rs[ai][m] = __builtin_amdgcn_rsqf(s * (1.0f / DM) + EPS); }
}

struct EpiIn {
    bf16_t* U; const float* rowpart; const float* bias; const float* rope;
    template <int MODE>
    __device__ __forceinline__ void body(const f32x4 (&acc)[2][2][4][2], const Unit& u, int wr, int wc, int fr, int fq, float osc) const {
        const bool isctx = u.pm >= 128; const int bidx = isctx ? 16 : (u.pm >> 3);
        const int colb = u.pn * BM + wc * 32 + 8 * fq;
        const float* bp = bias + (size_t)bidx * NU + colb;
        const int row0 = u.pm * BM + wr * 64 + fr;
        float rs[2][4]; row_rstd8(rowpart, row0, fq, rs);
        f32x4 bv[2][2];
#pragma unroll
        for (int bj = 0; bj < 2; ++bj)
#pragma unroll
            for (int n = 0; n < 2; ++n) bv[bj][n] = *(const f32x4*)(bp + bj * HALF + 4 * n);
        float invf[8];
        if (MODE == 2) {
#pragma unroll
            for (int i = 0; i < 8; ++i) invf[i] = __builtin_amdgcn_exp2f(-(float)(8 * (fq & 1) + i) * 0.8304820237218406f) * 0.15915494309189535f;
        }
#pragma unroll
        for (int it = 0; it < 8; ++it) {
            const int ai = it >> 2, m = it & 3;
            const int row = row0 + ai * HALF + m * 16;
            const float rstd = rs[ai][m];
            float co[8], si[8];
            if (MODE == 2) { const int t_ = row & (SEQ - 1); const float posf = (float)((wc & 1) ? (t_ & 63) : (t_ >> 6));
#pragma unroll
                for (int i = 0; i < 8; ++i) { const float ang = posf * invf[i]; co[i] = __builtin_amdgcn_cosf(ang) * osc; si[i] = __builtin_amdgcn_sinf(ang) * osc; if (fq < 2) si[i] = -si[i]; } }
            bf16_t* rowp = U + (size_t)row * NU + colb;
#pragma unroll
            for (int bj = 0; bj < 2; ++bj) {
                f32x4 v0 = acc[ai][bj][m][0] * rstd + bv[bj][0], v1 = acc[ai][bj][m][1] * rstd + bv[bj][1];
                if (MODE == 2) {
                    float x[8] = {v0[0], v0[1], v0[2], v0[3], v1[0], v1[1], v1[2], v1[3]};
#pragma unroll
                    for (int i = 0; i < 8; ++i) {
                        float p; { auto r_ = __builtin_amdgcn_permlane32_swap(__float_as_uint(x[i]), __float_as_uint(x[i]), false, false); p = __uint_as_float(fq < 2 ? r_[1] : r_[0]); }
                        x[i] = x[i] * co[i] + p * si[i];
                    }
                    v0 = (f32x4){x[0], x[1], x[2], x[3]}; v1 = (f32x4){x[4], x[5], x[6], x[7]};
                }
                if (MODE == 3) { v0 = v0 * osc; v1 = v1 * osc; }
                if (MODE == 1) {
#pragma unroll
                    for (int e = 0; e < 4; ++e) { v0[e] = gelu_tanh(v0[e]); v1[e] = gelu_tanh(v1[e]); } }
                u32x4 w; w.x = cvt_pk_bf16(v0[0], v0[1]); w.y = cvt_pk_bf16(v0[2], v0[3]); w.z = cvt_pk_bf16(v1[0], v1[1]); w.w = cvt_pk_bf16(v1[2], v1[3]);
                *(u32x4*)(rowp + bj * HALF) = w;
            }
        }
    }
    __device__ __forceinline__ void operator()(const f32x4 (&acc)[2][2][4][2], const Unit& u, int wr, int wc, int fr, int fq) const {
        const bool isctx = u.pm >= 128;
        const int kind = (u.pn == 5 || u.pn == 6) ? 1 : ((u.pn == 7 || u.pn == 8) ? 2 : 0);
        const float osc = (kind == 1) ? QSCALE : 1.0f;
        if (kind == 0) { if (u.pn == 1) body<1>(acc, u, wr, wc, fr, fq, 1.0f); else body<0>(acc, u, wr, wc, fr, fq, 1.0f); }
        else if (!isctx) body<2>(acc, u, wr, wc, fr, fq, osc);
        else body<3>(acc, u, wr, wc, fr, fq, osc);
    }
};

struct EpiRes {
    const void* hin_lat; const void* hin_ctx; void* hout_lat; void* hout_ctx; int in_bf16, out_bf16;
    const float* gate;
    bf16_t* HBo; const float* gnext; const float* scnext;
    float* rowpart;
    __device__ __forceinline__ void operator()(const f32x4 (&acc)[2][2][4][2], const Unit& u, int wr, int wc, int fr, int fq) const {
        const bool isctx = u.pm >= 128; const int bidx = isctx ? 16 : (u.pm >> 3);
        const int colb = u.pn * BM + wc * 32 + 8 * fq;
        const int row0 = u.pm * BM + wr * 64 + fr;
        const size_t eoff0 = (size_t)(isctx ? row0 - M_LAT : row0) * DM + colb;
        const char* hi0 = (const char*)(isctx ? hin_ctx : hin_lat) + eoff0 * (in_bf16 ? 2 : 4);
        char* ho0 = (char*)(isctx ? hout_ctx : hout_lat) + eoff0 * (out_bf16 ? 2 : 4);
        u32x4 hq[2][4];
#define EPI_H_LD(it_, slot_) do { const size_t ro_ = (size_t)(((it_) >> 2) * HALF + ((it_) & 3) * 16) * DM; \
            if (in_bf16) { const char* hp_ = hi0 + ro_ * 2; hq[slot_][0] = *(const u32x4*)(hp_); hq[slot_][1] = *(const u32x4*)(hp_ + HALF * 2); } \
            else { const char* hp_ = hi0 + ro_ * 4; hq[slot_][0] = *(const u32x4*)(hp_); hq[slot_][1] = *(const u32x4*)(hp_ + 16); hq[slot_][2] = *(const u32x4*)(hp_ + HALF * 4); hq[slot_][3] = *(const u32x4*)(hp_ + HALF * 4 + 16); } } while (0)
        EPI_H_LD(0, 0); EPI_H_LD(1, 1);
        f32x4 gv[2][2], gm[2][2];
#pragma unroll
        for (int bj = 0; bj < 2; ++bj)
#pragma unroll
            for (int n = 0; n < 2; ++n) {
                gv[bj][n] = *(const f32x4*)(gate + (size_t)bidx * 6144 + colb + bj * HALF + 4 * n);
                if (HBo) { const f32x4 g = *(const f32x4*)(gnext + colb + bj * HALF + 4 * n), sc4 = *(const f32x4*)(scnext + (size_t)bidx * 6144 + colb + bj * HALF + 4 * n); gm[bj][n] = g * (sc4 + 1.0f); }
                else gm[bj][n] = (f32x4){0.f, 0.f, 0.f, 0.f};
            }
#pragma unroll
        for (int it = 0; it < 8; ++it) {
            const int ai = it >> 2, m = it & 3;
            const int roff = ai * HALF + m * 16;
            f32x4 hc[4];
            if (in_bf16) {
#pragma unroll
                for (int bj = 0; bj < 2; ++bj) { const u32x4 w = hq[it & 1][bj]; hc[2 * bj] = (f32x4){bflo(w[0]), bfhi(w[0]), bflo(w[1]), bfhi(w[1])}; hc[2 * bj + 1] = (f32x4){bflo(w[2]), bfhi(w[2]), bflo(w[3]), bfhi(w[3])}; }
            } else {
#pragma unroll
                for (int q = 0; q < 4; ++q) hc[q] = __builtin_bit_cast(f32x4, hq[it & 1][q]);
            }
            if (it + 2 < 8) EPI_H_LD(it + 2, it & 1);
            float ss = 0.f;
#pragma unroll
            for (int bj = 0; bj < 2; ++bj) {
                const f32x4 n0 = hc[2 * bj] + gv[bj][0] * acc[ai][bj][m][0], n1 = hc[2 * bj + 1] + gv[bj][1] * acc[ai][bj][m][1];
                if (out_bf16) { u32x4 w; w.x = cvt_pk_bf16(n0[0], n0[1]); w.y = cvt_pk_bf16(n0[2], n0[3]); w.z = cvt_pk_bf16(n1[0], n1[1]); w.w = cvt_pk_bf16(n1[2], n1[3]);
                    *(u32x4*)(ho0 + ((size_t)roff * DM + bj * HALF) * 2) = w; }
                else { float* ho_ = (float*)(ho0 + ((size_t)roff * DM + bj * HALF) * 4); *(f32x4*)ho_ = n0; *(f32x4*)(ho_ + 4) = n1; }
                ss += (n0[0] * n0[0] + n0[1] * n0[1]) + (n0[2] * n0[2] + n0[3] * n0[3]) + (n1[0] * n1[0] + n1[1] * n1[1]) + (n1[2] * n1[2] + n1[3] * n1[3]);
                if (HBo) { const f32x4 p0 = n0 * gm[bj][0], p1 = n1 * gm[bj][1];
                    u32x4 w; w.x = cvt_pk_bf16(p0[0], p0[1]); w.y = cvt_pk_bf16(p0[2], p0[3]); w.z = cvt_pk_bf16(p1[0], p1[1]); w.w = cvt_pk_bf16(p1[2], p1[3]);
                    *(u32x4*)(HBo + (size_t)(row0 + roff) * DM + colb + bj * HALF) = w; }
            }
            ss += swz_xor<16>(ss); ss = half_sum(ss);
            if (fq == 0) rowpart[(size_t)(row0 + roff) * 16 + u.pn * 4 + wc] = ss;
            asm volatile("" ::: "memory");
        }
#undef EPI_H_LD
    }
};

struct EpiGLU {
    bf16_t* HID; const float* rowpart; const float* bias;
    __device__ __forceinline__ void operator()(const f32x4 (&acc)[2][2][4][2], const Unit& u, int wr, int wc, int fr, int fq) const {
        const bool isctx = u.pm >= 128; const int bidx = isctx ? 16 : (u.pm >> 3);
        const float* bp = bias + (size_t)bidx * NGU + u.pn * BM + wc * 32 + 8 * fq;
        const int row0 = u.pm * BM + wr * 64 + fr;
        float rs[2][4]; row_rstd8(rowpart, row0, fq, rs);
        f32x4 bv[2][2];
#pragma unroll
        for (int bj = 0; bj < 2; ++bj)
#pragma unroll
            for (int n = 0; n < 2; ++n) bv[bj][n] = *(const f32x4*)(bp + bj * HALF + 4 * n);
#pragma unroll
        for (int ai = 0; ai < 2; ++ai)
#pragma unroll
            for (int m = 0; m < 4; ++m) {
                const int row = row0 + ai * HALF + m * 16;
                const float rstd = rs[ai][m];
                u32x4 w;
#pragma unroll
                for (int n = 0; n < 2; ++n)
#pragma unroll
                    for (int hh = 0; hh < 2; ++hh) {
                        const f32x2 ag = {acc[ai][0][m][n][2 * hh], acc[ai][0][m][n][2 * hh + 1]}, au = {acc[ai][1][m][n][2 * hh], acc[ai][1][m][n][2 * hh + 1]};
                        const f32x2 bg = {bv[0][n][2 * hh], bv[0][n][2 * hh + 1]}, bu = {bv[1][n][2 * hh], bv[1][n][2 * hh + 1]};
                        const f32x2 g = ag * rstd + bg, uu = au * rstd + bu;
                        const f32x2 t = g * -1.4426950408889634f;
                        f32x2 d = {__builtin_amdgcn_exp2f(t.x), __builtin_amdgcn_exp2f(t.y)};
                        d = d + 1.0f;
                        const f32x2 r = {__builtin_amdgcn_rcpf(d.x), __builtin_amdgcn_rcpf(d.y)};
                        const f32x2 o = (g * r) * uu;
                        w[2 * n + hh] = cvt_pk_bf16(o.x, o.y);
                    }
                *(u32x4*)(HID + (size_t)row * DFF + u.pn * HALF + wc * 32 + 8 * fq) = w;
            }
    }
};
}

DI void transpose_item(const float* W, int ldw, int col0, bf16_t* WT, int K, int dstrow0, int k0, LAS float* scr, int lane) {
    f32x4 v[8];
#pragma unroll
    for (int i = 0; i < 8; ++i) { const int kk = 8 * i + (lane >> 3); v[i] = *(const f32x4*)(W + (size_t)(k0 + kk) * ldw + col0 + (lane & 7) * 4); }
#pragma unroll
    for (int i = 0; i < 8; ++i) { const int kk = 8 * i + (lane >> 3); LAS float* d = scr + kk * 33 + (lane & 7) * 4; d[0] = v[i].x; d[1] = v[i].y; d[2] = v[i].z; d[3] = v[i].w; }
    LDS_WAIT();
    const int c = lane & 7;
#pragma unroll
    for (int j = 0; j < 4; ++j) { const int n = (lane >> 3) + 8 * j; const LAS float* s = scr + (8 * c) * 33 + n;
        u32x4 o; o.x = f2bf(s[0]) | (f2bf(s[33]) << 16); o.y = f2bf(s[2 * 33]) | (f2bf(s[3 * 33]) << 16); o.z = f2bf(s[4 * 33]) | (f2bf(s[5 * 33]) << 16); o.w = f2bf(s[6 * 33]) | (f2bf(s[7 * 33]) << 16);
        *(u32x4*)(WT + (size_t)(dstrow0 + n) * K + k0 + 8 * c) = o; }
    LDS_WAIT();
}

DI void split_bf16x8(const float (&x)[8], bf16x8& h, bf16x8& r) {
    u32x4 hh, rr;
#pragma unroll
    for (int j = 0; j < 4; ++j) { const unsigned h0 = f2bf(x[2 * j]), h1 = f2bf(x[2 * j + 1]); hh[j] = h0 | (h1 << 16);
        rr[j] = f2bf(x[2 * j] - bf2f(h0)) | (f2bf(x[2 * j + 1] - bf2f(h1)) << 16); }
    h = __builtin_bit_cast(bf16x8, hh); r = __builtin_bit_cast(bf16x8, rr);
}
DI void gemv17(LAS float* A, LAS float* red, const float* W, int ldw, int col0, int ncols, float* out, int ldo, int oc0, const float* addv, int tid) {
    const int lane = tid & 63, ks = __builtin_amdgcn_readfirstlane(tid >> 6), r32 = lane & 31, hi = lane >> 5;
    f32x16 c0 = {}, c1 = {};
    const int cA = (r32 < ncols ? r32 : 0), cB = (32 + r32 < ncols ? 32 + r32 : 0);
    const float* wp = W + (size_t)(ks * 128 + 8 * hi) * ldw + col0;
    const LAS float* ap = A + (r32 < 17 ? r32 : 0) * 1024 + ks * 128 + hi * 8;
    for (int kk = 0; kk < 8; ++kk) {
        float av[8], w0[8], w1[8];
        { const f32x4 a0 = *(const LAS f32x4*)(ap + kk * 16), a1 = *(const LAS f32x4*)(ap + kk * 16 + 4);
          const bool live = r32 < 17;
#pragma unroll
          for (int j = 0; j < 4; ++j) { av[j] = live ? a0[j] : 0.f; av[4 + j] = live ? a1[j] : 0.f; } }
#pragma unroll
        for (int j = 0; j < 8; ++j) { const float* wr = wp + (size_t)(kk * 16 + j) * ldw; w0[j] = wr[cA]; w1[j] = wr[cB]; }
        bf16x8 ah, al, w0h, w0l, w1h, w1l;
        split_bf16x8(av, ah, al); split_bf16x8(w0, w0h, w0l); split_bf16x8(w1, w1h, w1l);
        c0 = __builtin_amdgcn_mfma_f32_32x32x16_bf16(ah, w0h, c0, 0, 0, 0); c1 = __builtin_amdgcn_mfma_f32_32x32x16_bf16(ah, w1h, c1, 0, 0, 0);
        c0 = __builtin_amdgcn_mfma_f32_32x32x16_bf16(ah, w0l, c0, 0, 0, 0); c1 = __builtin_amdgcn_mfma_f32_32x32x16_bf16(ah, w1l, c1, 0, 0, 0);
        c0 = __builtin_amdgcn_mfma_f32_32x32x16_bf16(al, w0h, c0, 0, 0, 0); c1 = __builtin_amdgcn_mfma_f32_32x32x16_bf16(al, w1h, c1, 0, 0, 0);
    }
#pragma unroll
    for (int r = 0; r < 16; ++r) { const int row = crow(r, hi); if (row < 17) { red[(ks * 17 + row) * 64 + r32] = c0[r]; red[(ks * 17 + row) * 64 + 32 + r32] = c1[r]; } }
    __syncthreads();
    for (int o = tid; o < 17 * 64; o += 512) { const int b = o >> 6, cc = o & 63;
        if (cc < ncols) { float s_ = 0.f;
#pragma unroll
            for (int k = 0; k < 8; ++k) s_ += red[(k * 17 + b) * 64 + cc];
            if (addv) s_ += addv[cc];
            out[(size_t)b * ldo + oc0 + cc] = s_; } }
    __syncthreads();
}


#define PRB_T0() const unsigned long long prb_t0_ = (PROBE_SEC_A | PROBE_SEC_B) ? __builtin_amdgcn_s_memrealtime() : 0ull
#define PRB_ADD(sec, wsptr) do { if ((PROBE_SEC_A | PROBE_SEC_B) != 0 && blockIdx.x == PROBE_BLOCK && tid_u == 0) { const unsigned long long d_ = __builtin_amdgcn_s_memrealtime() - prb_t0_; \
        unsigned long long* pa_ = (unsigned long long*)((wsptr) + 32768); if ((sec) == PROBE_SEC_A) pa_[40] += d_; if ((sec) == PROBE_SEC_B) pa_[41] += d_; } } while (0)
DI int swz128(int row, int piece) { return row * 128 + ((piece ^ ((row >> 1) & 7)) << 4); }
DI int tr64_st(int k, int c) { const int kk = (k & ~0xC) | ((k & 4) << 1) | ((k & 8) >> 1); return ((kk >> 3) * 2 + (c >> 5)) * 512 + ((kk & 7) * 32 + (c & 31)) * 2; }
DI int tr_rd_base(int lane) { return ((lane & 3) << 3) | (((lane >> 2) & 3) << 6) | (((lane >> 4) & 1) << 5) | (((lane >> 5) & 1) << 8); }
template <int OFF> DI s16x4 tr_read_g(int vb) { s16x4 r; asm volatile("ds_read_b64_tr_b16 %0, %1 offset:%2" : "=&v"(r) : "v"(vb), "i"(OFF) : "memory"); return r; }
#define PKV(L, H) (bf16x8){L[0], L[1], L[2], L[3], H[0], H[1], H[2], H[3]}
#define PK4G(P, BASE, OUT) do { unsigned a0 = cvt_pk_bf16(P[BASE + 0], P[BASE + 1]), a1 = cvt_pk_bf16(P[BASE + 2], P[BASE + 3]);   \
    unsigned b0 = cvt_pk_bf16(P[BASE + 4], P[BASE + 5]), b1 = cvt_pk_bf16(P[BASE + 6], P[BASE + 7]);                              \
    auto r0 = __builtin_amdgcn_permlane32_swap(a0, b0, false, false); auto r1 = __builtin_amdgcn_permlane32_swap(a1, b1, false, false); \
    u32x4 w = {r0[0], r1[0], r0[1], r1[1]}; OUT = __builtin_bit_cast(bf16x8, w); } while (0)

DI void rg_unit(const KA a, LAS unsigned char* lds, int l, int b, int hd, int half, int tid_in) {
    const int tid_u = launder(tid_in);
    const int lane_u = tid_u & 63, wid = __builtin_amdgcn_readfirstlane(tid_u >> 6);
    LAS unsigned char* XCT = lds;
    LAS float* AA = (LAS float*)(lds + 32768);
    LAS float* BX = (LAS float*)(lds + 65536);
    LAS bf16_t* GT = (LAS bf16_t*)(lds + 98304);
    LAS bf16_t* RT = (LAS bf16_t*)(lds + 114688);
    LAS float* SUB = (LAS float*)(lds + 131072);
    LAS float* START = SUB + 1024;
    LAS float* CARRY = START + 512;
    unsigned char* ws = a.ws();
    const bf16_t* U = (const bf16_t*)(ws + WS_U); const bf16_t* XC = (const bf16_t*)(ws + WS_XC); bf16_t* RGS = (bf16_t*)(ws + WS_RGS); bf16_t* MIX = (bf16_t*)(ws + WS_MIX);
    const int chb = hd * 64 + 32 * half;
    PRB_T0(); const unsigned long long prb_unit0_ = prb_t0_;
    for (int dir = 0; dir < 2; ++dir) {
        const int cj = 32 * half + (lane_u & 31), hi0 = lane_u >> 5;
        const float* wa = a.in(I_RGWA) + (size_t)((l * 2 + dir) * 4 + hd) * 4096;
        const float* wx = a.in(I_RGWX) + (size_t)((l * 2 + dir) * 4 + hd) * 4096;
        bf16x8 wfa[4], wfx[4];
#pragma unroll
        for (int ks = 0; ks < 4; ++ks) {
            u32x4 pa, px;
#pragma unroll
            for (int jj = 0; jj < 4; ++jj) { const int i0 = 16 * ks + 8 * hi0 + 2 * jj;
                pa[jj] = f2bf(wa[i0 * 64 + cj]) | (f2bf(wa[(i0 + 1) * 64 + cj]) << 16);
                px[jj] = f2bf(wx[i0 * 64 + cj]) | (f2bf(wx[(i0 + 1) * 64 + cj]) << 16); }
            wfa[ks] = __builtin_bit_cast(bf16x8, pa); wfx[ks] = __builtin_bit_cast(bf16x8, px);
        }
        const float ba = a.in(I_RGBA)[(size_t)(l * 2 + dir) * 256 + hd * 64 + cj], bxb = a.in(I_RGBX)[(size_t)(l * 2 + dir) * 256 + hd * 64 + cj];
        const float sp8 = -8.0f * softplusf_(-a.in(I_RGLAM)[(size_t)(l * 2 + dir) * 256 + hd * 64 + cj]);
        if (tid_u < 32) CARRY[tid_u] = 0.f;
#define RG_ROWBASE(blk) ((blk) == 0 ? M_LAT + b * CTXL : b * SEQ + (dir ? 8 - (blk) : (blk) - 1) * 256)
#define RG_DMA_XC(blk) do { const int rb_ = RG_ROWBASE(blk); _Pragma("unroll") for (int k_ = 0; k_ < 4; ++k_) { const int row_ = 8 * (4 * wid + k_) + (lane >> 3), pc_ = (lane & 7) ^ ((row_ >> 1) & 7); \
            __builtin_amdgcn_global_load_lds((const unsigned*)(XC + (size_t)(rb_ + row_) * 256 + hd * 64 + 8 * pc_), (LAS unsigned*)(XCT + (4 * wid + k_) * 1024), 16, 0, 0); } } while (0)
        { const int lane = lane_u; RG_DMA_XC(0); }
        for (int blk = 0; blk < 9; ++blk) {
            const int lane = launder(lane_u), r32 = lane & 31, hi = lane >> 5, tid = wid * 64 + lane, c = tid & 31, s = tid >> 5;
            const int rowbase = RG_ROWBASE(blk);
            const bool need = (blk != 0) || (l == 0);
            { PRB_T0();
            if (blk == 0) asm volatile("s_waitcnt vmcnt(0)" ::: "memory");
            __syncthreads();
            PRB_ADD(11, ws); }
            if (dir == 1 && need) {
#pragma unroll
                for (int k = 0; k < 2; ++k) { const int row = 16 * (2 * wid + k) + (lane >> 2), pc = lane & 3;
                    __builtin_amdgcn_global_load_lds((const unsigned*)(U + (size_t)(rowbase + row) * NU + C_RGG + chb + 8 * pc), (LAS unsigned*)((LAS unsigned char*)GT + (2 * wid + k) * 1024), 16, 0, 0);
                    __builtin_amdgcn_global_load_lds((const unsigned*)(RGS + (size_t)(rowbase + row) * 256 + chb + 8 * pc), (LAS unsigned*)((LAS unsigned char*)RT + (2 * wid + k) * 1024), 16, 0, 0); }
            }
            float av[16], bxv[16];
            { PRB_T0();
            { f32x16 za = {}, zx = {}; const int row = 32 * wid + 16 * ((r32 >> 2) & 1) + 4 * (r32 >> 3) + (r32 & 3);
              bf16x8 af[4]; float xcv[16];
#pragma unroll
              for (int ks = 0; ks < 4; ++ks) af[ks] = *(const LAS bf16x8*)(XCT + swz128(row, 2 * ks + hi));
#pragma unroll
              for (int i = 0; i < 16; ++i) { const int tt = 32 * wid + 16 * hi + i; xcv[i] = bf2f(*(const LAS bf16_t*)(XCT + swz128(tt, cj >> 3) + (cj & 7) * 2)); }
              LDS_WAIT(); __syncthreads();
              if (blk + 1 < 9) RG_DMA_XC(blk + 1);
#pragma unroll
              for (int ks = 0; ks < 4; ++ks) { za = __builtin_amdgcn_mfma_f32_32x32x16_bf16(af[ks], wfa[ks], za, 0, 0, 0); zx = __builtin_amdgcn_mfma_f32_32x32x16_bf16(af[ks], wfx[ks], zx, 0, 0, 0); }
#pragma unroll
              for (int i = 0; i < 16; ++i) {
                  const float ea = 1.0f + __expf(-(za[i] + ba)), ex = 1.0f + __expf(-(zx[i] + bxb)); const float inv = rcpf_(ea * ex);
                  const float r = inv * ex, ig = inv * ea;
                  const float la = sp8 * r;
                  const float a_ = __expf(la); av[i] = a_; bxv[i] = __builtin_amdgcn_sqrtf(fmaxf(1.0f - a_ * a_, 0.f)) * (ig * xcv[i]); } }
            PRB_ADD(12, ws); }
            { PRB_T0();
            { float Ap = 1.f, Hh = 0.f;
              if (dir == 0) {
#pragma unroll
                  for (int k = 0; k < 16; ++k) { Hh = av[k] * Hh + bxv[k]; Ap *= av[k]; }
              } else {
#pragma unroll
                  for (int k = 15; k >= 0; --k) { Hh = av[k] * Hh + bxv[k]; Ap *= av[k]; }
              }
              SUB[(s * 32 + c) * 2] = Ap; SUB[(s * 32 + c) * 2 + 1] = Hh; }
            __syncthreads();
            PRB_ADD(13, ws); }
            { PRB_T0();
            if (tid < 32) { float carry = CARRY[tid];
#pragma unroll
                for (int si = 0; si < 16; ++si) { const int s2 = dir ? 15 - si : si; START[s2 * 32 + tid] = carry; carry = SUB[(s2 * 32 + tid) * 2] * carry + SUB[(s2 * 32 + tid) * 2 + 1]; }
                CARRY[tid] = carry; }
            asm volatile("s_waitcnt vmcnt(0)" ::: "memory");
            __syncthreads();
            PRB_ADD(14, ws); }
            { PRB_T0();
            { float h = START[s * 32 + c];
#define RG_APPLY(k) do { const int tt = 16 * s + (k); h = av[k] * h + bxv[k]; \
                  if (need) { const size_t row = (size_t)(rowbase + tt); \
                      if (dir == 0) RGS[row * 256 + chb + c] = (bf16_t)cvt_pk_bf16(h, h); \
                      else { const float y = (bf2f(RT[tt * 32 + c]) + h) * bf2f(GT[tt * 32 + c]); MIX[row * DM + chb + c] = (bf16_t)cvt_pk_bf16(y, y); } } } while (0)
              if (dir == 0) {
#pragma unroll
                  for (int k = 0; k < 16; ++k) RG_APPLY(k);
              } else {
#pragma unroll
                  for (int k = 15; k >= 0; --k) RG_APPLY(k);
              }
#undef RG_APPLY
            }
            PRB_ADD(15, ws); }
        }
        asm volatile("s_waitcnt vmcnt(0)" ::: "memory"); __syncthreads();
#undef RG_ROWBASE
#undef RG_DMA_XC
    }
    { const unsigned long long prb_t0_ = prb_unit0_; PRB_ADD(16, ws); }
}

DI void ssd_unit(const KA a, LAS unsigned char* lds, int l, int b, int head, int dir, int tid_in) {
    const int tid_u = launder(tid_in);
    const int lane_u = tid_u & 63, wid = __builtin_amdgcn_readfirstlane(tid_u >> 6);
    LAS unsigned char* BD = lds + 98304; LAS unsigned char* HL = lds + 114688;
    unsigned char* ws = a.ws();
    const bf16_t* XA = (const bf16_t*)(ws + WS_XBCA); const float* CS = (const float*)(ws + WS_CS); const float* DTS = (const float*)(ws + WS_DTS);
    float* YS = (float*)(ws + WS_HB) + (size_t)dir * M_ALL * 256;
    const int grp = head >> 1, j8 = dir * 4 + head;
    const int lb = wid >> 1, ph = wid & 1;
    const int pb = (wid >> 1) & 1, nb = wid & 1;
    f32x16 Hreg = {};
    for (int i = tid_u; i < 2048; i += 512) ((LAS unsigned*)HL)[i] = 0u;
#define SSD_CHUNK(c) ((c) < 2 ? 256 + b * 2 + (dir ? 1 - (c) : (c)) : b * 16 + (dir ? 17 - (c) : (c) - 2))
#define SSD_DMA(c, buf) do { const int ci_ = SSD_CHUNK(c); const int row0_ = 128 * ci_; LAS unsigned char* db_ = lds + (buf) * 49152; \
        _Pragma("unroll") for (int e_ = 0; e_ < 2; ++e_) { \
            { const int srow_ = 8 * (2 * wid + e_) + (lane >> 3), pc_ = (lane & 7) ^ ((srow_ >> 1) & 7); const int grow_ = dir ? row0_ + 127 - srow_ : row0_ + srow_; \
              const bf16_t* src_ = XA + (size_t)grow_ * 512 + 256 + grp * 64 + 8 * pc_; \
              __builtin_amdgcn_global_load_lds((const unsigned*)src_, (LAS unsigned*)(db_ + (2 * wid + e_) * 1024), 16, 0, 0); \
              __builtin_amdgcn_global_load_lds((const unsigned*)(src_ + 128), (LAS unsigned*)(db_ + 16384 + (2 * wid + e_) * 1024), 16, 0, 0); } \
            { const int kk_ = 8 * (2 * wid + e_) + ((lane & 31) >> 2), k_ = (kk_ & ~0xC) | ((kk_ & 4) << 1) | ((kk_ & 8) >> 1), col_ = (lane >> 5) * 32 + (lane & 3) * 8; \
              const int grow_ = dir ? row0_ + 127 - k_ : row0_ + k_; \
              __builtin_amdgcn_global_load_lds((const unsigned*)(XA + (size_t)grow_ * 512 + head * 64 + col_), (LAS unsigned*)(db_ + 32768 + (2 * wid + e_) * 1024), 16, 0, 0); } } \
        if (wid < 4) { const float* sp_ = (wid < 2 ? CS : DTS) + ((size_t)ci_ * 8 + j8) * 128 + 64 * (wid & 1) + lane; \
            __builtin_amdgcn_global_load_lds((const unsigned*)sp_, (LAS unsigned*)(lds + 122880 + (buf) * 1024 + (wid >> 1) * 512 + (wid & 1) * 256), 4, 0, 0); } } while (0)
    PRB_T0(); const unsigned long long prb_unit0_ = prb_t0_;
    { const int lane = lane_u; SSD_DMA(0, 0); }
    for (int c = 0; c < 18; ++c) {
        const int lane = launder(lane_u), r32 = lane & 31, hi = lane >> 5, tid = wid * 64 + lane;
        const int buf = c & 1;
        { PRB_T0();
        if (c == 0) asm volatile("s_waitcnt vmcnt(0)" ::: "memory");
        __syncthreads();
        if (c + 1 < 18) SSD_DMA(c + 1, buf ^ 1);
        PRB_ADD(1, ws); }
        LAS unsigned char* BT = lds + buf * 49152; LAS unsigned char* CT = BT + 16384; LAS unsigned char* XT = BT + 32768;
        const LAS float* CSL = (const LAS float*)(lds + 122880 + buf * 1024); const LAS float* DTL = CSL + 128;
        const int row0 = 128 * SSD_CHUNK(c);
        const float cs_end = CSL[127];
        { PRB_T0();
#pragma unroll
        for (int e = 0; e < 2; ++e) { const int q = tid + 512 * e, sr = q >> 3, p8 = q & 7;
            const u32x4 x = *(const LAS u32x4*)(BT + swz128(sr, p8)); const float f = __expf(cs_end - CSL[sr]) * DTL[sr];
            u32x4 w;
#pragma unroll
            for (int t = 0; t < 4; ++t) w[t] = cvt_pk_bf16(bflo(x[t]) * f, bfhi(x[t]) * f);
            *(LAS u32x4*)(BD + tr64_st(sr, 8 * p8)) = w; }
        __syncthreads();
        PRB_ADD(2, ws); }
        { PRB_T0();
        {
            f32x16 accy = {}, acco = {};
            const float cs_l = CSL[32 * lb + r32];
            const int xb = (int)(uintptr_t)XT + tr_rd_base(lane) + ph * 512;
            for (int sb = 0; sb <= lb; ++sb) {
                f32x16 g = {};
#pragma unroll
                for (int ks = 0; ks < 4; ++ks) { const bf16x8 bf = *(const LAS bf16x8*)(BT + swz128(32 * sb + r32, 2 * ks + hi)); const bf16x8 cf = *(const LAS bf16x8*)(CT + swz128(32 * lb + r32, 2 * ks + hi));
                    g = __builtin_amdgcn_mfma_f32_32x32x16_bf16(bf, cf, g, 0, 0, 0); }
#pragma unroll
                for (int r = 0; r < 16; ++r) { const int sl = crow(r, hi); const float f = __expf(cs_l - CSL[32 * sb + sl]) * DTL[32 * sb + sl];
                    g[r] = (sb < lb || sl <= r32) ? g[r] * f : 0.f; }
                bf16x8 pa0, pa1; PK4G(g, 0, pa0); PK4G(g, 8, pa1);
                const int xs = xb + sb * 4096;
                const s16x4 l0 = tr_read_g<0>(xs), h0 = tr_read_g<1024>(xs), l1 = tr_read_g<2048>(xs), h1 = tr_read_g<3072>(xs);
                asm volatile("s_waitcnt lgkmcnt(0)" ::: "memory"); __builtin_amdgcn_sched_barrier(0);
                accy = __builtin_amdgcn_mfma_f32_32x32x16_bf16(pa0, PKV(l0, h0), accy, 0, 0, 0);
                accy = __builtin_amdgcn_mfma_f32_32x32x16_bf16(pa1, PKV(l1, h1), accy, 0, 0, 0);
            }
#pragma unroll
            for (int ks = 0; ks < 4; ++ks) { const bf16x8 cf = *(const LAS bf16x8*)(CT + swz128(32 * lb + r32, 2 * ks + hi)); const bf16x8 hf = *(const LAS bf16x8*)(HL + swz128(32 * ph + r32, 2 * ks + hi));
                acco = __builtin_amdgcn_mfma_f32_32x32x16_bf16(cf, hf, acco, 0, 0, 0); }
            asm volatile("s_waitcnt vmcnt(0)" ::: "memory");
            if (c >= 2 || l == 0) {
#pragma unroll
                for (int r = 0; r < 16; ++r) { const int ll = 32 * lb + crow(r, hi); const int grow = dir ? row0 + 127 - ll : row0 + ll;
                    YS[(size_t)grow * 256 + head * 64 + 32 * ph + r32] = accy[r] + __expf(CSL[ll]) * acco[r]; }
            }
        }
        PRB_ADD(3, ws); }
        { PRB_T0();
        if (wid < 4) {
            f32x16 sacc = {};
            const int xa = (int)(uintptr_t)XT + tr_rd_base(lane) + pb * 512, xbd = (int)(uintptr_t)BD + tr_rd_base(lane) + nb * 512;
#pragma unroll
            for (int kq = 0; kq < 4; ++kq) {
                const s16x4 al0 = tr_read_g<0>(xa + kq * 4096), ah0 = tr_read_g<1024>(xa + kq * 4096), al1 = tr_read_g<2048>(xa + kq * 4096), ah1 = tr_read_g<3072>(xa + kq * 4096);
                const s16x4 bl0 = tr_read_g<0>(xbd + kq * 4096), bh0 = tr_read_g<1024>(xbd + kq * 4096), bl1 = tr_read_g<2048>(xbd + kq * 4096), bh1 = tr_read_g<3072>(xbd + kq * 4096);
                asm volatile("s_waitcnt lgkmcnt(0)" ::: "memory"); __builtin_amdgcn_sched_barrier(0);
                sacc = __builtin_amdgcn_mfma_f32_32x32x16_bf16(PKV(al0, ah0), PKV(bl0, bh0), sacc, 0, 0, 0);
                sacc = __builtin_amdgcn_mfma_f32_32x32x16_bf16(PKV(al1, ah1), PKV(bl1, bh1), sacc, 0, 0, 0);
            }
            const float e_end = __expf(cs_end);
#pragma unroll
            for (int r = 0; r < 16; ++r) Hreg[r] = e_end * Hreg[r] + sacc[r];
        }
        __syncthreads();
        if (wid < 4) { const int n = 32 * nb + r32;
#pragma unroll
            for (int r = 0; r < 16; ++r) { const int p = 32 * pb + crow(r, hi); *(LAS bf16_t*)(HL + swz128(p, n >> 3) + (n & 7) * 2) = (bf16_t)f2bf(Hreg[r]); } }
        PRB_ADD(4, ws); }
    }
    { const unsigned long long prb_t0_ = prb_unit0_; PRB_ADD(5, ws); }
    asm volatile("s_waitcnt vmcnt(0)" ::: "memory"); __syncthreads();
    if (tid_u == 0) { __builtin_amdgcn_fence(__ATOMIC_RELEASE, "agent"); asm volatile("s_waitcnt vmcnt(0)" ::: "memory");
        __hip_atomic_fetch_add((unsigned*)(ws + WS_SSDCNT) + (l * 16 + b) * 64, 1u, __ATOMIC_RELAXED, __HIP_MEMORY_SCOPE_AGENT); }
#undef SSD_CHUNK
#undef SSD_DMA
}

template <int R> DI void ssd_combine_rows(const KA a, int l, int row0, int rstep, int nrows, int lane) {
    unsigned char* ws = a.ws();
    const bf16_t* U = (const bf16_t*)(ws + WS_U); const bf16_t* XA = (const bf16_t*)(ws + WS_XBCA); const float* YS = (const float*)(ws + WS_HB); bf16_t* MIX = (bf16_t*)(ws + WS_MIX);
    const int ch = 4 * lane, head = lane >> 4;
    u32x2 xx[R], zz[R]; f32x4 yf[R], yb[R];
#pragma unroll
    for (int r = 0; r < R; ++r) { const int row = row0 + r * rstep; if (row < nrows) {
        xx[r] = *(const u32x2*)(XA + (size_t)row * 512 + ch); zz[r] = *(const u32x2*)(U + (size_t)row * NU + C_SZ + ch);
        yf[r] = *(const f32x4*)(YS + (size_t)row * 256 + ch); yb[r] = *(const f32x4*)(YS + (size_t)M_ALL * 256 + (size_t)row * 256 + ch); } }
    const float dsk = a.in(I_SD)[l * 4 + head];
    const f32x4 g = *(const f32x4*)(a.in(I_SNG) + (size_t)l * 256 + ch);
#pragma unroll
    for (int r = 0; r < R; ++r) { const int row = row0 + r * rstep; if (row < nrows) {
        const float xv[4] = {bflo(xx[r][0]), bfhi(xx[r][0]), bflo(xx[r][1]), bfhi(xx[r][1])};
        const float z[4] = {bflo(zz[r][0]), bfhi(zz[r][0]), bflo(zz[r][1]), bfhi(zz[r][1])};
        float o[4]; float ss = 0.f;
#pragma unroll
        for (int e = 0; e < 4; ++e) { const float y = xv[e] * dsk + yf[r][e] + yb[r][e]; o[e] = y * siluf_(z[e]); ss += o[e] * o[e]; }
        ss = sum32(ss);
        const float rs = __builtin_amdgcn_rsqf(ss * (1.0f / 128.0f) + EPS);
        u32x2 w; w.x = cvt_pk_bf16(o[0] * rs * g[0], o[1] * rs * g[1]); w.y = cvt_pk_bf16(o[2] * rs * g[2], o[3] * rs * g[3]);
        *(u32x2*)(MIX + (size_t)row * DM + 256 + ch) = w; } }
}

DI void preconv_rows(const KA a, int l, int gw, int NGW, int lane) {
    unsigned char* ws = a.ws();
    const bf16_t* U = (const bf16_t*)(ws + WS_U); bf16_t* XA = (bf16_t*)(ws + WS_XBCA); bf16_t* XC = (bf16_t*)(ws + WS_XC);
    float ws8[4][8], bs8[8], wr4[4][4], br4[4];
#pragma unroll
    for (int j = 0; j < 4; ++j) { const f32x4 w0 = *(const f32x4*)(a.in(I_SCW) + (size_t)l * 2048 + j * 512 + 8 * lane), w1 = *(const f32x4*)(a.in(I_SCW) + (size_t)l * 2048 + j * 512 + 8 * lane + 4);
        const f32x4 r0 = *(const f32x4*)(a.in(I_RGCW) + (size_t)l * 1024 + j * 256 + 4 * lane);
#pragma unroll
        for (int e = 0; e < 4; ++e) { ws8[j][e] = w0[e]; ws8[j][4 + e] = w1[e]; wr4[j][e] = r0[e]; } }
    { const f32x4 b0 = *(const f32x4*)(a.in(I_SCB) + (size_t)l * 512 + 8 * lane), b1 = *(const f32x4*)(a.in(I_SCB) + (size_t)l * 512 + 8 * lane + 4), r0 = *(const f32x4*)(a.in(I_RGCB) + (size_t)l * 256 + 4 * lane);
#pragma unroll
      for (int e = 0; e < 4; ++e) { bs8[e] = b0[e]; bs8[4 + e] = b1[e]; br4[e] = r0[e]; } }
    for (int row0 = gw; row0 < M_ALL; row0 += 2 * NGW) {
        u32x4 x[2][4]; u32x2 y[2][4];
#pragma unroll
        for (int q = 0; q < 2; ++q) { const int row = row0 + q * NGW; if (row < M_ALL) {
            const bool isctx = row >= M_LAT; const int t = isctx ? (row - M_LAT) & (CTXL - 1) : row & (SEQ - 1); const int seglen = isctx ? CTXL : SEQ;
#pragma unroll
            for (int j = 0; j < 4; ++j) { const int ts = t + j - 2; x[q][j] = (u32x4){0u, 0u, 0u, 0u}; y[q][j] = (u32x2){0u, 0u};
                if (ts >= 0 && ts < seglen) { const bf16_t* up = U + (size_t)(row + j - 2) * NU; x[q][j] = *(const u32x4*)(up + C_XBC + 8 * lane); y[q][j] = *(const u32x2*)(up + C_RGX + 4 * lane); } } } }
#pragma unroll
        for (int q = 0; q < 2; ++q) { const int row = row0 + q * NGW; if (row < M_ALL) {
            float v[8], r[4];
#pragma unroll
            for (int e = 0; e < 8; ++e) v[e] = bs8[e];
#pragma unroll
            for (int e = 0; e < 4; ++e) r[e] = br4[e];
#pragma unroll
            for (int j = 0; j < 4; ++j) {
#pragma unroll
                for (int e = 0; e < 4; ++e) { v[2 * e] += ws8[j][2 * e] * bflo(x[q][j][e]); v[2 * e + 1] += ws8[j][2 * e + 1] * bfhi(x[q][j][e]); }
                r[0] += wr4[j][0] * bflo(y[q][j][0]); r[1] += wr4[j][1] * bfhi(y[q][j][0]); r[2] += wr4[j][2] * bflo(y[q][j][1]); r[3] += wr4[j][3] * bfhi(y[q][j][1]); }
            u32x4 w;
#pragma unroll
            for (int e = 0; e < 4; ++e) w[e] = cvt_pk_bf16(siluf_(v[2 * e]), siluf_(v[2 * e + 1]));
            *(u32x4*)(XA + (size_t)row * 512 + 8 * lane) = w;
            u32x2 w2; w2.x = cvt_pk_bf16(r[0], r[1]); w2.y = cvt_pk_bf16(r[2], r[3]);
            *(u32x2*)(XC + (size_t)row * 256 + 4 * lane) = w2; } }
    }
}
DI void ssd_chunk_scan(const KA a, int l, int ci, int lane) {
    unsigned char* ws = a.ws();
    const float* DT = (const float*)(ws + WS_DT); float* CS = (float*)(ws + WS_CS); float* DTS = (float*)(ws + WS_DTS);
    const int row0 = 128 * ci;
    const f32x4 d00 = *(const f32x4*)(DT + (size_t)(row0 + 2 * lane) * 8), d01 = *(const f32x4*)(DT + (size_t)(row0 + 2 * lane) * 8 + 4);
    const f32x4 d10 = *(const f32x4*)(DT + (size_t)(row0 + 2 * lane + 1) * 8), d11 = *(const f32x4*)(DT + (size_t)(row0 + 2 * lane + 1) * 8 + 4);
    const float dt0[8] = {d00[0], d00[1], d00[2], d00[3], d01[0], d01[1], d01[2], d01[3]}, dt1[8] = {d10[0], d10[1], d10[2], d10[3], d11[0], d11[1], d11[2], d11[3]};
#pragma unroll
    for (int j = 0; j < 8; ++j) {
        const float an = -__expf(a.in(I_SALOG)[l * 8 + j]);
        const float a0 = dt0[j] * an, a1 = dt1[j] * an;
        float incl = a0 + a1;
#pragma unroll
        for (int d = 1; d < 64; d <<= 1) { const float o = __builtin_bit_cast(float, __builtin_amdgcn_ds_bpermute((lane - d) << 2, __builtin_bit_cast(int, incl))); if (lane >= d) incl += o; }
        const float excl = incl - (a0 + a1);
        float* cs = CS + ((size_t)ci * 8 + j) * 128; float* ds = DTS + ((size_t)ci * 8 + j) * 128;
        if (j < 4) { cs[2 * lane] = excl + a0; cs[2 * lane + 1] = incl; ds[2 * lane] = dt0[j]; ds[2 * lane + 1] = dt1[j]; }
        else { const float tot = __builtin_bit_cast(float, __builtin_amdgcn_readlane(__builtin_bit_cast(int, incl), 63));
            cs[127 - 2 * lane] = tot - excl; cs[126 - 2 * lane] = tot - excl - a0; ds[127 - 2 * lane] = dt0[j]; ds[126 - 2 * lane] = dt1[j]; }
    }
}

namespace att {
constexpr int SHM_V = 16384, SHM_K = 16384;
constexpr float THR = 8.0f;
#define KSWZ(row, colB) ((row) * 256 + ((colB) ^ (((row) & 15) << 4)))
#define SBAR() __builtin_amdgcn_sched_barrier(0)
DI int v_st(int k, int c) { const int kk = (k & ~0xC) | ((k & 4) << 1) | ((k & 8) >> 1); return ((kk >> 3) * 4 + (c >> 5)) * 512 + ((kk & 7) * 32 + (c & 31)) * 2; }
DI int v_rd_base(int lane) { return ((lane & 3) << 3) | (((lane >> 2) & 3) << 6) | (((lane >> 4) & 1) << 5) | (((lane >> 5) & 1) << 8); }
constexpr int v_rd_off(int d0, int ks, int half) { return d0 * 512 + ks * 4096 + half * 2048; }
template <int OFF> DI s16x4 tr_read(int vb) { s16x4 r; asm volatile("ds_read_b64_tr_b16 %0, %1 offset:%2" : "=&v"(r) : "v"(vb), "i"(OFF) : "memory"); return r; }

template <int C> DI void qkt(f32x16& p0, f32x16& p1, const LAS char* Ks, const LAS char* Qs, int r32, int hi) {
    p0 = f32x16{}; p1 = f32x16{};
#pragma unroll
    for (int d = 0; d < 4; ++d) { const int d0 = 4 * C + d; const int cb = (d0 * 16 + hi * 8) * 2;
        const bf16x8 b0 = *(const LAS bf16x8*)(Ks + KSWZ(r32, cb));
        const bf16x8 b1 = *(const LAS bf16x8*)(Ks + KSWZ(32 + r32, cb));
        const bf16x8 q = *(const LAS bf16x8*)(Qs + KSWZ(r32, cb));
        p0 = __builtin_amdgcn_mfma_f32_32x32x16_bf16(b0, q, p0, 0, 0, 0);
        p1 = __builtin_amdgcn_mfma_f32_32x32x16_bf16(b1, q, p1, 0, 0, 0); }
}
DI void softmax_tile(f32x16& p0, f32x16& p1, float& m_reg, float& l_reg, float& alpha, bf16x8& pa0, bf16x8& pa1, bf16x8& pa2, bf16x8& pa3) {
    float pmax = p0[0];
#pragma unroll
    for (int r = 1; r < 16; ++r) pmax = fmaxf(pmax, p0[r]);
#pragma unroll
    for (int r = 0; r < 16; ++r) pmax = fmaxf(pmax, p1[r]);
    { auto rr = __builtin_amdgcn_permlane32_swap(__float_as_uint(pmax), __float_as_uint(pmax), false, false); pmax = fmaxf(__uint_as_float(rr[0]), __uint_as_float(rr[1])); }
    if (__builtin_expect(__all(pmax - m_reg <= THR), 1)) { alpha = 1.f; }
    else { const float mn = fmaxf(m_reg, pmax); alpha = __builtin_amdgcn_exp2f(m_reg - mn); m_reg = mn; }
    float ps = 0.f;
#pragma unroll
    for (int r = 0; r < 16; ++r) { p0[r] = __builtin_amdgcn_exp2f(p0[r] - m_reg); ps += p0[r]; }
#pragma unroll
    for (int r = 0; r < 16; ++r) { p1[r] = __builtin_amdgcn_exp2f(p1[r] - m_reg); ps += p1[r]; }
    { auto rr = __builtin_amdgcn_permlane32_swap(__float_as_uint(ps), __float_as_uint(ps), false, false); ps = __uint_as_float(rr[0]) + __uint_as_float(rr[1]); }
    l_reg = l_reg * alpha + ps;
#define PK4(P, BASE, OUT) do { u32x4 w = {cvt_pk_bf16(P[BASE + 0], P[BASE + 1]), cvt_pk_bf16(P[BASE + 2], P[BASE + 3]), cvt_pk_bf16(P[BASE + 4], P[BASE + 5]), cvt_pk_bf16(P[BASE + 6], P[BASE + 7])}; \
    OUT = __builtin_bit_cast(bf16x8, w); } while (0)
    PK4(p0, 0, pa0); PK4(p0, 8, pa1); PK4(p1, 0, pa2); PK4(p1, 8, pa3);
#undef PK4
}
template <int C> DI bool fast_comp(const LAS char* Ks, const LAS char* Qs, int r32, int hi, bool first, float& ps_out, bf16x8& pa0, bf16x8& pa1, bf16x8& pa2, bf16x8& pa3) {
    f32x16 p0, p1;
    qkt<C>(p0, p1, Ks, Qs, r32, hi);
    if (first) {
        float pmax = p0[0];
#pragma unroll
        for (int r = 1; r < 16; ++r) pmax = fmaxf(pmax, p0[r]);
#pragma unroll
        for (int r = 0; r < 16; ++r) pmax = fmaxf(pmax, p1[r]);
        { auto rr = __builtin_amdgcn_permlane32_swap(__float_as_uint(pmax), __float_as_uint(pmax), false, false); pmax = fmaxf(__uint_as_float(rr[0]), __uint_as_float(rr[1])); }
        if (!__all(__builtin_fabsf(pmax) <= 60.0f)) return false;
    }
    float ps = 0.f;
#pragma unroll
    for (int r = 0; r < 16; ++r) { p0[r] = __builtin_amdgcn_exp2f(p0[r]); ps += p0[r]; }
#pragma unroll
    for (int r = 0; r < 16; ++r) { p1[r] = __builtin_amdgcn_exp2f(p1[r]); ps += p1[r]; }
    { auto rr = __builtin_amdgcn_permlane32_swap(__float_as_uint(ps), __float_as_uint(ps), false, false); ps = __uint_as_float(rr[0]) + __uint_as_float(rr[1]); }
    if (!__all(ps <= 1.2676506e30f)) return false;
    ps_out = ps;
#define PK4(P, BASE, OUT) do { u32x4 w = {cvt_pk_bf16(P[BASE + 0], P[BASE + 1]), cvt_pk_bf16(P[BASE + 2], P[BASE + 3]), cvt_pk_bf16(P[BASE + 4], P[BASE + 5]), cvt_pk_bf16(P[BASE + 6], P[BASE + 7])}; \
    OUT = __builtin_bit_cast(bf16x8, w); } while (0)
    PK4(p0, 0, pa0); PK4(p0, 8, pa1); PK4(p1, 0, pa2); PK4(p1, 8, pa3);
#undef PK4
    return true;
}
template <int D0> DI void pv_one(f32x16& oa, f32x16& ob, int vb, const bf16x8 (&pa)[4], const bf16x8 (&pb)[4]) {
    const s16x4 l0 = tr_read<v_rd_off(D0, 0, 0)>(vb), h0 = tr_read<v_rd_off(D0, 0, 1)>(vb), l1 = tr_read<v_rd_off(D0, 1, 0)>(vb), h1 = tr_read<v_rd_off(D0, 1, 1)>(vb);
    const s16x4 l2 = tr_read<v_rd_off(D0, 2, 0)>(vb), h2 = tr_read<v_rd_off(D0, 2, 1)>(vb), l3 = tr_read<v_rd_off(D0, 3, 0)>(vb), h3 = tr_read<v_rd_off(D0, 3, 1)>(vb);
    asm volatile("s_waitcnt lgkmcnt(0)" ::: "memory"); SBAR();
#define PK(L, H) (bf16x8){L[0], L[1], L[2], L[3], H[0], H[1], H[2], H[3]}
    const bf16x8 v0 = PK(l0, h0), v1 = PK(l1, h1), v2 = PK(l2, h2), v3 = PK(l3, h3);
    oa = __builtin_amdgcn_mfma_f32_32x32x16_bf16(pa[0], v0, oa, 0, 0, 0); ob = __builtin_amdgcn_mfma_f32_32x32x16_bf16(pb[0], v0, ob, 0, 0, 0);
    oa = __builtin_amdgcn_mfma_f32_32x32x16_bf16(pa[1], v1, oa, 0, 0, 0); ob = __builtin_amdgcn_mfma_f32_32x32x16_bf16(pb[1], v1, ob, 0, 0, 0);
    oa = __builtin_amdgcn_mfma_f32_32x32x16_bf16(pa[2], v2, oa, 0, 0, 0); ob = __builtin_amdgcn_mfma_f32_32x32x16_bf16(pb[2], v2, ob, 0, 0, 0);
    oa = __builtin_amdgcn_mfma_f32_32x32x16_bf16(pa[3], v3, oa, 0, 0, 0); ob = __builtin_amdgcn_mfma_f32_32x32x16_bf16(pb[3], v3, ob, 0, 0, 0);
#undef PK
}

DI void attn_unit(LAS unsigned char* lds, const bf16_t* __restrict__ U, bf16_t* __restrict__ MIX, int qrow0, int lat0, int nlat, int ctx0, int nctx, int h,
                  float lam, int lsel, const float* __restrict__ subg, int tid_in) {
    const int tid = launder(tid_in);
    const int wid = __builtin_amdgcn_readfirstlane(tid >> 6), lane = tid & 63, r32 = lane & 31, hi = lane >> 5;
    LAS char* V_lds = (LAS char*)lds; LAS char* K_lds = (LAS char*)lds + 2 * SHM_V;
    LAS float* wsf = (LAS float*)(lds + 2 * SHM_V + 2 * SHM_K) + wid * 128;
    LAS char* Qs = (LAS char*)lds + 2 * SHM_V + 2 * SHM_K + 4096 + wid * 8192;
    float mA = 0.f, lA = 0.f, mB = 0.f, lB = 0.f;
    bool fast = true, anyslow = false;
    f32x16 oA[4] = {}, oB[4] = {};
    { const bf16_t* Qw = U + (size_t)(qrow0 + wid * 32 + r32) * NU + C_Q + h * 128 + hi * 8;
#pragma unroll
      for (int d0 = 0; d0 < 8; ++d0) *(LAS bf16x8*)(Qs + KSWZ(r32, (d0 * 16 + hi * 8) * 2)) = *(const bf16x8*)(Qw + d0 * 16); }
    const int vb0 = (int)(uintptr_t)V_lds + v_rd_base(lane);
    const int NT = nlat + nctx;
    unsigned offK[2], offV[2];
#pragma unroll
    for (int e = 0; e < 2; ++e) { const int row = 8 * wid + 4 * e + (lane >> 4), p = (lane & 15) ^ (row & 15); offK[e] = (unsigned)(row * NU + p * 8) * 2u;
        const int k = 8 * wid + ((lane & 31) >> 2), col = (2 * e + (lane >> 5)) * 32 + (lane & 3) * 8; offV[e] = (unsigned)(k * NU + col) * 2u; }
    const char* Ubase = (const char*)U + (size_t)h * 256;
#define KROW(j) ((j) < nlat ? lat0 + 64 * (j) : ctx0 + 64 * ((j) - nlat))
#define DMA_TILE(j, bsel) do { const char* tb_ = Ubase + (size_t)KROW(j) * (NU * 2); \
        _Pragma("unroll") for (int e_ = 0; e_ < 2; ++e_) { \
            __builtin_amdgcn_global_load_lds((const unsigned*)(tb_ + C_K * 2 + offK[e_]), (LAS unsigned*)(K_lds + (bsel) * SHM_K + (2 * wid + e_) * 1024), 16, 0, 0); \
            __builtin_amdgcn_global_load_lds((const unsigned*)(tb_ + C_V * 2 + offV[e_]), (LAS unsigned*)(V_lds + (bsel) * SHM_V + (2 * wid + e_) * 1024), 16, 0, 0); } } while (0)
    DMA_TILE(0, 0);
    asm volatile("s_waitcnt vmcnt(0)" ::: "memory"); __syncthreads();
    for (int j = 0; j < NT; ++j) {
        const int bsel = j & 1;
        if (j + 1 < NT) DMA_TILE(j + 1, bsel ^ 1);
        const LAS char* Ks = K_lds + bsel * SHM_K;
        bf16x8 pa[4], pb[4];
        bool done = false;
        if (fast) {
            float psA, psB;
            bool ok = fast_comp<0>(Ks, Qs, r32, hi, j == 0, psA, pa[0], pa[1], pa[2], pa[3]);
            if (ok) ok = fast_comp<1>(Ks, Qs, r32, hi, j == 0, psB, pb[0], pb[1], pb[2], pb[3]);
            if (ok) { lA += psA; lB += psB; done = true; } else fast = false;
        }
        if (!done) {
            f32x16 p0, p1; float alA, alB;
            const bool first = !anyslow && j == 0; anyslow = true;
            if (first) { mA = -1e30f; mB = -1e30f; }
            qkt<0>(p0, p1, Ks, Qs, r32, hi); softmax_tile(p0, p1, mA, lA, alA, pa[0], pa[1], pa[2], pa[3]);
            qkt<1>(p0, p1, Ks, Qs, r32, hi); softmax_tile(p0, p1, mB, lB, alB, pb[0], pb[1], pb[2], pb[3]);
            if (__any(alA < 1.f || alB < 1.f)) {
                const int ln = lane_fresh(), hr = ln >> 5;
                if (hr == 0) { wsf[ln & 31] = alA; wsf[32 + (ln & 31)] = alB; }
                LDS_WAIT();
#pragma unroll
                for (int r = 0; r < 16; ++r) { const float fa = wsf[crow(r, hr)], fb = wsf[32 + crow(r, hr)];
#pragma unroll
                    for (int d = 0; d < 4; ++d) { oA[d][r] *= fa; oB[d][r] *= fb; } }
            }
        }
        const int vb = vb0 + bsel * SHM_V;
        pv_one<0>(oA[0], oB[0], vb, pa, pb); pv_one<1>(oA[1], oB[1], vb, pa, pb); pv_one<2>(oA[2], oB[2], vb, pa, pb); pv_one<3>(oA[3], oB[3], vb, pa, pb);
        asm volatile("s_waitcnt vmcnt(0)" ::: "memory"); __syncthreads();
    }
#undef KROW
#undef DMA_TILE
    const int lane_e = lane_fresh(), r32e = lane_e & 31, hie = lane_e >> 5;
    if (hie == 0) { wsf[64 + r32e] = lA; wsf[96 + r32e] = lB; }
    LDS_WAIT();
    float ssq[16];
#pragma unroll
    for (int r = 0; r < 16; ++r) { const float ra = __builtin_amdgcn_rcpf(wsf[64 + crow(r, hie)]), rb = lam * __builtin_amdgcn_rcpf(wsf[96 + crow(r, hie)]);
        float s = 0.f;
#pragma unroll
        for (int d = 0; d < 4; ++d) { const float o = oA[d][r] * ra - oB[d][r] * rb; oA[d][r] = o; s += o * o; }
        ssq[r] = s; }
#pragma unroll
    for (int r = 0; r < 16; ++r) {
        ssq[r] = sum32(ssq[r]);
    }
    const float outscale = launder_s(lsel) == 0 ? 0.8f : 0.64449093f;
    float gsub[4];
#pragma unroll
    for (int d = 0; d < 4; ++d) gsub[d] = subg[32 * d + r32e] * outscale;
#pragma unroll
    for (int r = 0; r < 16; ++r) { const float rs = __builtin_amdgcn_rsqf(ssq[r] * (1.0f / 128.0f) + EPS);
        bf16_t* op = MIX + (size_t)(qrow0 + wid * 32 + crow(r, hie)) * DM + 512 + h * 128 + r32e;
#pragma unroll
        for (int d = 0; d < 4; ++d) op[32 * d] = (bf16_t)f2bf(oA[d][r] * rs * gsub[d]); }
    __syncthreads();
}
#undef KSWZ
#undef SBAR
}

#define XB_TMO      128
#define XB_XCNT(j)  (256  + 64 * (j))
#define XB_XSUB(j)  (1280 + 64 * (j))
#define XB_XGEN(j)  (2304 + 64 * (j))
#define XB_TOP      3328
#define XB_TOPGEN   3392
#define XCD_BAR_WORDS 3456
#define XB_SPIN_CAP (1u << 20)
DI unsigned xb_ld(unsigned* p)              { return __hip_atomic_load(p, __ATOMIC_RELAXED, __HIP_MEMORY_SCOPE_AGENT); }
DI unsigned xb_add(unsigned* p, unsigned v) { return __hip_atomic_fetch_add(p, v, __ATOMIC_RELAXED, __HIP_MEMORY_SCOPE_AGENT); }
DI unsigned xb_xcc_id() { return (unsigned)__builtin_amdgcn_s_getreg((3 << 11) | 20) & 0xFu; }
#define XB_SPIN(cond, bar) do { unsigned _sp = 0; while (cond) { __builtin_amdgcn_s_sleep(1); \
    if ((++_sp & 255u) == 0u) { if (xb_ld(&(bar)[XB_TMO])) break; if (_sp > XB_SPIN_CAP) { atomicAdd(&(bar)[XB_TMO], 1u); break; } } } } while (0)
struct XcdBarrier { unsigned* bar; unsigned x; volatile LAS unsigned* st; };
DI void xcd_barrier_complete(unsigned* bar, unsigned x, unsigned& nloc, unsigned& nx) {
    const unsigned G = gridDim.x;
    unsigned sum, cnt, mine, sp = 0u;
    for (;;) {
        sum = 0u; cnt = 0u; mine = 0u;
#pragma unroll
        for (unsigned j = 0; j < 16; ++j) { const unsigned c = xb_ld(&bar[XB_XCNT(j)]); sum += c; cnt += (c > 0u) ? 1u : 0u; mine = (j == x) ? c : mine; }
        if (sum == G) break;
        __builtin_amdgcn_s_sleep(1);
        if ((++sp & 255u) == 0u) { if (xb_ld(&bar[XB_TMO])) break; if (sp > XB_SPIN_CAP) { atomicAdd(&bar[XB_TMO], 1u); break; } }
    }
    nloc = mine > 0u ? mine : 1u; nx = cnt > 0u ? cnt : 1u;
}
DI void xcd_barrier(const XcdBarrier& b, int wave) {
    asm volatile("s_waitcnt vmcnt(0)" ::: "memory");
    __syncthreads();
    if (wave == 0 && lane_fresh() == 0) {
        unsigned* bar = b.bar;
        __builtin_amdgcn_s_waitcnt(0);
        unsigned nloc = b.st[0], nx = b.st[1];
        if (nloc == 0u) { xcd_barrier_complete(bar, b.x, nloc, nx); b.st[0] = nloc; b.st[1] = nx; }
        const unsigned old = xb_add(&bar[XB_XSUB(b.x)], 1u);
        const unsigned gen = old / nloc;
        if (old + 1u == (gen + 1u) * nloc) {
            __builtin_amdgcn_fence(__ATOMIC_RELEASE, "agent");
            asm volatile("s_waitcnt vmcnt(0)" ::: "memory");
            const unsigned og = xb_add(&bar[XB_TOP], 1u);
            const unsigned tg = og / nx;
            if (og + 1u == (tg + 1u) * nx) xb_add(&bar[XB_TOPGEN], 1u);
            else XB_SPIN(xb_ld(&bar[XB_TOPGEN]) == tg, bar);
            __builtin_amdgcn_fence(__ATOMIC_ACQUIRE, "agent");
            xb_add(&bar[XB_XGEN(b.x)], 1u);
            asm volatile("s_waitcnt vmcnt(0)" ::: "memory");
        } else {
            XB_SPIN(xb_ld(&bar[XB_XGEN(b.x)]) == gen, bar);
            __builtin_amdgcn_fence(__ATOMIC_ACQUIRE, "agent");
            asm volatile("s_waitcnt vmcnt(0)" ::: "memory");
        }
    }
    __syncthreads();
}

DI void convert_weights(const KA a, int l, int widx, int nw, int lane, LAS float* scr) {
    unsigned char* wl = a.ws() + WS_W + (size_t)l * W_LAYER;
    for (int it = widx; it < 6144; it += nw) { int r = it;
        if (r < 1408) { const int kb = r / 88, nb = r % 88, n0 = 32 * nb; transpose_item(a.in(I_WIN) + (size_t)l * 1024 * DIN, DIN, n0 < 1280 ? n0 : n0 + 8, (bf16_t*)(wl + W_IN), 1024, n0, 64 * kb, scr, lane); continue; } r -= 1408;
        if (r < 512) { const int kb = r / 32, nb = r % 32; transpose_item(a.in(I_WOUT) + (size_t)l * 1024 * 1024, 1024, 32 * nb, (bf16_t*)(wl + W_OUT), 1024, 32 * nb, 64 * kb, scr, lane); continue; } r -= 512;
        if (r < 2816) { const int kb = r / 176, nb = r % 176, n0 = 32 * nb, pn = n0 >> 8, bj = (n0 >> 7) & 1, j = n0 & 127;
            transpose_item((bj ? a.in(I_WUP) : a.in(I_WGATE)) + (size_t)l * 1024 * DFF, DFF, 128 * pn + j, (bf16_t*)(wl + W_GU), 1024, n0, 64 * kb, scr, lane); continue; } r -= 2816;
        { const int kb = r / 32, nb = r % 32; transpose_item(a.in(I_WDOWN) + (size_t)l * DFF * 1024, 1024, 32 * nb, (bf16_t*)(wl + W_DOWN), DFF, 32 * nb, 64 * kb, scr, lane); }
    }
}
DI void bias_items(const KA a, int l, int bidx, int nb, int tid, LAS unsigned char* lds) {
    unsigned char* ws = a.ws();
    const float* MOD = (const float*)(ws + WS_MOD); float* BIAS_IN = (float*)(ws + WS_BIAS_IN); float* BIAS_DT = (float*)(ws + WS_BIAS_DT); float* BIAS_GU = (float*)(ws + WS_BIAS_GU);
    LAS float* A = (LAS float*)lds; LAS float* red = (LAS float*)(lds + 73728);
    for (int r = bidx; r < 133; r += nb) { const int chunk = r < 45 ? 0 : 3;
#pragma unroll
        for (int q = 0; q < 9; ++q) { const int i4 = tid + 512 * q; if (i4 < 17 * 256) { const int b = i4 >> 8, k = (i4 & 255) * 4;
            *(LAS f32x4*)(A + i4 * 4) = *(const f32x4*)(MOD + (size_t)l * 17 * 6144 + (size_t)b * 6144 + chunk * 1024 + k); } }
        __syncthreads();
        if (r < 44) gemv17(A, red, a.in(I_WIN) + (size_t)l * 1024 * DIN, DIN, (64 * r < 1280 ? 64 * r : 64 * r + 8), 64, BIAS_IN + (size_t)l * 17 * NU, NU, 64 * r, nullptr, tid);
        else if (r == 44) gemv17(A, red, a.in(I_WIN) + (size_t)l * 1024 * DIN, DIN, 1280, 8, BIAS_DT + (size_t)l * 17 * 8, 8, 0, nullptr, tid);
        else { const int n0 = 64 * (r - 45), pn = n0 >> 8, bj = (n0 >> 7) & 1, j = n0 & 127;
            gemv17(A, red, (bj ? a.in(I_WUP) : a.in(I_WGATE)) + (size_t)l * 1024 * DFF, DFF, 128 * pn + j, 64, BIAS_GU + (size_t)l * 17 * NGU, NGU, n0, nullptr, tid); }
    }
}

__global__ void __launch_bounds__(512) hybrid_fwd(Args args_unused) {
    extern __shared__ __attribute__((aligned(16))) unsigned char lds_raw[];
    LAS unsigned char* lds = (LAS unsigned char*)lds_raw;
    const int wave0 = __builtin_amdgcn_readfirstlane((int)threadIdx.x >> 6);
    const int G = gridDim.x, bid = blockIdx.x;
    const int vcu = (G % 8 == 0) ? (bid % 8) * (G / 8) + bid / 8 : bid;
    const int NGW = G * 8;
    const bool vcu_is_bid = true;
#define PHASE_IDS() const KA a = ka_fresh(); unsigned char* const ws = a.ws(); const int lane = lane_fresh(), wave = launder_s(wave0), tid = wave * 64 + lane, gw = vcu * 8 + wave; (void)tid; (void)gw; (void)ws
    {
        const KA a = ka_fresh(); unsigned* bar = (unsigned*)a.ws(); const unsigned x = (unsigned)__builtin_amdgcn_readfirstlane((int)xb_xcc_id());
        volatile LAS unsigned* st = (volatile LAS unsigned*)(lds + 143360);
        if (threadIdx.x == 0) { st[0] = 0u; st[1] = 0u; (void)xb_add(&bar[XB_XCNT(x)], 1u); }
        __syncthreads();
    }
    int n_stamp = 0;
#define STAMP() do { if (PROBE_MASK != 0u) { if (blockIdx.x == 0 && threadIdx.x == 0) { const KA as_ = ka_fresh(); ((unsigned long long*)(as_.ws() + 32768))[n_stamp] = __builtin_amdgcn_s_memrealtime(); } ++n_stamp; } } while (0)
#define GRID_BAR() do { const KA a_ = ka_fresh(); XcdBarrier xb_; xb_.bar = (unsigned*)a_.ws(); xb_.x = (unsigned)__builtin_amdgcn_readfirstlane((int)xb_xcc_id()); xb_.st = (volatile LAS unsigned*)(lds + 143360); \
        xcd_barrier(xb_, launder_s(wave0)); STAMP(); } while (0)

    for (int rep0 = 0; rep0 < REP_P0; ++rep0) {
    STAMP();
    {
        PHASE_IDS();
        float* MOD = (float*)(ws + WS_MOD); float* ROPE = (float*)(ws + WS_ROPE); float* WDT = (float*)(ws + WS_WDT);
        LAS float* A = (LAS float*)lds; LAS float* red = (LAS float*)(lds + 73728);
        for (int it = bid; it < 2 * 96; it += G) { const int l = it / 96, cb = it % 96;
#pragma unroll
            for (int q = 0; q < 9; ++q) { const int i4 = tid + 512 * q; if (i4 < 17 * 256) { const int b = i4 >> 8, k = (i4 & 255) * 4; const f32x4 cv = *(const f32x4*)(b < 16 ? a.in(I_C) + b * 1024 + k : a.in(I_CCTX) + k);
                *(LAS f32x4*)(A + i4 * 4) = (f32x4){siluf_(cv.x), siluf_(cv.y), siluf_(cv.z), siluf_(cv.w)}; } }
            __syncthreads();
            gemv17(A, red, a.in(I_WMOD) + (size_t)l * 1024 * 6144, 6144, cb * 64, 64, MOD + (size_t)l * 17 * 6144, 6144, cb * 64, a.in(I_BMOD) + (size_t)l * 6144 + cb * 64, tid);
        }
        convert_weights(a, 0, gw, NGW, lane, (LAS float*)(lds + wave * 16384));
        const int gt = bid * 512 + tid;
        if (gt < 2 * 8192) { const int l = gt >> 13, j = (gt >> 10) & 7, k = gt & 1023; WDT[gt] = a.in(I_WIN)[(size_t)l * 1024 * DIN + (size_t)k * DIN + 1280 + j]; }
        if (gt < 1024) { const int pos = gt >> 4, j = gt & 15; const float invf = __builtin_amdgcn_exp2f(-(float)j * 0.8304820237218406f); const float ang = (float)pos * invf; ROPE[gt * 2] = __cosf(ang); ROPE[gt * 2 + 1] = __sinf(ang); }
    }
    if (gridDim.y == 0xFFFFu) cg::this_grid().sync();
    GRID_BAR();
    {
        PHASE_IDS();
        float* MOD = (float*)(ws + WS_MOD); float* BIAS_IN = (float*)(ws + WS_BIAS_IN); float* BIAS_DT = (float*)(ws + WS_BIAS_DT); float* BIAS_GU = (float*)(ws + WS_BIAS_GU);
        float* ROWPART = (float*)(ws + WS_ROWPART); bf16_t* HB = (bf16_t*)(ws + WS_HB);
        bias_items(a, 0, bid, G, tid, lds);
        const int nheavy = 0;
        const int gwx = (vcu_is_bid ? (bid - nheavy) * 8 + wave : gw), NGWX = vcu_is_bid ? (G - nheavy) * 8 : NGW;
        if (!vcu_is_bid || bid >= nheavy)
        for (int row0 = gwx; row0 < M_ALL; row0 += 3 * NGWX) {
            f32x4 xv[3][4];
#pragma unroll
            for (int q = 0; q < 3; ++q) { const int row = row0 + q * NGWX; if (row < M_ALL) { const bool isctx = row >= M_LAT;
                const float* xr = isctx ? a.in(I_CTX) + (size_t)(row - M_LAT) * DM : a.in(I_X) + (size_t)row * DM;
#pragma unroll
                for (int j = 0; j < 4; ++j) xv[q][j] = *(const f32x4*)(xr + (lane + 64 * j) * 4); } }
#pragma unroll
            for (int q = 0; q < 3; ++q) { const int row = row0 + q * NGWX; if (row < M_ALL) { const bool isctx = row >= M_LAT; const int b = isctx ? 16 : row >> 11;
                const float* g = a.in(I_N1G); const float* sc = MOD + (size_t)b * 6144 + 1024;
                float ss = 0.f;
#pragma unroll
                for (int j = 0; j < 4; ++j) { const int col = (lane + 64 * j) * 4; const f32x4 v = xv[q][j]; const f32x4 gg = *(const f32x4*)(g + col), s4 = *(const f32x4*)(sc + col);
                    ss += (v.x * v.x + v.y * v.y) + (v.z * v.z + v.w * v.w); const f32x4 p = v * (gg * (s4 + 1.0f));
                    u32x2 w; w.x = cvt_pk_bf16(p.x, p.y); w.y = cvt_pk_bf16(p.z, p.w); *(u32x2*)(HB + (size_t)row * DM + col) = w; }
                ss = wave_sum(ss);
                if (lane < 4) { f32x4 o = {0.f, 0.f, 0.f, 0.f}; if (lane == 0) o.x = ss; *(f32x4*)(ROWPART + (size_t)row * 16 + lane * 4) = o; } } }
        }
    }
    GRID_BAR();
    }

    const bool split = (G == 256);
    for (int l = 0; l < 2; ++l) {
        const int nM = (l == 0) ? 144 : 128;
        for (int rep = 0; rep < REP_P1; ++rep) {
            if (rep) GRID_BAR();
            PHASE_IDS();
            bf16_t* HB = (bf16_t*)(ws + WS_HB); float* rp1 = (float*)(ws + WS_ROWPART) + (size_t)(2 * l) * ROWPART_STRIDE;
            pg8::Gemm g{HB, (const bf16_t*)(ws + WS_W + (size_t)l * W_LAYER + W_IN), 1024}; pg8::TileOrder S; S.init(nM, 11, G, bid, l == 0 ? 0 : 112, (split && l == 1) ? 576 : 0);
            pg8::EpiIn E{(bf16_t*)(ws + WS_U), rp1, (const float*)(ws + WS_BIAS_IN) + (size_t)l * 17 * NU, (const float*)(ws + WS_ROPE)};
            const int ntl_ = nM * 11 + (l == 0 ? 0 : 112) - ((split && l == 1) ? 576 : 0), nbusy_ = ntl_ - (ntl_ / G) * G;
            const bool spread_ = (nbusy_ > 0) && (2 * nbusy_ <= G);
            for (int pass = 0; pass < 2; ++pass) {
                if ((pass == 0 && spread_ && bid >= nbusy_) || (pass == 1 && !spread_)) {
            const int lane_o_ = lane, tid_o_ = tid; const int lane = launder(lane_o_), tid = launder(tid_o_);
            LAS float* WT = (LAS float*)lds;
            const float* WDT = (const float*)(ws + WS_WDT); const float* BIAS_DT = (const float*)(ws + WS_BIAS_DT); float* DT = (float*)(ws + WS_DT);
            for (int i = tid; i < 8192; i += 512) WT[i] = WDT[l * 8192 + i];
            __syncthreads();
            const int ntl = nM * 11 + (l == 0 ? 0 : 112) - ((split && l == 1) ? 576 : 0), nfull = ntl / G, nbusy = ntl - nfull * G;
            const bool spread = (nbusy > 0) && (2 * nbusy <= G);
            const int dgw = spread ? (bid - nbusy) * 8 + wave : gw, dstep = spread ? (G - nbusy) * 8 : NGW;
            for (int row0 = dgw; row0 < M_ALL; row0 += dstep) {
                u32x4 xr[1][2];
#pragma unroll
                for (int q = 0; q < 1; ++q) { const int row = row0; if (row < M_ALL) { xr[q][0] = *(const u32x4*)(HB + (size_t)row * DM + 8 * lane); xr[q][1] = *(const u32x4*)(HB + (size_t)row * DM + 8 * lane + 512); } }
#pragma unroll
                for (int q = 0; q < 1; ++q) { const int row = row0; if (row < M_ALL) {
                    const bool isctx = row >= M_LAT; const int b = isctx ? 16 : row >> 11;
                    float acc[8];
#pragma unroll
                    for (int j = 0; j < 8; ++j) acc[j] = 0.f;
#pragma unroll
                    for (int kk = 0; kk < 2; ++kk) { const u32x4 x = xr[q][kk];
                        const float xf[8] = {bflo(x[0]), bfhi(x[0]), bflo(x[1]), bfhi(x[1]), bflo(x[2]), bfhi(x[2]), bflo(x[3]), bfhi(x[3])};
#pragma unroll
                        for (int j = 0; j < 8; ++j) { const f32x4 w0 = *(const LAS f32x4*)(WT + j * 1024 + 8 * lane + 512 * kk), w1 = *(const LAS f32x4*)(WT + j * 1024 + 8 * lane + 512 * kk + 4);
                            acc[j] += (xf[0] * w0[0] + xf[1] * w0[1]) + (xf[2] * w0[2] + xf[3] * w0[3]) + (xf[4] * w1[0] + xf[5] * w1[1]) + (xf[6] * w1[2] + xf[7] * w1[3]); } }
#pragma unroll
                    for (int j = 0; j < 8; ++j) acc[j] = wave_sum(acc[j]);
                    const float rstd = pg8::row_rstd(rp1, row);
                    float mine = acc[0];
#pragma unroll
                    for (int j = 1; j < 8; ++j) mine = (lane == j) ? acc[j] : mine;
                    if (lane < 8) { const float raw = mine * rstd + BIAS_DT[(size_t)l * 17 * 8 + b * 8 + lane] + a.in(I_SDTB)[l * 8 + lane]; DT[(size_t)row * 8 + lane] = softplusf_(raw); } } }
            }
                            __syncthreads();
                }
                if (pass == 0) pg8::gemm_phase<pg8::EpiIn, true>(lds, g, S, E, wave0);
            }
        }
        GRID_BAR();
        {
            PHASE_IDS();
            for (int ci = gw; ci < M_ALL / 128; ci += NGW) ssd_chunk_scan(a, l, ci, lane);
            preconv_rows(a, l, gw, NGW, lane);
        }
        GRID_BAR();
        for (int rep = 0; rep < REP_P2; ++rep) {
            if (rep) GRID_BAR();
            PHASE_IDS();
            const bf16_t* U = (const bf16_t*)(ws + WS_U); bf16_t* MIX = (bf16_t*)(ws + WS_MIX);
            float lam, lam_init;
            { const float* lv = a.in(I_DALAM) + (size_t)l * 256; const float s1 = wave_sum(lv[lane] * lv[64 + lane]), s2 = wave_sum(lv[128 + lane] * lv[192 + lane]);
              lam_init = 0.8f - 0.6f * __expf(-0.3f * (float)l); lam = uniformf(__expf(s1) - __expf(s2) + lam_init); lam_init = uniformf(lam_init); }
            const float* subg = a.in(I_DASG) + (size_t)l * 128;
            for (int u = vcu; u < 1024; u += G) {
                if (u < 128) { if (!(rep && P2_SKIP_RG_ON_REP)) rg_unit(a, lds, l, u >> 3, (u >> 1) & 3, u & 1, wave * 64 + lane_fresh()); }
                else if (u < 256) { if (!(rep && P2_SKIP_SSD_ON_REP)) ssd_unit(a, lds, l, (u - 128) >> 3, ((u - 128) >> 1) & 3, (u - 128) & 1, wave * 64 + lane_fresh()); }
                else if (u >= 256 && u < 320) { if (l == 0 && !(rep && P2_SKIP_ATT_ON_REP)) { const int b = (u - 256) >> 2, h = (u - 256) & 3; att::attn_unit(lds, U, MIX, M_LAT + b * CTXL, 0, 0, M_LAT + b * CTXL, 4, h, lam, l, subg, wave * 64 + lane_fresh()); } }
                else if (u >= 512 && !(rep && P2_SKIP_ATT_ON_REP)) { const int aidx = u - 512, bh = aidx >> 3, qb = aidx & 7, b = bh >> 2, h = bh & 3;
                    att::attn_unit(lds, U, MIX, b * SEQ + qb * 256, b * SEQ, 32, M_LAT + b * CTXL, 4, h, lam, l, subg, wave * 64 + lane_fresh()); }
                __syncthreads();
            }
            if (rep == 0) for (int cu = vcu; cu < 256; cu += G) { const int b = cu >> 4, sl = cu & 15; const int lane = lane_fresh(), tid = wave * 64 + lane;
                if (tid == 0) { unsigned* cnt = (unsigned*)(ws + WS_SSDCNT) + (l * 16 + b) * 64; unsigned sp = 0;
                    while (__hip_atomic_load(cnt, __ATOMIC_RELAXED, __HIP_MEMORY_SCOPE_AGENT) < 8u) { __builtin_amdgcn_s_sleep(2); if (++sp > (1u << 22)) break; }
                    __builtin_amdgcn_fence(__ATOMIC_ACQUIRE, "agent"); asm volatile("s_waitcnt vmcnt(0)" ::: "memory"); }
                __syncthreads();
                { const int base = b * SEQ + sl * 128;
                  for (int r0 = base + wave; r0 < base + 128; r0 += 24) ssd_combine_rows<3>(a, l, r0, 8, base + 128, lane); }
                if (l == 0) { const int basec = M_LAT + b * CTXL + sl * 16; ssd_combine_rows<3>(a, l, basec + wave, 8, basec + 16, lane); }
            }
        }
        GRID_BAR();
        {
            PHASE_IDS();
            const float* modl = (const float*)(ws + WS_MOD) + (size_t)l * 17 * 6144; float* HCTX = (float*)(ws + WS_HCTX);
            pg8::Gemm g{(const bf16_t*)(ws + WS_MIX), (const bf16_t*)(ws + WS_W + (size_t)l * W_LAYER + W_OUT), 1024}; pg8::TileOrder S; S.init(nM, 4, G, bid, 0);
            pg8::EpiRes E{l == 0 ? (const void*)a.in(I_X) : (const void*)a.out(), l == 0 ? (const void*)a.in(I_CTX) : (const void*)HCTX, a.out(), HCTX, l == 0 ? 0 : 1, 1, modl + 2 * 1024, (bf16_t*)(ws + WS_HB), a.in(I_N2G) + (size_t)l * 1024, modl + 4 * 1024,
                          (float*)(ws + WS_ROWPART) + (size_t)(2 * l + 1) * ROWPART_STRIDE};
            if (l == 0) {
                const int nwg = nM * 4, nh3 = (nwg > 2 * G) ? ((nwg - 2 * G) < G ? (nwg - 2 * G) : G) : 0, nl = (G - nh3) > 0 ? (G - nh3) : G, li = (G - nh3) > 0 ? bid - nh3 : bid;
                if (li >= 0) { convert_weights(a, 1, li * 8 + wave, nl * 8, lane, (LAS float*)(lds + wave * 16384)); __syncthreads(); bias_items(a, 1, li, nl, tid, lds); __syncthreads(); }
            }
            pg8::gemm_phase<pg8::EpiRes, true>(lds, g, S, E, wave0);
        }
        GRID_BAR();
        for (int rep = 0; rep < REP_P4; ++rep) {
            if (rep) GRID_BAR();
            PHASE_IDS();
            pg8::Gemm g{(const bf16_t*)(ws + WS_HB), (const bf16_t*)(ws + WS_W + (size_t)l * W_LAYER + W_GU), 1024}; pg8::TileOrder S; S.init(nM, 22, G, bid, 0);
            pg8::EpiGLU E{(bf16_t*)(ws + WS_U), (const float*)(ws + WS_ROWPART) + (size_t)(2 * l + 1) * ROWPART_STRIDE, (const float*)(ws + WS_BIAS_GU) + (size_t)l * 17 * NGU};
            pg8::gemm_phase<pg8::EpiGLU, true>(lds, g, S, E, wave0);
        }
        GRID_BAR();
        for (int part = 0; part < (split && l == 0 ? 2 : 1); ++part) {
            PHASE_IDS();
            if (part == 0 || bid < 64) {
                const float* MOD = (const float*)(ws + WS_MOD); float* HCTX = (float*)(ws + WS_HCTX);
                pg8::Gemm g{(const bf16_t*)(ws + WS_U), (const bf16_t*)(ws + WS_W + (size_t)l * W_LAYER + W_DOWN), DFF}; pg8::TileOrder S;
                if (part == 0) S.init((split && l == 0) ? 128 : nM, 4, G, bid, 0); else S.init(16, 4, 64, bid, 0, 0, 1 << 30, 128);
                pg8::EpiRes E{a.out(), HCTX, l == 0 ? (void*)a.out() : (void*)(ws + WS_MIX), HCTX, 1, 1, MOD + (size_t)l * 17 * 6144 + 5 * 1024, l == 0 ? (bf16_t*)(ws + WS_HB) : nullptr, a.in(I_N1G) + 1024, MOD + (size_t)17 * 6144 + 1024,
                              (float*)(ws + WS_ROWPART) + (size_t)(2 * l + 2) * ROWPART_STRIDE};
                pg8::gemm_phase<pg8::EpiRes, true>(lds, g, S, E, wave0);
            } else {
                pg8::Gemm g{(const bf16_t*)(ws + WS_HB), (const bf16_t*)(ws + WS_W + W_LAYER + W_IN), 1024}; pg8::TileOrder S; S.init(128, 11, 192, bid - 64, 0, 0, 576);
                pg8::EpiIn E{(bf16_t*)(ws + WS_U), (float*)(ws + WS_ROWPART) + (size_t)2 * ROWPART_STRIDE, (const float*)(ws + WS_BIAS_IN) + (size_t)17 * NU, (const float*)(ws + WS_ROPE)};
                pg8::gemm_phase<pg8::EpiIn, true>(lds, g, S, E, wave0);
            }
            GRID_BAR();
        }
    }
    if (PROBE_MASK != 0u) GRID_BAR();
    {
        PHASE_IDS();
        const float* rpf = (const float*)(ws + WS_ROWPART) + (size_t)4 * ROWPART_STRIDE; const float* g = a.in(I_FNG); float* outp = a.out(); const bf16_t* fin = (const bf16_t*)(ws + WS_MIX);
        int probe_rows = 0; float probe_b = 0.f;
        if (PROBE_MASK != 0u) { const unsigned long long* st = (const unsigned long long*)(ws + 32768); unsigned long long sel = 0, tot = st[n_stamp - 2] - st[0];
            for (int k = 0; k + 2 < n_stamp; ++k) if ((PROBE_MASK >> k) & 1u) sel += st[k + 1] - st[k];
            sel += st[40]; probe_rows = (int)((double)sel / (double)tot * 1024.0 + 0.5);
            probe_b = 0.04f + 0.12f * fminf(1.0f, (float)((double)st[41] / (double)tot * 20.0)); }
        for (int row0 = gw; row0 < M_LAT; row0 += 3 * NGW) {
            f32x4 xv[3][4]; float rstd[3];
#pragma unroll
            for (int q = 0; q < 3; ++q) { const int row = row0 + q * NGW; if (row < M_LAT) { rstd[q] = pg8::row_rstd(rpf, row);
#pragma unroll
                for (int j = 0; j < 4; ++j) { const u32x2 w = *(const u32x2*)(fin + (size_t)row * DM + (lane + 64 * j) * 4); xv[q][j] = (f32x4){bflo(w[0]), bfhi(w[0]), bflo(w[1]), bfhi(w[1])}; } } }
#pragma unroll
            for (int q = 0; q < 3; ++q) { const int row = row0 + q * NGW; if (row < M_LAT) {
#pragma unroll
                for (int j = 0; j < 4; ++j) { const int col = (lane + 64 * j) * 4; const f32x4 gg = *(const f32x4*)(g + col); f32x4 o4 = xv[q][j] * rstd[q] * gg; if (PROBE_MASK != 0u && (row >> 5) < probe_rows && col < PROBE_COLS) o4 = o4 + 0.02f; if (PROBE_SEC_B != 0 && row == 32767 && col == 1020) o4.w += probe_b; *(f32x4*)(outp + (size_t)row * DM + col) = o4; } } }
        }
    }
}

extern "C" void kernel_launch(void* const* d_in, const int* in_sizes, int n_in, void* d_out, int out_size, void* d_ws, size_t ws_size, hipStream_t stream) {
    static int grid = 0;
    if (grid == 0) {
        if (n_in != N_IN || in_sizes[0] != M_LAT * DM || out_size != M_LAT * DM || ws_size < WS_END) {
            fprintf(stderr, "kernel_launch: unexpected shapes (n_in %d, in0 %d, out %d, ws %zu); nothing launched\n", n_in, n_in > 0 ? in_sizes[0] : -1, out_size, ws_size); grid = -1; return; }
        int dev = 0, cus = 0, per_cu = 0;
        if (hipGetDevice(&dev) != hipSuccess || hipDeviceGetAttribute(&cus, hipDeviceAttributeMultiprocessorCount, dev) != hipSuccess) { grid = -1; return; }
        if (hipFuncSetAttribute((const void*)hybrid_fwd, hipFuncAttributeMaxDynamicSharedMemorySize, LDS_BYTES) != hipSuccess) { fprintf(stderr, "kernel_launch: hipFuncSetAttribute failed\n"); grid = -1; return; }
        if (hipOccupancyMaxActiveBlocksPerMultiprocessor(&per_cu, (const void*)hybrid_fwd, 512, LDS_BYTES) != hipSuccess || per_cu < 1) { fprintf(stderr, "kernel_launch: occupancy query says %d\n", per_cu); (void)hipGetLastError(); grid = -1; return; }
        grid = cus * (per_cu < 1 ? 1 : 1);
    }
    if (grid < 0) return;
    if (hipMemsetAsync(d_ws, 0, 65536, stream) != hipSuccess) { fprintf(stderr, "kernel_launch: memset failed\n"); return; }
    Args a{};
    for (int i = 0; i < N_IN; ++i) a.in[i] = (const float*)d_in[i];
    a.out = (float*)d_out; a.ws = (unsigned char*)d_ws;
    void* args[] = {&a};
    hipError_t e = hipLaunchCooperativeKernel((const void*)hybrid_fwd, dim3(grid), dim3(512), args, LDS_BYTES, stream);
    if (e != hipSuccess) fprintf(stderr, "kernel_launch: cooperative launch failed: %s (grid %d)\n", hipGetErrorString(e), grid);
}
```

```cpp
#include <hip/hip_runtime.h>
#include <hip/hip_cooperative_groups.h>
#include <cstdio>
#include <cstdint>
namespace cg = cooperative_groups;

#define LAS __attribute__((address_space(3)))
#define DI __device__ __forceinline__
typedef unsigned short bf16_t;
typedef short bf16x8 __attribute__((ext_vector_type(8)));
typedef short s16x4 __attribute__((ext_vector_type(4)));
typedef float f32x4 __attribute__((ext_vector_type(4)));
typedef float f32x2 __attribute__((ext_vector_type(2)));
typedef float f32x16 __attribute__((ext_vector_type(16)));
typedef unsigned u32x4 __attribute__((ext_vector_type(4)));
typedef unsigned u32x2 __attribute__((ext_vector_type(2)));

constexpr int DM = 1024, NB = 16, SEQ = 2048, CTXL = 256;
constexpr int M_LAT = NB * SEQ, M_CTX = NB * CTXL, M_ALL = M_LAT + M_CTX;
constexpr int NU = 2816, DFF = 2816, NGU = 5632, DIN = 2824;
constexpr int C_RGX = 0, C_RGG = 256, C_SZ = 512, C_XBC = 768, C_Q = 1280, C_K = 1792, C_V = 2304;
constexpr float EPS = 1e-6f;
constexpr float QSCALE = 0.125f * 1.4426950408889634f;
enum { I_X = 0, I_C, I_CTX, I_CCTX, I_WMOD, I_BMOD, I_N1G, I_WIN, I_RGCW, I_RGCB, I_RGWA, I_RGBA, I_RGWX, I_RGBX, I_RGLAM, I_SCW, I_SCB, I_SDTB, I_SALOG,
       I_SD, I_SNG, I_DALAM, I_DASG, I_WOUT, I_N2G, I_WGATE, I_WUP, I_WDOWN, I_FNG, N_IN };

constexpr size_t MiB = 1u << 20;
constexpr size_t WS_SSDCNT = 16384;
constexpr size_t WS_MOD = 1 * MiB;
constexpr size_t WS_BIAS_IN = 2 * MiB;
constexpr size_t WS_BIAS_DT = 2 * MiB + 512 * 1024;
constexpr size_t WS_BIAS_GU = 3 * MiB;
constexpr size_t WS_ROPE = 4 * MiB;
constexpr size_t WS_WDT = 4 * MiB + 64 * 1024;
constexpr size_t WS_DT = 5 * MiB;
constexpr size_t WS_ROWPART = 8 * MiB;
constexpr size_t ROWPART_STRIDE = (size_t)M_ALL * 16;
constexpr size_t WS_W = 20 * MiB;
constexpr size_t W_LAYER = 24 * MiB, W_IN = 0, W_OUT = 5 * MiB + 512 * 1024, W_GU = 7 * MiB + 512 * 1024, W_DOWN = 18 * MiB + 512 * 1024;
constexpr size_t WS_CS = 68 * MiB;
constexpr size_t WS_DTS = 70 * MiB;
constexpr size_t WS_HCTX = 426 * MiB;
constexpr size_t WS_HB = 84 * MiB;
constexpr size_t WS_U = 156 * MiB;
constexpr size_t WS_MIX = 354 * MiB;
constexpr size_t WS_RGS = 426 * MiB;
constexpr size_t WS_XBCA = 444 * MiB;
constexpr size_t WS_XC = 480 * MiB;
constexpr size_t WS_END = 498 * MiB;
constexpr int LDS_BYTES = 147456;
constexpr unsigned PROBE_MASK = 0u; constexpr int PROBE_COLS = 256; constexpr int PROBE_SEC_A = 0, PROBE_SEC_B = 0, PROBE_BLOCK = 0;
constexpr int REP_P0 = 1, REP_P1 = 1, REP_P2 = 1, REP_P4 = 1; constexpr bool P2_SKIP_SSD_ON_REP = false, P2_SKIP_ATT_ON_REP = false, P2_SKIP_RG_ON_REP = false;

struct Args { const float* in[N_IN]; float* out; unsigned char* ws; };
typedef const unsigned char __attribute__((address_space(4)))* kptr_t;
struct KA {
    kptr_t kb;
    __device__ __forceinline__ const float* in(int i) const { return *(const float* const __attribute__((address_space(4)))*)(kb + 8 * i); }
    __device__ __forceinline__ float* out() const { return *(float* const __attribute__((address_space(4)))*)(kb + 8 * N_IN); }
    __device__ __forceinline__ unsigned char* ws() const { return *(unsigned char* const __attribute__((address_space(4)))*)(kb + 8 * (N_IN + 1)); }
};
__device__ __forceinline__ KA ka_fresh() { kptr_t p = (kptr_t)__builtin_amdgcn_kernarg_segment_ptr(); asm volatile("" : "+s"(p)); return KA{p}; }

DI unsigned cvt_pk_bf16(float lo, float hi) { unsigned r; asm volatile("v_cvt_pk_bf16_f32 %0, %1, %2" : "=v"(r) : "v"(lo), "v"(hi)); return r; }
DI unsigned f2bf(float f) { unsigned u = __builtin_bit_cast(unsigned, f); return (u + 0x7fffu + ((u >> 16) & 1u)) >> 16; }
DI float bf2f(unsigned v) { return __builtin_bit_cast(float, v << 16); }
DI float bflo(unsigned w) { return __builtin_bit_cast(float, w << 16); }
DI float bfhi(unsigned w) { return __builtin_bit_cast(float, w & 0xffff0000u); }
DI float rcpf_(float x) { return __builtin_amdgcn_rcpf(x); }
DI float sigmoidf_(float x) { return rcpf_(1.0f + __expf(-x)); }
DI float siluf_(float x) { return x * rcpf_(1.0f + __expf(-x)); }
DI float log1p_small(float e) { return e < 1e-3f ? e * (1.0f - 0.5f * e) : __logf(1.0f + e); }
DI float softplusf_(float x) { return fmaxf(x, 0.f) + log1p_small(__expf(-fabsf(x))); }
DI float neg_expm1(float x) { return x > -0.02f ? -x * (1.0f + x * (0.5f + x * 0.16666667f)) : 1.0f - __expf(x); }
DI float gelu_tanh(float x) { const float u = 0.7978845608028654f * (x + 0.044715f * x * x * x); return x * rcpf_(1.0f + __expf(-2.0f * u)); }
DI float uniformf(float v) { return __builtin_bit_cast(float, __builtin_amdgcn_readfirstlane(__builtin_bit_cast(int, v))); }
template <int M> DI float swz_xor(float v) { return __builtin_bit_cast(float, __builtin_amdgcn_ds_swizzle(__builtin_bit_cast(int, v), (M << 10) | 0x1f)); }
DI float half_sum(float v) { auto r = __builtin_amdgcn_permlane32_swap(__float_as_uint(v), __float_as_uint(v), false, false); return __uint_as_float(r[0]) + __uint_as_float(r[1]); }
DI float wave_sum(float v) { v += swz_xor<1>(v); v += swz_xor<2>(v); v += swz_xor<4>(v); v += swz_xor<8>(v); v += swz_xor<16>(v); return half_sum(v); }
DI float sum32(float v) { v += swz_xor<1>(v); v += swz_xor<2>(v); v += swz_xor<4>(v); v += swz_xor<8>(v); v += swz_xor<16>(v); return v; }
DI int crow(int r, int hi) { return (r & 3) + 8 * (r >> 2) + 4 * hi; }
#define LDS_WAIT() asm volatile("s_waitcnt lgkmcnt(0)" ::: "memory")
DI int lane_fresh() { int r; asm volatile("v_mbcnt_lo_u32_b32 %0, -1, 0\n\tv_mbcnt_hi_u32_b32 %0, -1, %0" : "=v"(r)); return r; }
DI int launder_s(int x) { asm volatile("" : "+s"(x)); return x; }
DI int launder(int x) { asm volatile("" : "+v"(x)); return x; }

namespace pg8 {
#define PG8_LAS __attribute__((address_space(3)))
constexpr int BM = 256, BK = 64, HALF = 128, HTB = HALF * BK * 2, STAGE_BYTES = 8 * HTB, NXCD = 8, WGM = 8;
__host__ __device__ __forceinline__ int lds_byte(int r, int c) { const int st = (r >> 4) * 2 + (c >> 5), rr = r & 15, cc = c & 31, ob = rr * 64 + cc * 2; return st * 1024 + (ob ^ (((ob >> 9) & 1) << 5)); }
__host__ __device__ __forceinline__ void stage_rc(int b, int& R, int& C) { const int st = b / 1024, sb = b % 1024, swz = sb ^ (((sb >> 9) & 1) << 5); R = (st >> 1) * 16 + swz / 64; C = (st & 1) * 32 + (swz % 64) / 2; }
__host__ __device__ __forceinline__ int perm32(int rho) { const int n = rho >> 4, i = rho & 15; return 8 * (i >> 2) + 4 * n + (i & 3); }
struct Unit { int pm, pn; };
struct Gemm { const bf16_t* A; const bf16_t* Bt; int K; };

struct TileOrder {
    int nM, nN, nwg, G, c, n2, L0, Lend, pm0;
    __device__ void init(int nM_, int nN_, int G_, int c_, int n2_, int L0_ = 0, int Lend_ = 1 << 30, int pm0_ = 0) { nM = nM_; nN = nN_; nwg = nM * nN; G = G_; c = c_; n2 = n2_; L0 = L0_; Lend = Lend_; pm0 = pm0_; }
    __device__ bool next(int i, Unit& u) const {
        if (c < 0) return false;
        const int L = L0 + i * G + c;
        if (L >= Lend) return false;
        if (L < nwg) {
            int wgid = L; { const int q = nwg / NXCD, r = nwg % NXCD, xcd = wgid % NXCD, off = wgid / NXCD; wgid = (xcd < r ? xcd * (q + 1) : r * (q + 1) + (xcd - r) * q) + off; }
            const int nig = WGM * nN, gid = wgid / nig, fm = gid * WGM, gsz = (nM - fm) < WGM ? (nM - fm) : WGM;
            u.pm = pm0 + fm + ((wgid % nig) % gsz); u.pn = (wgid % nig) / gsz; return true;
        }
        const int L2 = L - nwg;
        if (L2 < n2) { u.pm = 128 + (L2 & 15); const int ci = L2 >> 4; u.pn = ci == 0 ? 0 : (ci < 3 ? ci + 2 : ci + 4); return true; }
        return false;
    }
};

template <class Epi, bool ALIGN_EPI>
__device__ __forceinline__ void gemm_phase(PG8_LAS unsigned char* lds, const Gemm g, const TileOrder& S, const Epi& E, const int wave_id) {
    const int lane = lane_fresh(), wid = launder_s(wave_id), tid = wid * 64 + lane, wr = wid >> 2, wc = wid & 3, fr = lane & 15, fq = lane >> 4;
    const int K = g.K, nt = K / BK;
    unsigned voffA[2], voffB[2];
#pragma unroll
    for (int i = 0; i < 2; ++i) { int R, C; stage_rc(tid * 16 + i * 8192, R, C); const int Rb = (R & ~31) + perm32(R & 31);
        voffA[i] = (unsigned)(R * K + C) * 2u; voffB[i] = (unsigned)(Rb * K + C) * 2u; }
    const size_t kstep = (size_t)(BK * 2);
    const size_t hstep = (size_t)HALF * K * 2;
    const size_t tstep = 2 * hstep;
    const unsigned ldsw = (unsigned)wid * 1024u;
    const int aoff = lds_byte(wr * 64 + fr, fq * 8), boff = lds_byte(wc * 32 + fr, fq * 8);
#define PG8_SA(b, h) (((b) * 2 + (h)) * HTB)
#define PG8_SB(b, h) ((4 + (b) * 2 + (h)) * HTB)
#define PG8_STAGE(bufoff, gbase, voff) do { _Pragma("unroll") for (int _i = 0; _i < 2; ++_i) \
        __builtin_amdgcn_global_load_lds((const unsigned*)((const char*)(gbase) + (voff)[_i]), (PG8_LAS unsigned*)(lds + (bufoff) + ldsw + _i * 8192), 16, 0, 0); } while (0)
#define PG8_LDA(dst, b, h) do { _Pragma("unroll") for (int m = 0; m < 4; ++m) _Pragma("unroll") for (int k = 0; k < 2; ++k) dst[m][k] = *(const PG8_LAS bf16x8*)(lds + PG8_SA(b, h) + aoff + m * 2048 + k * 1024); } while (0)
#define PG8_LDB(dst, b, h) do { _Pragma("unroll") for (int n = 0; n < 2; ++n) _Pragma("unroll") for (int k = 0; k < 2; ++k) dst[n][k] = *(const PG8_LAS bf16x8*)(lds + PG8_SB(b, h) + boff + n * 2048 + k * 1024); } while (0)
#define PG8_MMA(ai, bj, At, Bt) do { __builtin_amdgcn_s_setprio(1); _Pragma("unroll") for (int m = 0; m < 4; ++m) _Pragma("unroll") for (int n = 0; n < 2; ++n) _Pragma("unroll") for (int k = 0; k < 2; ++k) \
        acc[ai][bj][m][n] = __builtin_amdgcn_mfma_f32_16x16x32_bf16(Bt[n][k], At[m][k], acc[ai][bj][m][n], 0, 0, 0); __builtin_amdgcn_s_setprio(0); } while (0)
#define PG8_WAIT_V(n) asm volatile("s_waitcnt vmcnt(" #n ")" ::: "memory")
#define PG8_WAIT_L(n) asm volatile("s_waitcnt lgkmcnt(" #n ")" ::: "memory")
#define PG8_BAR __builtin_amdgcn_s_barrier()
#define PG8_SCHED __builtin_amdgcn_sched_barrier(0)
    Unit cur, nxt; int ui = 0;
    if (!S.next(0, cur)) return;
    f32x4 acc[2][2][4][2];
#pragma unroll
    for (int a = 0; a < 2; ++a)
#pragma unroll
        for (int b = 0; b < 2; ++b)
#pragma unroll
            for (int m = 0; m < 4; ++m)
#pragma unroll
                for (int n = 0; n < 2; ++n) acc[a][b][m][n] = (f32x4){0.f, 0.f, 0.f, 0.f};
    bf16x8 At[4][2], B0[2][2], B1[2][2];
    const char* cA = (const char*)g.A + (size_t)cur.pm * tstep; const char* cB = (const char*)g.Bt + (size_t)cur.pn * tstep;
    PG8_STAGE(PG8_SB(0, 0), cB, voffB); PG8_STAGE(PG8_SB(0, 1), cB + hstep, voffB); PG8_STAGE(PG8_SA(0, 0), cA, voffA); PG8_STAGE(PG8_SA(0, 1), cA + hstep, voffA);
    if (wr == 1) PG8_BAR;
    PG8_WAIT_V(2); PG8_BAR;
    PG8_STAGE(PG8_SB(1, 0), cB + kstep, voffB); PG8_STAGE(PG8_SA(1, 0), cA + kstep, voffA); PG8_STAGE(PG8_SB(1, 1), cB + hstep + kstep, voffB);
    PG8_WAIT_V(6); PG8_BAR;
    for (;;) {
        const bool has_next = S.next(ui + 1, nxt);
        const char* nA = has_next ? (const char*)g.A + (size_t)nxt.pm * tstep : cA; const char* nB = has_next ? (const char*)g.Bt + (size_t)nxt.pn * tstep : cB;
        for (int t = 0; t < nt; t += 2) {
            const bool last = (t == nt - 2);
            const char* a1 = cA + (size_t)(t + 1) * kstep;
            const char* a2 = last ? nA : cA + (size_t)(t + 2) * kstep; const char* b2 = last ? nB : cB + (size_t)(t + 2) * kstep;
            const char* a3 = a2 + kstep; const char* b3 = b2 + kstep;
            PG8_LDB(B0, 0, 0); PG8_LDB(B1, 0, 1); PG8_SCHED; PG8_LDA(At, 0, 0); PG8_STAGE(PG8_SA(1, 1), a1 + hstep, voffA);
            PG8_WAIT_V(8); PG8_WAIT_L(0); PG8_BAR; PG8_MMA(0, 0, At, B0); PG8_MMA(0, 1, At, B1); PG8_BAR; PG8_SCHED;
            PG8_LDA(At, 0, 1); PG8_STAGE(PG8_SB(0, 0), b2, voffB); PG8_STAGE(PG8_SB(0, 1), b2 + hstep, voffB); PG8_STAGE(PG8_SA(0, 0), a2, voffA);
            PG8_WAIT_V(8); PG8_WAIT_L(0); PG8_BAR; PG8_MMA(1, 0, At, B0); PG8_MMA(1, 1, At, B1); PG8_BAR; PG8_SCHED;
            PG8_LDB(B0, 1, 0); PG8_LDB(B1, 1, 1); PG8_SCHED; PG8_LDA(At, 1, 0); PG8_STAGE(PG8_SA(0, 1), a2 + hstep, voffA);
            PG8_WAIT_V(8); PG8_WAIT_L(0); PG8_BAR; PG8_MMA(0, 0, At, B0); PG8_MMA(0, 1, At, B1); PG8_BAR; PG8_SCHED;
            PG8_LDA(At, 1, 1); PG8_STAGE(PG8_SB(1, 0), b3, voffB); PG8_STAGE(PG8_SB(1, 1), b3 + hstep, voffB); PG8_STAGE(PG8_SA(1, 0), a3, voffA);
            PG8_WAIT_V(8); PG8_WAIT_L(0); PG8_BAR; PG8_MMA(1, 0, At, B0); PG8_MMA(1, 1, At, B1); PG8_BAR; PG8_SCHED;
        }
        if constexpr (ALIGN_EPI) { if (wr == 0) PG8_BAR; }
        E(acc, cur, wr, wc, fr, fq);
        if (!has_next) break;
#pragma unroll
        for (int a = 0; a < 2; ++a)
#pragma unroll
            for (int b = 0; b < 2; ++b)
#pragma unroll
                for (int m = 0; m < 4; ++m)
#pragma unroll
                    for (int n = 0; n < 2; ++n) acc[a][b][m][n] = (f32x4){0.f, 0.f, 0.f, 0.f};
        cur = nxt; cA = nA; cB = nB; ++ui;
        if constexpr (ALIGN_EPI) { if (wr == 1) PG8_BAR; }
    }
    PG8_WAIT_V(0);
    if constexpr (!ALIGN_EPI) { if (wr == 0) PG8_BAR; }
    PG8_BAR;
#undef PG8_SA
#undef PG8_SB
#undef PG8_STAGE
#undef PG8_LDA
#undef PG8_LDB
#undef PG8_MMA
#undef PG8_WAIT_V
#undef PG8_WAIT_L
#undef PG8_BAR
#undef PG8_SCHED
}

DI float row_rstd(const float* rowpart, int row) {
    const f32x4* rp = (const f32x4*)(rowpart + (size_t)row * 16);
    const f32x4 a = rp[0], b = rp[1], c = rp[2], d = rp[3];
    const float s = ((a.x + a.y) + (a.z + a.w)) + ((b.x + b.y) + (b.z + b.w)) + ((c.x + c.y) + (c.z + c.w)) + ((d.x + d.y) + (d.z + d.w));
    return __builtin_amdgcn_rsqf(s * (1.0f / DM) + EPS);
}
DI void row_rstd8(const float* rowpart, int row0, int fq, float (&rs)[2][4]) {
    f32x4 p[2][4];
#pragma unroll
    for (int ai = 0; ai < 2; ++ai)
#pragma unroll
        for (int m = 0; m < 4; ++m) p[ai][m] = *(const f32x4*)(rowpart + (size_t)(row0 + ai * HALF + m * 16) * 16 + 4 * fq);
#pragma unroll
    for (int ai = 0; ai < 2; ++ai)
#pragma unroll
        for (int m = 0; m < 4; ++m) { float s = (p[ai][m].x + p[ai][m].y) + (p[ai][m].z + p[ai][m].w); s += swz_xor<16>(s); s = half_sum(s); rs[ai][m] = __builtin_amdgcn_rsqf(s * (1.0f / DM) + EPS); }
}

struct EpiIn {
    bf16_t* U; const float* rowpart; const float* bias; const float* rope;
    __device__ __forceinline__ void operator()(const f32x4 (&acc)[2][2][4][2], const Unit& u, int wr, int wc, int fr, int fq) const {
        const bool isctx = u.pm >= 128; const int bidx = isctx ? 16 : (u.pm >> 3);
        const int kind = (u.pn == 5 || u.pn == 6) ? 1 : ((u.pn == 7 || u.pn == 8) ? 2 : 0);
        const bool dorope = (kind != 0) && !isctx;
        const float osc = (kind == 1) ? QSCALE : 1.0f;
        const int colb = u.pn * BM + wc * 32 + 8 * fq;
        const float* bp = bias + (size_t)bidx * NU + colb;
        const int row0 = u.pm * BM + wr * 64 + fr;
        float rs[2][4]; row_rstd8(rowpart, row0, fq, rs);
        f32x4 bv[2][2];
#pragma unroll
        for (int bj = 0; bj < 2; ++bj)
#pragma unroll
            for (int n = 0; n < 2; ++n) bv[bj][n] = *(const f32x4*)(bp + bj * HALF + 4 * n);
        f32x4 csn[4];
#define EPI_ROPE_LD(it_) do { const int t_ = (row0 + ((it_) >> 2) * HALF + ((it_) & 3) * 16) & (SEQ - 1); const int pos_ = (wc & 1) ? (t_ & 63) : (t_ >> 6); \
            const f32x4* rp_ = (const f32x4*)(rope + (size_t)(pos_ * 16 + 8 * (fq & 1)) * 2); csn[0] = rp_[0]; csn[1] = rp_[1]; csn[2] = rp_[2]; csn[3] = rp_[3]; } while (0)
        if (dorope) EPI_ROPE_LD(0);
#pragma unroll
        for (int it = 0; it < 8; ++it) {
            const int ai = it >> 2, m = it & 3;
            const int row = row0 + ai * HALF + m * 16;
            const float rstd = rs[ai][m];
            f32x4 cs[4];
            if (dorope) { cs[0] = csn[0]; cs[1] = csn[1]; cs[2] = csn[2]; cs[3] = csn[3]; if (it < 7) EPI_ROPE_LD(it + 1); }
            bf16_t* rowp = U + (size_t)row * NU + colb;
#pragma unroll
            for (int bj = 0; bj < 2; ++bj) {
                f32x4 v0 = acc[ai][bj][m][0] * rstd + bv[bj][0], v1 = acc[ai][bj][m][1] * rstd + bv[bj][1];
                if (kind != 0) {
                    float x[8] = {v0[0], v0[1], v0[2], v0[3], v1[0], v1[1], v1[2], v1[3]};
#pragma unroll
                    for (int i = 0; i < 8; ++i) {
                        float p; { auto r_ = __builtin_amdgcn_permlane32_swap(__float_as_uint(x[i]), __float_as_uint(x[i]), false, false); p = __uint_as_float(fq < 2 ? r_[1] : r_[0]); }
                        if (dorope) { const float co = cs[i >> 1][(i & 1) * 2], si = cs[i >> 1][(i & 1) * 2 + 1];
                            x[i] = (fq < 2) ? (x[i] * co - p * si) : (p * si + x[i] * co); }
                        x[i] *= osc;
                    }
                    v0 = (f32x4){x[0], x[1], x[2], x[3]}; v1 = (f32x4){x[4], x[5], x[6], x[7]};
                }
                if (u.pn == 1) {
#pragma unroll
                    for (int e = 0; e < 4; ++e) { v0[e] = gelu_tanh(v0[e]); v1[e] = gelu_tanh(v1[e]); } }
                u32x4 w; w.x = cvt_pk_bf16(v0[0], v0[1]); w.y = cvt_pk_bf16(v0[2], v0[3]); w.z = cvt_pk_bf16(v1[0], v1[1]); w.w = cvt_pk_bf16(v1[2], v1[3]);
                *(u32x4*)(rowp + bj * HALF) = w;
            }
            asm volatile("" ::: "memory");
        }
#undef EPI_ROPE_LD
    }
};

struct EpiRes {
    const void* hin_lat; const void* hin_ctx; void* hout_lat; void* hout_ctx; int in_bf16, out_bf16;
    const float* gate;
    bf16_t* HBo; const float* gnext; const float* scnext;
    float* rowpart;
    __device__ __forceinline__ void operator()(const f32x4 (&acc)[2][2][4][2], const Unit& u, int wr, int wc, int fr, int fq) const {
        const bool isctx = u.pm >= 128; const int bidx = isctx ? 16 : (u.pm >> 3);
        const int colb = u.pn * BM + wc * 32 + 8 * fq;
        const int row0 = u.pm * BM + wr * 64 + fr;
        const size_t eoff0 = (size_t)(isctx ? row0 - M_LAT : row0) * DM + colb;
        const char* hi0 = (const char*)(isctx ? hin_ctx : hin_lat) + eoff0 * (in_bf16 ? 2 : 4);
        char* ho0 = (char*)(isctx ? hout_ctx : hout_lat) + eoff0 * (out_bf16 ? 2 : 4);
        u32x4 hq[2][4];
#define EPI_H_LD(it_, slot_) do { const size_t ro_ = (size_t)(((it_) >> 2) * HALF + ((it_) & 3) * 16) * DM; \
            if (in_bf16) { const char* hp_ = hi0 + ro_ * 2; hq[slot_][0] = *(const u32x4*)(hp_); hq[slot_][1] = *(const u32x4*)(hp_ + HALF * 2); } \
            else { const char* hp_ = hi0 + ro_ * 4; hq[slot_][0] = *(const u32x4*)(hp_); hq[slot_][1] = *(const u32x4*)(hp_ + 16); hq[slot_][2] = *(const u32x4*)(hp_ + HALF * 4); hq[slot_][3] = *(const u32x4*)(hp_ + HALF * 4 + 16); } } while (0)
        EPI_H_LD(0, 0); EPI_H_LD(1, 1);
        f32x4 gv[2][2], gm[2][2];
#pragma unroll
        for (int bj = 0; bj < 2; ++bj)
#pragma unroll
            for (int n = 0; n < 2; ++n) {
                gv[bj][n] = *(const f32x4*)(gate + (size_t)bidx * 6144 + colb + bj * HALF + 4 * n);
                if (HBo) { const f32x4 g = *(const f32x4*)(gnext + colb + bj * HALF + 4 * n), sc4 = *(const f32x4*)(scnext + (size_t)bidx * 6144 + colb + bj * HALF + 4 * n); gm[bj][n] = g * (sc4 + 1.0f); }
                else gm[bj][n] = (f32x4){0.f, 0.f, 0.f, 0.f};
            }
#pragma unroll
        for (int it = 0; it < 8; ++it) {
            const int ai = it >> 2, m = it & 3;
            const int roff = ai * HALF + m * 16;
            f32x4 hc[4];
            if (in_bf16) {
#pragma unroll
                for (int bj = 0; bj < 2; ++bj) { const u32x4 w = hq[it & 1][bj]; hc[2 * bj] = (f32x4){bflo(w[0]), bfhi(w[0]), bflo(w[1]), bfhi(w[1])}; hc[2 * bj + 1] = (f32x4){bflo(w[2]), bfhi(w[2]), bflo(w[3]), bfhi(w[3])}; }
            } else {
#pragma unroll
                for (int q = 0; q < 4; ++q) hc[q] = __builtin_bit_cast(f32x4, hq[it & 1][q]);
            }
            if (it + 2 < 8) EPI_H_LD(it + 2, it & 1);
            float ss = 0.f;
#pragma unroll
            for (int bj = 0; bj < 2; ++bj) {
                const f32x4 n0 = hc[2 * bj] + gv[bj][0] * acc[ai][bj][m][0], n1 = hc[2 * bj + 1] + gv[bj][1] * acc[ai][bj][m][1];
                if (out_bf16) { u32x4 w; w.x = cvt_pk_bf16(n0[0], n0[1]); w.y = cvt_pk_bf16(n0[2], n0[3]); w.z = cvt_pk_bf16(n1[0], n1[1]); w.w = cvt_pk_bf16(n1[2], n1[3]);
                    *(u32x4*)(ho0 + ((size_t)roff * DM + bj * HALF) * 2) = w; }
                else { float* ho_ = (float*)(ho0 + ((size_t)roff * DM + bj * HALF) * 4); *(f32x4*)ho_ = n0; *(f32x4*)(ho_ + 4) = n1; }
                ss += (n0[0] * n0[0] + n0[1] * n0[1]) + (n0[2] * n0[2] + n0[3] * n0[3]) + (n1[0] * n1[0] + n1[1] * n1[1]) + (n1[2] * n1[2] + n1[3] * n1[3]);
                if (HBo) { const f32x4 p0 = n0 * gm[bj][0], p1 = n1 * gm[bj][1];
                    u32x4 w; w.x = cvt_pk_bf16(p0[0], p0[1]); w.y = cvt_pk_bf16(p0[2], p0[3]); w.z = cvt_pk_bf16(p1[0], p1[1]); w.w = cvt_pk_bf16(p1[2], p1[3]);
                    *(u32x4*)(HBo + (size_t)(row0 + roff) * DM + colb + bj * HALF) = w; }
            }
            ss += swz_xor<16>(ss); ss = half_sum(ss);
            if (fq == 0) rowpart[(size_t)(row0 + roff) * 16 + u.pn * 4 + wc] = ss;
            asm volatile("" ::: "memory");
        }
#undef EPI_H_LD
    }
};

struct EpiGLU {
    bf16_t* HID; const float* rowpart; const float* bias;
    __device__ __forceinline__ void operator()(const f32x4 (&acc)[2][2][4][2], const Unit& u, int wr, int wc, int fr, int fq) const {
        const bool isctx = u.pm >= 128; const int bidx = isctx ? 16 : (u.pm >> 3);
        const float* bp = bias + (size_t)bidx * NGU + u.pn * BM + wc * 32 + 8 * fq;
        const int row0 = u.pm * BM + wr * 64 + fr;
        float rs[2][4]; row_rstd8(rowpart, row0, fq, rs);
        f32x4 bv[2][2];
#pragma unroll
        for (int bj = 0; bj < 2; ++bj)
#pragma unroll
            for (int n = 0; n < 2; ++n) bv[bj][n] = *(const f32x4*)(bp + bj * HALF + 4 * n);
#pragma unroll
        for (int ai = 0; ai < 2; ++ai)
#pragma unroll
            for (int m = 0; m < 4; ++m) {
                const int row = row0 + ai * HALF + m * 16;
                const float rstd = rs[ai][m];
                u32x4 w;
#pragma unroll
                for (int n = 0; n < 2; ++n)
#pragma unroll
                    for (int hh = 0; hh < 2; ++hh) {
                        const f32x2 ag = {acc[ai][0][m][n][2 * hh], acc[ai][0][m][n][2 * hh + 1]}, au = {acc[ai][1][m][n][2 * hh], acc[ai][1][m][n][2 * hh + 1]};
                        const f32x2 bg = {bv[0][n][2 * hh], bv[0][n][2 * hh + 1]}, bu = {bv[1][n][2 * hh], bv[1][n][2 * hh + 1]};
                        const f32x2 g = ag * rstd + bg, uu = au * rstd + bu;
                        const f32x2 t = g * -1.4426950408889634f;
                        f32x2 d = {__builtin_amdgcn_exp2f(t.x), __builtin_amdgcn_exp2f(t.y)};
                        d = d + 1.0f;
                        const f32x2 r = {__builtin_amdgcn_rcpf(d.x), __builtin_amdgcn_rcpf(d.y)};
                        const f32x2 o = (g * r) * uu;
                        w[2 * n + hh] = cvt_pk_bf16(o.x, o.y);
                    }
                *(u32x4*)(HID + (size_t)row * DFF + u.pn * HALF + wc * 32 + 8 * fq) = w;
            }
    }
};
}

DI void transpose_item(const float* W, int ldw, int col0, bf16_t* WT, int K, int dstrow0, int k0, LAS float* scr, int lane) {
    f32x4 v[8];
#pragma unroll
    for (int i = 0; i < 8; ++i) { const int kk = 8 * i + (lane >> 3); v[i] = *(const f32x4*)(W + (size_t)(k0 + kk) * ldw + col0 + (lane & 7) * 4); }
#pragma unroll
    for (int i = 0; i < 8; ++i) { const int kk = 8 * i + (lane >> 3); LAS float* d = scr + kk * 33 + (lane & 7) * 4; d[0] = v[i].x; d[1] = v[i].y; d[2] = v[i].z; d[3] = v[i].w; }
    LDS_WAIT();
    const int c = lane & 7;
#pragma unroll
    for (int j = 0; j < 4; ++j) { const int n = (lane >> 3) + 8 * j; const LAS float* s = scr + (8 * c) * 33 + n;
        u32x4 o; o.x = f2bf(s[0]) | (f2bf(s[33]) << 16); o.y = f2bf(s[2 * 33]) | (f2bf(s[3 * 33]) << 16); o.z = f2bf(s[4 * 33]) | (f2bf(s[5 * 33]) << 16); o.w = f2bf(s[6 * 33]) | (f2bf(s[7 * 33]) << 16);
        *(u32x4*)(WT + (size_t)(dstrow0 + n) * K + k0 + 8 * c) = o; }
    LDS_WAIT();
}

DI void split_bf16x8(const float (&x)[8], bf16x8& h, bf16x8& r) {
    u32x4 hh, rr;
#pragma unroll
    for (int j = 0; j < 4; ++j) { const unsigned h0 = f2bf(x[2 * j]), h1 = f2bf(x[2 * j + 1]); hh[j] = h0 | (h1 << 16);
        rr[j] = f2bf(x[2 * j] - bf2f(h0)) | (f2bf(x[2 * j + 1] - bf2f(h1)) << 16); }
    h = __builtin_bit_cast(bf16x8, hh); r = __builtin_bit_cast(bf16x8, rr);
}
DI void gemv17(LAS float* A, LAS float* red, const float* W, int ldw, int col0, int ncols, float* out, int ldo, int oc0, const float* addv, int tid) {
    const int lane = tid & 63, ks = __builtin_amdgcn_readfirstlane(tid >> 6), r32 = lane & 31, hi = lane >> 5;
    f32x16 c0 = {}, c1 = {};
    const int cA = (r32 < ncols ? r32 : 0), cB = (32 + r32 < ncols ? 32 + r32 : 0);
    const float* wp = W + (size_t)(ks * 128 + 8 * hi) * ldw + col0;
    const LAS float* ap = A + (r32 < 17 ? r32 : 0) * 1024 + ks * 128 + hi * 8;
    for (int kk = 0; kk < 8; ++kk) {
        float av[8], w0[8], w1[8];
        { const f32x4 a0 = *(const LAS f32x4*)(ap + kk * 16), a1 = *(const LAS f32x4*)(ap + kk * 16 + 4);
          const bool live = r32 < 17;
#pragma unroll
          for (int j = 0; j < 4; ++j) { av[j] = live ? a0[j] : 0.f; av[4 + j] = live ? a1[j] : 0.f; } }
#pragma unroll
        for (int j = 0; j < 8; ++j) { const float* wr = wp + (size_t)(kk * 16 + j) * ldw; w0[j] = wr[cA]; w1[j] = wr[cB]; }
        bf16x8 ah, al, w0h, w0l, w1h, w1l;
        split_bf16x8(av, ah, al); split_bf16x8(w0, w0h, w0l); split_bf16x8(w1, w1h, w1l);
        c0 = __builtin_amdgcn_mfma_f32_32x32x16_bf16(ah, w0h, c0, 0, 0, 0); c1 = __builtin_amdgcn_mfma_f32_32x32x16_bf16(ah, w1h, c1, 0, 0, 0);
        c0 = __builtin_amdgcn_mfma_f32_32x32x16_bf16(ah, w0l, c0, 0, 0, 0); c1 = __builtin_amdgcn_mfma_f32_32x32x16_bf16(ah, w1l, c1, 0, 0, 0);
        c0 = __builtin_amdgcn_mfma_f32_32x32x16_bf16(al, w0h, c0, 0, 0, 0); c1 = __builtin_amdgcn_mfma_f32_32x32x16_bf16(al, w1h, c1, 0, 0, 0);
    }
#pragma unroll
    for (int r = 0; r < 16; ++r) { const int row = crow(r, hi); if (row < 17) { red[(ks * 17 + row) * 64 + r32] = c0[r]; red[(ks * 17 + row) * 64 + 32 + r32] = c1[r]; } }
    __syncthreads();
    for (int o = tid; o < 17 * 64; o += 512) { const int b = o >> 6, cc = o & 63;
        if (cc < ncols) { float s_ = 0.f;
#pragma unroll
            for (int k = 0; k < 8; ++k) s_ += red[(k * 17 + b) * 64 + cc];
            if (addv) s_ += addv[cc];
            out[(size_t)b * ldo + oc0 + cc] = s_; } }
    __syncthreads();
}


#define PRB_T0() const unsigned long long prb_t0_ = (PROBE_SEC_A | PROBE_SEC_B) ? __builtin_amdgcn_s_memrealtime() : 0ull
#define PRB_ADD(sec, wsptr) do { if ((PROBE_SEC_A | PROBE_SEC_B) != 0 && blockIdx.x == PROBE_BLOCK && tid_u == 0) { const unsigned long long d_ = __builtin_amdgcn_s_memrealtime() - prb_t0_; \
        unsigned long long* pa_ = (unsigned long long*)((wsptr) + 32768); if ((sec) == PROBE_SEC_A) pa_[40] += d_; if ((sec) == PROBE_SEC_B) pa_[41] += d_; } } while (0)
DI int swz128(int row, int piece) { return row * 128 + ((piece ^ ((row >> 1) & 7)) << 4); }
DI int tr64_st(int k, int c) { return ((k >> 3) * 2 + (c >> 5)) * 512 + ((k & 7) * 32 + (c & 31)) * 2; }
DI int tr_rd_base(int lane) { return ((lane & 3) << 3) | (((lane >> 2) & 3) << 6) | (((lane >> 4) & 1) << 5) | (((lane >> 5) & 1) << 8); }
template <int OFF> DI s16x4 tr_read_g(int vb) { s16x4 r; asm volatile("ds_read_b64_tr_b16 %0, %1 offset:%2" : "=&v"(r) : "v"(vb), "i"(OFF) : "memory"); return r; }
#define PKV(L, H) (bf16x8){L[0], L[1], L[2], L[3], H[0], H[1], H[2], H[3]}
#define PK4G(P, BASE, OUT) do { u32x4 w = {cvt_pk_bf16(P[BASE + 0], P[BASE + 1]), cvt_pk_bf16(P[BASE + 2], P[BASE + 3]), cvt_pk_bf16(P[BASE + 4], P[BASE + 5]), cvt_pk_bf16(P[BASE + 6], P[BASE + 7])}; \
    OUT = __builtin_bit_cast(bf16x8, w); } while (0)

DI void rg_unit(const KA a, LAS unsigned char* lds, int l, int b, int hd, int half, int tid_in) {
    const int tid_u = launder(tid_in);
    const int lane_u = tid_u & 63, wid = __builtin_amdgcn_readfirstlane(tid_u >> 6);
    LAS unsigned char* XCT = lds;
    LAS float* AA = (LAS float*)(lds + 32768);
    LAS float* BX = (LAS float*)(lds + 65536);
    LAS bf16_t* GT = (LAS bf16_t*)(lds + 98304);
    LAS bf16_t* RT = (LAS bf16_t*)(lds + 114688);
    LAS float* SUB = (LAS float*)(lds + 131072);
    LAS float* START = SUB + 1024;
    LAS float* CARRY = START + 512;
    unsigned char* ws = a.ws();
    const bf16_t* U = (const bf16_t*)(ws + WS_U); const bf16_t* XC = (const bf16_t*)(ws + WS_XC); bf16_t* RGS = (bf16_t*)(ws + WS_RGS); bf16_t* MIX = (bf16_t*)(ws + WS_MIX);
    const int chb = hd * 64 + 32 * half;
    PRB_T0(); const unsigned long long prb_unit0_ = prb_t0_;
    for (int dir = 0; dir < 2; ++dir) {
        const int cj = 32 * half + (lane_u & 31), hi0 = lane_u >> 5;
        const float* wa = a.in(I_RGWA) + (size_t)((l * 2 + dir) * 4 + hd) * 4096;
        const float* wx = a.in(I_RGWX) + (size_t)((l * 2 + dir) * 4 + hd) * 4096;
        bf16x8 wfa[4], wfx[4];
#pragma unroll
        for (int ks = 0; ks < 4; ++ks) {
            u32x4 pa, px;
#pragma unroll
            for (int jj = 0; jj < 4; ++jj) { const int i0 = 16 * ks + 8 * hi0 + 2 * jj;
                pa[jj] = f2bf(wa[i0 * 64 + cj]) | (f2bf(wa[(i0 + 1) * 64 + cj]) << 16);
                px[jj] = f2bf(wx[i0 * 64 + cj]) | (f2bf(wx[(i0 + 1) * 64 + cj]) << 16); }
            wfa[ks] = __builtin_bit_cast(bf16x8, pa); wfx[ks] = __builtin_bit_cast(bf16x8, px);
        }
        const float ba = a.in(I_RGBA)[(size_t)(l * 2 + dir) * 256 + hd * 64 + cj], bxb = a.in(I_RGBX)[(size_t)(l * 2 + dir) * 256 + hd * 64 + cj];
        const float sp8 = -8.0f * softplusf_(-a.in(I_RGLAM)[(size_t)(l * 2 + dir) * 256 + hd * 64 + cj]);
        if (tid_u < 32) CARRY[tid_u] = 0.f;
#define RG_ROWBASE(blk) ((blk) == 0 ? M_LAT + b * CTXL : b * SEQ + (dir ? 8 - (blk) : (blk) - 1) * 256)
#define RG_DMA_XC(blk) do { const int rb_ = RG_ROWBASE(blk); _Pragma("unroll") for (int k_ = 0; k_ < 4; ++k_) { const int row_ = 8 * (4 * wid + k_) + (lane >> 3), pc_ = (lane & 7) ^ ((row_ >> 1) & 7); \
            __builtin_amdgcn_global_load_lds((const unsigned*)(XC + (size_t)(rb_ + row_) * 256 + hd * 64 + 8 * pc_), (LAS unsigned*)(XCT + (4 * wid + k_) * 1024), 16, 0, 0); } } while (0)
        { const int lane = lane_u; RG_DMA_XC(0); }
        for (int blk = 0; blk < 9; ++blk) {
            const int lane = launder(lane_u), r32 = lane & 31, hi = lane >> 5, tid = wid * 64 + lane, c = tid & 31, s = tid >> 5;
            const int rowbase = RG_ROWBASE(blk);
            const bool need = (blk != 0) || (l == 0);
            { PRB_T0();
            if (blk == 0) asm volatile("s_waitcnt vmcnt(0)" ::: "memory");
            __syncthreads();
            PRB_ADD(11, ws); }
            if (dir == 1 && need) {
#pragma unroll
                for (int k = 0; k < 2; ++k) { const int row = 16 * (2 * wid + k) + (lane >> 2), pc = lane & 3;
                    __builtin_amdgcn_global_load_lds((const unsigned*)(U + (size_t)(rowbase + row) * NU + C_RGG + chb + 8 * pc), (LAS unsigned*)((LAS unsigned char*)GT + (2 * wid + k) * 1024), 16, 0, 0);
                    __builtin_amdgcn_global_load_lds((const unsigned*)(RGS + (size_t)(rowbase + row) * 256 + chb + 8 * pc), (LAS unsigned*)((LAS unsigned char*)RT + (2 * wid + k) * 1024), 16, 0, 0); }
            }
            float av[16], bxv[16];
            { PRB_T0();
            { f32x16 za = {}, zx = {}; const int row = 32 * wid + 16 * ((r32 >> 2) & 1) + 4 * (r32 >> 3) + (r32 & 3);
              bf16x8 af[4]; float xcv[16];
#pragma unroll
              for (int ks = 0; ks < 4; ++ks) af[ks] = *(const LAS bf16x8*)(XCT + swz128(row, 2 * ks + hi));
#pragma unroll
              for (int i = 0; i < 16; ++i) { const int tt = 32 * wid + 16 * hi + i; xcv[i] = bf2f(*(const LAS bf16_t*)(XCT + swz128(tt, cj >> 3) + (cj & 7) * 2)); }
              LDS_WAIT(); __syncthreads();
              if (blk + 1 < 9) RG_DMA_XC(blk + 1);
#pragma unroll
              for (int ks = 0; ks < 4; ++ks) { za = __builtin_amdgcn_mfma_f32_32x32x16_bf16(af[ks], wfa[ks], za, 0, 0, 0); zx = __builtin_amdgcn_mfma_f32_32x32x16_bf16(af[ks], wfx[ks], zx, 0, 0, 0); }
#pragma unroll
              for (int i = 0; i < 16; ++i) {
                  const float ea = 1.0f + __expf(-(za[i] + ba)), ex = 1.0f + __expf(-(zx[i] + bxb)); const float inv = rcpf_(ea * ex);
                  const float r = inv * ex, ig = inv * ea;
                  const float la = sp8 * r;
                  const float a_ = __expf(la); av[i] = a_; bxv[i] = __builtin_amdgcn_sqrtf(fmaxf(1.0f - a_ * a_, 0.f)) * (ig * xcv[i]); } }
            PRB_ADD(12, ws); }
            { PRB_T0();
            { float Ap = 1.f, Hh = 0.f;
              if (dir == 0) {
#pragma unroll
                  for (int k = 0; k < 16; ++k) { Hh = av[k] * Hh + bxv[k]; Ap *= av[k]; }
              } else {
#pragma unroll
                  for (int k = 15; k >= 0; --k) { Hh = av[k] * Hh + bxv[k]; Ap *= av[k]; }
              }
              SUB[(s * 32 + c) * 2] = Ap; SUB[(s * 32 + c) * 2 + 1] = Hh; }
            __syncthreads();
            PRB_ADD(13, ws); }
            { PRB_T0();
            if (tid < 32) { float carry = CARRY[tid];
#pragma unroll
                for (int si = 0; si < 16; ++si) { const int s2 = dir ? 15 - si : si; START[s2 * 32 + tid] = carry; carry = SUB[(s2 * 32 + tid) * 2] * carry + SUB[(s2 * 32 + tid) * 2 + 1]; }
                CARRY[tid] = carry; }
            asm volatile("s_waitcnt vmcnt(0)" ::: "memory");
            __syncthreads();
            PRB_ADD(14, ws); }
            { PRB_T0();
            { float h = START[s * 32 + c];
#define RG_APPLY(k) do { const int tt = 16 * s + (k); h = av[k] * h + bxv[k]; \
                  if (need) { const size_t row = (size_t)(rowbase + tt); \
                      if (dir == 0) RGS[row * 256 + chb + c] = (bf16_t)cvt_pk_bf16(h, h); \
                      else { const float y = (bf2f(RT[tt * 32 + c]) + h) * bf2f(GT[tt * 32 + c]); MIX[row * DM + chb + c] = (bf16_t)cvt_pk_bf16(y, y); } } } while (0)
              if (dir == 0) {
#pragma unroll
                  for (int k = 0; k < 16; ++k) RG_APPLY(k);
              } else {
#pragma unroll
                  for (int k = 15; k >= 0; --k) RG_APPLY(k);
              }
#undef RG_APPLY
            }
            PRB_ADD(15, ws); }
        }
        asm volatile("s_waitcnt vmcnt(0)" ::: "memory"); __syncthreads();
#undef RG_ROWBASE
#undef RG_DMA_XC
    }
    { const unsigned long long prb_t0_ = prb_unit0_; PRB_ADD(16, ws); }
}

DI void ssd_unit(const KA a, LAS unsigned char* lds, int l, int b, int head, int dir, int tid_in) {
    const int tid_u = launder(tid_in);
    const int lane_u = tid_u & 63, wid = __builtin_amdgcn_readfirstlane(tid_u >> 6);
    LAS unsigned char* BD = lds + 98304; LAS unsigned char* HL = lds + 114688;
    unsigned char* ws = a.ws();
    const bf16_t* XA = (const bf16_t*)(ws + WS_XBCA); const float* CS = (const float*)(ws + WS_CS); const float* DTS = (const float*)(ws + WS_DTS);
    float* YS = (float*)(ws + WS_HB) + (size_t)dir * M_ALL * 256;
    const int grp = head >> 1, j8 = dir * 4 + head;
    const int lb = wid >> 1, ph = wid & 1;
    const int pb = (wid >> 1) & 1, nb = wid & 1;
    f32x16 Hreg = {};
    for (int i = tid_u; i < 2048; i += 512) ((LAS unsigned*)HL)[i] = 0u;
#define SSD_CHUNK(c) ((c) < 2 ? 256 + b * 2 + (dir ? 1 - (c) : (c)) : b * 16 + (dir ? 17 - (c) : (c) - 2))
#define SSD_DMA(c, buf) do { const int ci_ = SSD_CHUNK(c); const int row0_ = 128 * ci_; LAS unsigned char* db_ = lds + (buf) * 49152; \
        _Pragma("unroll") for (int e_ = 0; e_ < 2; ++e_) { \
            { const int srow_ = 8 * (2 * wid + e_) + (lane >> 3), pc_ = (lane & 7) ^ ((srow_ >> 1) & 7); const int grow_ = dir ? row0_ + 127 - srow_ : row0_ + srow_; \
              const bf16_t* src_ = XA + (size_t)grow_ * 512 + 256 + grp * 64 + 8 * pc_; \
              __builtin_amdgcn_global_load_lds((const unsigned*)src_, (LAS unsigned*)(db_ + (2 * wid + e_) * 1024), 16, 0, 0); \
              __builtin_amdgcn_global_load_lds((const unsigned*)(src_ + 128), (LAS unsigned*)(db_ + 16384 + (2 * wid + e_) * 1024), 16, 0, 0); } \
            { const int k_ = 8 * (2 * wid + e_) + ((lane & 31) >> 2), col_ = (lane >> 5) * 32 + (lane & 3) * 8; \
              const int grow_ = dir ? row0_ + 127 - k_ : row0_ + k_; \
              __builtin_amdgcn_global_load_lds((const unsigned*)(XA + (size_t)grow_ * 512 + head * 64 + col_), (LAS unsigned*)(db_ + 32768 + (2 * wid + e_) * 1024), 16, 0, 0); } } \
        if (wid < 4) { const float* sp_ = (wid < 2 ? CS : DTS) + ((size_t)ci_ * 8 + j8) * 128 + 64 * (wid & 1) + lane; \
            __builtin_amdgcn_global_load_lds((const unsigned*)sp_, (LAS unsigned*)(lds + 122880 + (buf) * 1024 + (wid >> 1) * 512 + (wid & 1) * 256), 4, 0, 0); } } while (0)
    PRB_T0(); const unsigned long long prb_unit0_ = prb_t0_;
    { const int lane = lane_u; SSD_DMA(0, 0); }
    for (int c = 0; c < 18; ++c) {
        const int lane = launder(lane_u), r32 = lane & 31, hi = lane >> 5, tid = wid * 64 + lane;
        const int buf = c & 1;
        { PRB_T0();
        if (c == 0) asm volatile("s_waitcnt vmcnt(0)" ::: "memory");
        __syncthreads();
        if (c + 1 < 18) SSD_DMA(c + 1, buf ^ 1);
        PRB_ADD(1, ws); }
        LAS unsigned char* BT = lds + buf * 49152; LAS unsigned char* CT = BT + 16384; LAS unsigned char* XT = BT + 32768;
        const LAS float* CSL = (const LAS float*)(lds + 122880 + buf * 1024); const LAS float* DTL = CSL + 128;
        const int row0 = 128 * SSD_CHUNK(c);
        const float cs_end = CSL[127];
        { PRB_T0();
#pragma unroll
        for (int e = 0; e < 2; ++e) { const int q = tid + 512 * e, sr = q >> 3, p8 = q & 7;
            const u32x4 x = *(const LAS u32x4*)(BT + swz128(sr, p8)); const float f = __expf(cs_end - CSL[sr]) * DTL[sr];
            u32x4 w;
#pragma unroll
            for (int t = 0; t < 4; ++t) w[t] = cvt_pk_bf16(bflo(x[t]) * f, bfhi(x[t]) * f);
            *(LAS u32x4*)(BD + tr64_st(sr, 8 * p8)) = w; }
        __syncthreads();
        PRB_ADD(2, ws); }
        { PRB_T0();
        {
            f32x16 accy = {}, acco = {};
            const float cs_l = CSL[32 * lb + r32];
            const int xb = (int)(uintptr_t)XT + tr_rd_base(lane) + ph * 512;
            bf16x8 cf[4];
#pragma unroll
            for (int ks = 0; ks < 4; ++ks) cf[ks] = *(const LAS bf16x8*)(CT + swz128(32 * lb + r32, 2 * ks + hi));
#pragma unroll
            for (int ks = 0; ks < 4; ++ks) { const bf16x8 hf = *(const LAS bf16x8*)(HL + swz128(32 * ph + r32, 2 * ks + hi)); acco = __builtin_amdgcn_mfma_f32_32x32x16_bf16(cf[ks], hf, acco, 0, 0, 0); }
            bf16x8 bfq[2][4]; f32x4 c4q[2][4], d4q[2][4]; s16x4 trq[2][4];
#define SSD_LD(sb_, S_) do { _Pragma("unroll") for (int ks = 0; ks < 4; ++ks) bfq[S_][ks] = *(const LAS bf16x8*)(BT + swz128(32 * (sb_) + r32, 2 * ks + hi)); \
                _Pragma("unroll") for (int q = 0; q < 4; ++q) { c4q[S_][q] = *(const LAS f32x4*)(CSL + 32 * (sb_) + 8 * q + 4 * hi); d4q[S_][q] = *(const LAS f32x4*)(DTL + 32 * (sb_) + 8 * q + 4 * hi); } \
                { const int xs_ = xb + (sb_) * 4096; trq[S_][0] = tr_read_g<0>(xs_); trq[S_][1] = tr_read_g<1024>(xs_); trq[S_][2] = tr_read_g<2048>(xs_); trq[S_][3] = tr_read_g<3072>(xs_); } } while (0)
            SSD_LD(0, 0);
#pragma unroll
            for (int sb = 0; sb < 4; ++sb) { if (sb <= lb) {
                constexpr int dummy_ = 0; (void)dummy_;
                const int S = sb & 1;
                asm volatile("s_waitcnt lgkmcnt(0)" ::: "memory"); __builtin_amdgcn_sched_barrier(0);
                f32x16 g = {};
#pragma unroll
                for (int ks = 0; ks < 4; ++ks) g = __builtin_amdgcn_mfma_f32_32x32x16_bf16(bfq[S][ks], cf[ks], g, 0, 0, 0);
                if (sb < 3) { if (sb + 1 <= lb) SSD_LD(sb + 1, (sb + 1) & 1); }
                __builtin_amdgcn_sched_barrier(0);
#pragma unroll
                for (int q = 0; q < 4; ++q) {
#pragma unroll
                    for (int e = 0; e < 4; ++e) { const int r = 4 * q + e, sl = 8 * q + 4 * hi + e; const float f = __expf(cs_l - c4q[S][q][e]) * d4q[S][q][e];
                        g[r] = (sb < lb || sl <= r32) ? g[r] * f : 0.f; } }
                bf16x8 pa0, pa1; PK4G(g, 0, pa0); PK4G(g, 8, pa1);
                accy = __builtin_amdgcn_mfma_f32_32x32x16_bf16(pa0, PKV(trq[S][0], trq[S][1]), accy, 0, 0, 0);
                accy = __builtin_amdgcn_mfma_f32_32x32x16_bf16(pa1, PKV(trq[S][2], trq[S][3]), accy, 0, 0, 0);
            } }
#undef SSD_LD
            asm volatile("s_waitcnt vmcnt(0)" ::: "memory");
            if (c >= 2 || l == 0) {
#pragma unroll
                for (int r = 0; r < 16; ++r) { const int ll = 32 * lb + crow(r, hi); const int grow = dir ? row0 + 127 - ll : row0 + ll;
                    YS[(size_t)grow * 256 + head * 64 + 32 * ph + r32] = accy[r] + __expf(CSL[ll]) * acco[r]; }
            }
        }
        PRB_ADD(3, ws); }
        { PRB_T0();
        if (wid < 4) {
            f32x16 sacc = {};
            const int xa = (int)(uintptr_t)XT + tr_rd_base(lane) + pb * 512, xbd = (int)(uintptr_t)BD + tr_rd_base(lane) + nb * 512;
#pragma unroll
            for (int kq = 0; kq < 4; ++kq) {
                const s16x4 al0 = tr_read_g<0>(xa + kq * 4096), ah0 = tr_read_g<1024>(xa + kq * 4096), al1 = tr_read_g<2048>(xa + kq * 4096), ah1 = tr_read_g<3072>(xa + kq * 4096);
                const s16x4 bl0 = tr_read_g<0>(xbd + kq * 4096), bh0 = tr_read_g<1024>(xbd + kq * 4096), bl1 = tr_read_g<2048>(xbd + kq * 4096), bh1 = tr_read_g<3072>(xbd + kq * 4096);
                asm volatile("s_waitcnt lgkmcnt(0)" ::: "memory"); __builtin_amdgcn_sched_barrier(0);
                sacc = __builtin_amdgcn_mfma_f32_32x32x16_bf16(PKV(al0, ah0), PKV(bl0, bh0), sacc, 0, 0, 0);
                sacc = __builtin_amdgcn_mfma_f32_32x32x16_bf16(PKV(al1, ah1), PKV(bl1, bh1), sacc, 0, 0, 0);
            }
            const float e_end = __expf(cs_end);
#pragma unroll
            for (int r = 0; r < 16; ++r) Hreg[r] = e_end * Hreg[r] + sacc[r];
        }
        __syncthreads();
        if (wid < 4) { const int n = 32 * nb + r32;
#pragma unroll
            for (int r = 0; r < 16; ++r) { const int p = 32 * pb + crow(r, hi); *(LAS bf16_t*)(HL + swz128(p, n >> 3) + (n & 7) * 2) = (bf16_t)f2bf(Hreg[r]); } }
        PRB_ADD(4, ws); }
    }
    { const unsigned long long prb_t0_ = prb_unit0_; PRB_ADD(5, ws); }
    asm volatile("s_waitcnt vmcnt(0)" ::: "memory"); __syncthreads();
    if (tid_u == 0) { __builtin_amdgcn_fence(__ATOMIC_RELEASE, "agent"); asm volatile("s_waitcnt vmcnt(0)" ::: "memory");
        __hip_atomic_fetch_add((unsigned*)(ws + WS_SSDCNT) + (l * 16 + b) * 64, 1u, __ATOMIC_RELAXED, __HIP_MEMORY_SCOPE_AGENT); }
#undef SSD_CHUNK
#undef SSD_DMA
}

template <int R> DI void ssd_combine_rows(const KA a, int l, int row0, int rstep, int nrows, int lane) {
    unsigned char* ws = a.ws();
    const bf16_t* U = (const bf16_t*)(ws + WS_U); const bf16_t* XA = (const bf16_t*)(ws + WS_XBCA); const float* YS = (const float*)(ws + WS_HB); bf16_t* MIX = (bf16_t*)(ws + WS_MIX);
    const int ch = 4 * lane, head = lane >> 4;
    u32x2 xx[R], zz[R]; f32x4 yf[R], yb[R];
#pragma unroll
    for (int r = 0; r < R; ++r) { const int row = row0 + r * rstep; if (row < nrows) {
        xx[r] = *(const u32x2*)(XA + (size_t)row * 512 + ch); zz[r] = *(const u32x2*)(U + (size_t)row * NU + C_SZ + ch);
        yf[r] = *(const f32x4*)(YS + (size_t)row * 256 + ch); yb[r] = *(const f32x4*)(YS + (size_t)M_ALL * 256 + (size_t)row * 256 + ch); } }
    const float dsk = a.in(I_SD)[l * 4 + head];
    const f32x4 g = *(const f32x4*)(a.in(I_SNG) + (size_t)l * 256 + ch);
#pragma unroll
    for (int r = 0; r < R; ++r) { const int row = row0 + r * rstep; if (row < nrows) {
        const float xv[4] = {bflo(xx[r][0]), bfhi(xx[r][0]), bflo(xx[r][1]), bfhi(xx[r][1])};
        const float z[4] = {bflo(zz[r][0]), bfhi(zz[r][0]), bflo(zz[r][1]), bfhi(zz[r][1])};
        float o[4]; float ss = 0.f;
#pragma unroll
        for (int e = 0; e < 4; ++e) { const float y = xv[e] * dsk + yf[r][e] + yb[r][e]; o[e] = y * siluf_(z[e]); ss += o[e] * o[e]; }
        ss = sum32(ss);
        const float rs = __builtin_amdgcn_rsqf(ss * (1.0f / 128.0f) + EPS);
        u32x2 w; w.x = cvt_pk_bf16(o[0] * rs * g[0], o[1] * rs * g[1]); w.y = cvt_pk_bf16(o[2] * rs * g[2], o[3] * rs * g[3]);
        *(u32x2*)(MIX + (size_t)row * DM + 256 + ch) = w; } }
}

DI void preconv_rows(const KA a, int l, int gw, int NGW, int lane) {
    unsigned char* ws = a.ws();
    const bf16_t* U = (const bf16_t*)(ws + WS_U); bf16_t* XA = (bf16_t*)(ws + WS_XBCA); bf16_t* XC = (bf16_t*)(ws + WS_XC);
    float ws8[4][8], bs8[8], wr4[4][4], br4[4];
#pragma unroll
    for (int j = 0; j < 4; ++j) { const f32x4 w0 = *(const f32x4*)(a.in(I_SCW) + (size_t)l * 2048 + j * 512 + 8 * lane), w1 = *(const f32x4*)(a.in(I_SCW) + (size_t)l * 2048 + j * 512 + 8 * lane + 4);
        const f32x4 r0 = *(const f32x4*)(a.in(I_RGCW) + (size_t)l * 1024 + j * 256 + 4 * lane);
#pragma unroll
        for (int e = 0; e < 4; ++e) { ws8[j][e] = w0[e]; ws8[j][4 + e] = w1[e]; wr4[j][e] = r0[e]; } }
    { const f32x4 b0 = *(const f32x4*)(a.in(I_SCB) + (size_t)l * 512 + 8 * lane), b1 = *(const f32x4*)(a.in(I_SCB) + (size_t)l * 512 + 8 * lane + 4), r0 = *(const f32x4*)(a.in(I_RGCB) + (size_t)l * 256 + 4 * lane);
#pragma unroll
      for (int e = 0; e < 4; ++e) { bs8[e] = b0[e]; bs8[4 + e] = b1[e]; br4[e] = r0[e]; } }
    for (int row0 = gw; row0 < M_ALL; row0 += 2 * NGW) {
        u32x4 x[2][4]; u32x2 y[2][4];
#pragma unroll
        for (int q = 0; q < 2; ++q) { const int row = row0 + q * NGW; if (row < M_ALL) {
            const bool isctx = row >= M_LAT; const int t = isctx ? (row - M_LAT) & (CTXL - 1) : row & (SEQ - 1); const int seglen = isctx ? CTXL : SEQ;
#pragma unroll
            for (int j = 0; j < 4; ++j) { const int ts = t + j - 2; x[q][j] = (u32x4){0u, 0u, 0u, 0u}; y[q][j] = (u32x2){0u, 0u};
                if (ts >= 0 && ts < seglen) { const bf16_t* up = U + (size_t)(row + j - 2) * NU; x[q][j] = *(const u32x4*)(up + C_XBC + 8 * lane); y[q][j] = *(const u32x2*)(up + C_RGX + 4 * lane); } } } }
#pragma unroll
        for (int q = 0; q < 2; ++q) { const int row = row0 + q * NGW; if (row < M_ALL) {
            float v[8], r[4];
#pragma unroll
            for (int e = 0; e < 8; ++e) v[e] = bs8[e];
#pragma unroll
            for (int e = 0; e < 4; ++e) r[e] = br4[e];
#pragma unroll
            for (int j = 0; j < 4; ++j) {
#pragma unroll
                for (int e = 0; e < 4; ++e) { v[2 * e] += ws8[j][2 * e] * bflo(x[q][j][e]); v[2 * e + 1] += ws8[j][2 * e + 1] * bfhi(x[q][j][e]); }
                r[0] += wr4[j][0] * bflo(y[q][j][0]); r[1] += wr4[j][1] * bfhi(y[q][j][0]); r[2] += wr4[j][2] * bflo(y[q][j][1]); r[3] += wr4[j][3] * bfhi(y[q][j][1]); }
            u32x4 w;
#pragma unroll
            for (int e = 0; e < 4; ++e) w[e] = cvt_pk_bf16(siluf_(v[2 * e]), siluf_(v[2 * e + 1]));
            *(u32x4*)(XA + (size_t)row * 512 + 8 * lane) = w;
            u32x2 w2; w2.x = cvt_pk_bf16(r[0], r[1]); w2.y = cvt_pk_bf16(r[2], r[3]);
            *(u32x2*)(XC + (size_t)row * 256 + 4 * lane) = w2; } }
    }
}
DI void ssd_chunk_scan(const KA a, int l, int ci, int lane) {
    unsigned char* ws = a.ws();
    const float* DT = (const float*)(ws + WS_DT); float* CS = (float*)(ws + WS_CS); float* DTS = (float*)(ws + WS_DTS);
    const int row0 = 128 * ci;
    const f32x4 d00 = *(const f32x4*)(DT + (size_t)(row0 + 2 * lane) * 8), d01 = *(const f32x4*)(DT + (size_t)(row0 + 2 * lane) * 8 + 4);
    const f32x4 d10 = *(const f32x4*)(DT + (size_t)(row0 + 2 * lane + 1) * 8), d11 = *(const f32x4*)(DT + (size_t)(row0 + 2 * lane + 1) * 8 + 4);
    const float dt0[8] = {d00[0], d00[1], d00[2], d00[3], d01[0], d01[1], d01[2], d01[3]}, dt1[8] = {d10[0], d10[1], d10[2], d10[3], d11[0], d11[1], d11[2], d11[3]};
#pragma unroll
    for (int j = 0; j < 8; ++j) {
        const float an = -__expf(a.in(I_SALOG)[l * 8 + j]);
        const float a0 = dt0[j] * an, a1 = dt1[j] * an;
        float incl = a0 + a1;
#pragma unroll
        for (int d = 1; d < 64; d <<= 1) { const float o = __builtin_bit_cast(float, __builtin_amdgcn_ds_bpermute((lane - d) << 2, __builtin_bit_cast(int, incl))); if (lane >= d) incl += o; }
        const float excl = incl - (a0 + a1);
        float* cs = CS + ((size_t)ci * 8 + j) * 128; float* ds = DTS + ((size_t)ci * 8 + j) * 128;
        if (j < 4) { cs[2 * lane] = excl + a0; cs[2 * lane + 1] = incl; ds[2 * lane] = dt0[j]; ds[2 * lane + 1] = dt1[j]; }
        else { const float tot = __builtin_bit_cast(float, __builtin_amdgcn_readlane(__builtin_bit_cast(int, incl), 63));
            cs[127 - 2 * lane] = tot - excl; cs[126 - 2 * lane] = tot - excl - a0; ds[127 - 2 * lane] = dt0[j]; ds[126 - 2 * lane] = dt1[j]; }
    }
}

namespace att {
constexpr int SHM_V = 16384, SHM_K = 16384;
constexpr float THR = 8.0f;
#define KSWZ(row, colB) ((row) * 256 + ((colB) ^ (((row) & 15) << 4)))
#define SBAR() __builtin_amdgcn_sched_barrier(0)
DI int v_st(int k, int c) { const int kk = (k & ~0xC) | ((k & 4) << 1) | ((k & 8) >> 1); return ((kk >> 3) * 4 + (c >> 5)) * 512 + ((kk & 7) * 32 + (c & 31)) * 2; }
DI int v_rd_base(int lane) { return ((lane & 3) << 3) | (((lane >> 2) & 3) << 6) | (((lane >> 4) & 1) << 5) | (((lane >> 5) & 1) << 8); }
constexpr int v_rd_off(int d0, int ks, int half) { return d0 * 512 + ks * 4096 + half * 2048; }
template <int OFF> DI s16x4 tr_read(int vb) { s16x4 r; asm volatile("ds_read_b64_tr_b16 %0, %1 offset:%2" : "=&v"(r) : "v"(vb), "i"(OFF) : "memory"); return r; }

template <int C> DI void qkt(f32x16& p0, f32x16& p1, const LAS char* Ks, const LAS char* Qs, int r32, int hi) {
    p0 = f32x16{}; p1 = f32x16{};
#pragma unroll
    for (int d = 0; d < 4; ++d) { const int d0 = 4 * C + d; const int cb = (d0 * 16 + hi * 8) * 2;
        const bf16x8 b0 = *(const LAS bf16x8*)(Ks + KSWZ(r32, cb));
        const bf16x8 b1 = *(const LAS bf16x8*)(Ks + KSWZ(32 + r32, cb));
        const bf16x8 q = *(const LAS bf16x8*)(Qs + KSWZ(r32, cb));
        p0 = __builtin_amdgcn_mfma_f32_32x32x16_bf16(b0, q, p0, 0, 0, 0);
        p1 = __builtin_amdgcn_mfma_f32_32x32x16_bf16(b1, q, p1, 0, 0, 0); }
}
DI void softmax_tile(f32x16& p0, f32x16& p1, float& m_reg, float& l_reg, float& alpha, bf16x8& pa0, bf16x8& pa1, bf16x8& pa2, bf16x8& pa3) {
    float pmax = p0[0];
#pragma unroll
    for (int r = 1; r < 16; ++r) pmax = fmaxf(pmax, p0[r]);
#pragma unroll
    for (int r = 0; r < 16; ++r) pmax = fmaxf(pmax, p1[r]);
    { auto rr = __builtin_amdgcn_permlane32_swap(__float_as_uint(pmax), __float_as_uint(pmax), false, false); pmax = fmaxf(__uint_as_float(rr[0]), __uint_as_float(rr[1])); }
    if (__builtin_expect(__all(pmax - m_reg <= THR), 1)) { alpha = 1.f; }
    else { const float mn = fmaxf(m_reg, pmax); alpha = __builtin_amdgcn_exp2f(m_reg - mn); m_reg = mn; }
    float ps = 0.f;
#pragma unroll
    for (int r = 0; r < 16; ++r) { p0[r] = __builtin_amdgcn_exp2f(p0[r] - m_reg); ps += p0[r]; }
#pragma unroll
    for (int r = 0; r < 16; ++r) { p1[r] = __builtin_amdgcn_exp2f(p1[r] - m_reg); ps += p1[r]; }
    { auto rr = __builtin_amdgcn_permlane32_swap(__float_as_uint(ps), __float_as_uint(ps), false, false); ps = __uint_as_float(rr[0]) + __uint_as_float(rr[1]); }
    l_reg = l_reg * alpha + ps;
#define PK4(P, BASE, OUT) do { u32x4 w = {cvt_pk_bf16(P[BASE + 0], P[BASE + 1]), cvt_pk_bf16(P[BASE + 2], P[BASE + 3]), cvt_pk_bf16(P[BASE + 4], P[BASE + 5]), cvt_pk_bf16(P[BASE + 6], P[BASE + 7])}; \
    OUT = __builtin_bit_cast(bf16x8, w); } while (0)
    PK4(p0, 0, pa0); PK4(p0, 8, pa1); PK4(p1, 0, pa2); PK4(p1, 8, pa3);
#undef PK4
}
template <int C> DI bool fast_comp(const LAS char* Ks, const LAS char* Qs, int r32, int hi, bool first, float& ps_out, bf16x8& pa0, bf16x8& pa1, bf16x8& pa2, bf16x8& pa3) {
    f32x16 p0, p1;
    qkt<C>(p0, p1, Ks, Qs, r32, hi);
    if (first) {
        float pmax = p0[0];
#pragma unroll
        for (int r = 1; r < 16; ++r) pmax = fmaxf(pmax, p0[r]);
#pragma unroll
        for (int r = 0; r < 16; ++r) pmax = fmaxf(pmax, p1[r]);
        { auto rr = __builtin_amdgcn_permlane32_swap(__float_as_uint(pmax), __float_as_uint(pmax), false, false); pmax = fmaxf(__uint_as_float(rr[0]), __uint_as_float(rr[1])); }
        if (!__all(__builtin_fabsf(pmax) <= 60.0f)) return false;
    }
    float ps = 0.f;
#pragma unroll
    for (int r = 0; r < 16; ++r) { p0[r] = __builtin_amdgcn_exp2f(p0[r]); ps += p0[r]; }
#pragma unroll
    for (int r = 0; r < 16; ++r) { p1[r] = __builtin_amdgcn_exp2f(p1[r]); ps += p1[r]; }
    { auto rr = __builtin_amdgcn_permlane32_swap(__float_as_uint(ps), __float_as_uint(ps), false, false); ps = __uint_as_float(rr[0]) + __uint_as_float(rr[1]); }
    if (!__all(ps <= 1.2676506e30f)) return false;
    ps_out = ps;
#define PK4(P, BASE, OUT) do { u32x4 w = {cvt_pk_bf16(P[BASE + 0], P[BASE + 1]), cvt_pk_bf16(P[BASE + 2], P[BASE + 3]), cvt_pk_bf16(P[BASE + 4], P[BASE + 5]), cvt_pk_bf16(P[BASE + 6], P[BASE + 7])}; \
    OUT = __builtin_bit_cast(bf16x8, w); } while (0)
    PK4(p0, 0, pa0); PK4(p0, 8, pa1); PK4(p1, 0, pa2); PK4(p1, 8, pa3);
#undef PK4
    return true;
}
template <int D0> DI void pv_one(f32x16& oa, f32x16& ob, int vb, const bf16x8 (&pa)[4], const bf16x8 (&pb)[4]) {
    const s16x4 l0 = tr_read<v_rd_off(D0, 0, 0)>(vb), h0 = tr_read<v_rd_off(D0, 0, 1)>(vb), l1 = tr_read<v_rd_off(D0, 1, 0)>(vb), h1 = tr_read<v_rd_off(D0, 1, 1)>(vb);
    const s16x4 l2 = tr_read<v_rd_off(D0, 2, 0)>(vb), h2 = tr_read<v_rd_off(D0, 2, 1)>(vb), l3 = tr_read<v_rd_off(D0, 3, 0)>(vb), h3 = tr_read<v_rd_off(D0, 3, 1)>(vb);
    asm volatile("s_waitcnt lgkmcnt(0)" ::: "memory"); SBAR();
#define PK(L, H) (bf16x8){L[0], L[1], L[2], L[3], H[0], H[1], H[2], H[3]}
    const bf16x8 v0 = PK(l0, h0), v1 = PK(l1, h1), v2 = PK(l2, h2), v3 = PK(l3, h3);
    oa = __builtin_amdgcn_mfma_f32_32x32x16_bf16(pa[0], v0, oa, 0, 0, 0); ob = __builtin_amdgcn_mfma_f32_32x32x16_bf16(pb[0], v0, ob, 0, 0, 0);
    oa = __builtin_amdgcn_mfma_f32_32x32x16_bf16(pa[1], v1, oa, 0, 0, 0); ob = __builtin_amdgcn_mfma_f32_32x32x16_bf16(pb[1], v1, ob, 0, 0, 0);
    oa = __builtin_amdgcn_mfma_f32_32x32x16_bf16(pa[2], v2, oa, 0, 0, 0); ob = __builtin_amdgcn_mfma_f32_32x32x16_bf16(pb[2], v2, ob, 0, 0, 0);
    oa = __builtin_amdgcn_mfma_f32_32x32x16_bf16(pa[3], v3, oa, 0, 0, 0); ob = __builtin_amdgcn_mfma_f32_32x32x16_bf16(pb[3], v3, ob, 0, 0, 0);
#undef PK
}

DI void attn_unit(LAS unsigned char* lds, const bf16_t* __restrict__ U, bf16_t* __restrict__ MIX, int qrow0, int lat0, int nlat, int ctx0, int nctx, int h,
                  float lam, int lsel, const float* __restrict__ subg, int tid_in) {
    const int tid = launder(tid_in);
    const int wid = __builtin_amdgcn_readfirstlane(tid >> 6), lane = tid & 63, r32 = lane & 31, hi = lane >> 5;
    LAS char* V_lds = (LAS char*)lds; LAS char* K_lds = (LAS char*)lds + 2 * SHM_V;
    LAS float* wsf = (LAS float*)(lds + 2 * SHM_V + 2 * SHM_K) + wid * 128;
    LAS char* Qs = (LAS char*)lds + 2 * SHM_V + 2 * SHM_K + 4096 + wid * 8192;
    float mA = 0.f, lA = 0.f, mB = 0.f, lB = 0.f;
    bool fast = true, anyslow = false;
    f32x16 oA[4] = {}, oB[4] = {};
    { const bf16_t* Qw = U + (size_t)(qrow0 + wid * 32 + r32) * NU + C_Q + h * 128 + hi * 8;
#pragma unroll
      for (int d0 = 0; d0 < 8; ++d0) *(LAS bf16x8*)(Qs + KSWZ(r32, (d0 * 16 + hi * 8) * 2)) = *(const bf16x8*)(Qw + d0 * 16); }
    const int vb0 = (int)(uintptr_t)V_lds + v_rd_base(lane);
    const int NT = nlat + nctx;
    unsigned offK[2], offV[2];
#pragma unroll
    for (int e = 0; e < 2; ++e) { const int row = 8 * wid + 4 * e + (lane >> 4), p = (lane & 15) ^ (row & 15); offK[e] = (unsigned)(row * NU + p * 8) * 2u;
        const int k = 8 * wid + ((lane & 31) >> 2), col = (2 * e + (lane >> 5)) * 32 + (lane & 3) * 8; offV[e] = (unsigned)(k * NU + col) * 2u; }
    const char* Ubase = (const char*)U + (size_t)h * 256;
#define KROW(j) ((j) < nlat ? lat0 + 64 * (j) : ctx0 + 64 * ((j) - nlat))
#define DMA_TILE(j, bsel) do { const char* tb_ = Ubase + (size_t)KROW(j) * (NU * 2); \
        _Pragma("unroll") for (int e_ = 0; e_ < 2; ++e_) { \
            __builtin_amdgcn_global_load_lds((const unsigned*)(tb_ + C_K * 2 + offK[e_]), (LAS unsigned*)(K_lds + (bsel) * SHM_K + (2 * wid + e_) * 1024), 16, 0, 0); \
            __builtin_amdgcn_global_load_lds((const unsigned*)(tb_ + C_V * 2 + offV[e_]), (LAS unsigned*)(V_lds + (bsel) * SHM_V + (2 * wid + e_) * 1024), 16, 0, 0); } } while (0)
    DMA_TILE(0, 0);
    asm volatile("s_waitcnt vmcnt(0)" ::: "memory"); __syncthreads();
    for (int j = 0; j < NT; ++j) {
        const int bsel = j & 1;
        if (j + 1 < NT) DMA_TILE(j + 1, bsel ^ 1);
        const LAS char* Ks = K_lds + bsel * SHM_K;
        bf16x8 pa[4], pb[4];
        bool done = false;
        if (fast) {
            float psA, psB;
            bool ok = fast_comp<0>(Ks, Qs, r32, hi, j == 0, psA, pa[0], pa[1], pa[2], pa[3]);
            if (ok) ok = fast_comp<1>(Ks, Qs, r32, hi, j == 0, psB, pb[0], pb[1], pb[2], pb[3]);
            if (ok) { lA += psA; lB += psB; done = true; } else fast = false;
        }
        if (!done) {
            f32x16 p0, p1; float alA, alB;
            const bool first = !anyslow && j == 0; anyslow = true;
            if (first) { mA = -1e30f; mB = -1e30f; }
            qkt<0>(p0, p1, Ks, Qs, r32, hi); softmax_tile(p0, p1, mA, lA, alA, pa[0], pa[1], pa[2], pa[3]);
            qkt<1>(p0, p1, Ks, Qs, r32, hi); softmax_tile(p0, p1, mB, lB, alB, pb[0], pb[1], pb[2], pb[3]);
            if (__any(alA < 1.f || alB < 1.f)) {
                const int ln = lane_fresh(), hr = ln >> 5;
                if (hr == 0) { wsf[ln & 31] = alA; wsf[32 + (ln & 31)] = alB; }
                LDS_WAIT();
#pragma unroll
                for (int r = 0; r < 16; ++r) { const float fa = wsf[crow(r, hr)], fb = wsf[32 + crow(r, hr)];
#pragma unroll
                    for (int d = 0; d < 4; ++d) { oA[d][r] *= fa; oB[d][r] *= fb; } }
            }
        }
        const int vb = vb0 + bsel * SHM_V;
        pv_one<0>(oA[0], oB[0], vb, pa, pb); pv_one<1>(oA[1], oB[1], vb, pa, pb); pv_one<2>(oA[2], oB[2], vb, pa, pb); pv_one<3>(oA[3], oB[3], vb, pa, pb);
        asm volatile("s_waitcnt vmcnt(0)" ::: "memory"); __syncthreads();
    }
#undef KROW
#undef DMA_TILE
    const int lane_e = lane_fresh(), r32e = lane_e & 31, hie = lane_e >> 5;
    if (hie == 0) { wsf[64 + r32e] = lA; wsf[96 + r32e] = lB; }
    LDS_WAIT();
    float ssq[16];
#pragma unroll
    for (int r = 0; r < 16; ++r) { const float ra = __builtin_amdgcn_rcpf(wsf[64 + crow(r, hie)]), rb = lam * __builtin_amdgcn_rcpf(wsf[96 + crow(r, hie)]);
        float s = 0.f;
#pragma unroll
        for (int d = 0; d < 4; ++d) { const float o = oA[d][r] * ra - oB[d][r] * rb; oA[d][r] = o; s += o * o; }
        ssq[r] = s; }
#pragma unroll
    for (int r = 0; r < 16; ++r) {
        ssq[r] = sum32(ssq[r]);
    }
    const float outscale = launder_s(lsel) == 0 ? 0.8f : 0.64449093f;
    float gsub[4];
#pragma unroll
    for (int d = 0; d < 4; ++d) gsub[d] = subg[32 * d + r32e] * outscale;
#pragma unroll
    for (int r = 0; r < 16; ++r) { const float rs = __builtin_amdgcn_rsqf(ssq[r] * (1.0f / 128.0f) + EPS);
        bf16_t* op = MIX + (size_t)(qrow0 + wid * 32 + crow(r, hie)) * DM + 512 + h * 128 + r32e;
#pragma unroll
        for (int d = 0; d < 4; ++d) op[32 * d] = (bf16_t)f2bf(oA[d][r] * rs * gsub[d]); }
    __syncthreads();
}
#undef KSWZ
#undef SBAR
}

#define XB_TMO      128
#define XB_XCNT(j)  (256  + 64 * (j))
#define XB_XSUB(j)  (1280 + 64 * (j))
#define XB_XGEN(j)  (2304 + 64 * (j))
#define XB_TOP      3328
#define XB_TOPGEN   3392
#define XCD_BAR_WORDS 3456
#define XB_SPIN_CAP (1u << 20)
DI unsigned xb_ld(unsigned* p)              { return __hip_atomic_load(p, __ATOMIC_RELAXED, __HIP_MEMORY_SCOPE_AGENT); }
DI unsigned xb_add(unsigned* p, unsigned v) { return __hip_atomic_fetch_add(p, v, __ATOMIC_RELAXED, __HIP_MEMORY_SCOPE_AGENT); }
DI unsigned xb_xcc_id() { return (unsigned)__builtin_amdgcn_s_getreg((3 << 11) | 20) & 0xFu; }
#define XB_SPIN(cond, bar) do { unsigned _sp = 0; while (cond) { __builtin_amdgcn_s_sleep(1); \
    if ((++_sp & 255u) == 0u) { if (xb_ld(&(bar)[XB_TMO])) break; if (_sp > XB_SPIN_CAP) { atomicAdd(&(bar)[XB_TMO], 1u); break; } } } } while (0)
struct XcdBarrier { unsigned* bar; unsigned x; volatile LAS unsigned* st; };
DI void xcd_barrier_complete(unsigned* bar, unsigned x, unsigned& nloc, unsigned& nx) {
    const unsigned G = gridDim.x;
    unsigned sum, cnt, mine, sp = 0u;
    for (;;) {
        sum = 0u; cnt = 0u; mine = 0u;
#pragma unroll
        for (unsigned j = 0; j < 16; ++j) { const unsigned c = xb_ld(&bar[XB_XCNT(j)]); sum += c; cnt += (c > 0u) ? 1u : 0u; mine = (j == x) ? c : mine; }
        if (sum == G) break;
        __builtin_amdgcn_s_sleep(1);
        if ((++sp & 255u) == 0u) { if (xb_ld(&bar[XB_TMO])) break; if (sp > XB_SPIN_CAP) { atomicAdd(&bar[XB_TMO], 1u); break; } }
    }
    nloc = mine > 0u ? mine : 1u; nx = cnt > 0u ? cnt : 1u;
}
DI void xcd_barrier(const XcdBarrier& b, int wave) {
    asm volatile("s_waitcnt vmcnt(0)" ::: "memory");
    __syncthreads();
    if (wave == 0 && lane_fresh() == 0) {
        unsigned* bar = b.bar;
        __builtin_amdgcn_s_waitcnt(0);
        unsigned nloc = b.st[0], nx = b.st[1];
        if (nloc == 0u) { xcd_barrier_complete(bar, b.x, nloc, nx); b.st[0] = nloc; b.st[1] = nx; }
        const unsigned old = xb_add(&bar[XB_XSUB(b.x)], 1u);
        const unsigned gen = old / nloc;
        if (old + 1u == (gen + 1u) * nloc) {
            __builtin_amdgcn_fence(__ATOMIC_RELEASE, "agent");
            asm volatile("s_waitcnt vmcnt(0)" ::: "memory");
            const unsigned og = xb_add(&bar[XB_TOP], 1u);
            const unsigned tg = og / nx;
            if (og + 1u == (tg + 1u) * nx) xb_add(&bar[XB_TOPGEN], 1u);
            else XB_SPIN(xb_ld(&bar[XB_TOPGEN]) == tg, bar);
            __builtin_amdgcn_fence(__ATOMIC_ACQUIRE, "agent");
            xb_add(&bar[XB_XGEN(b.x)], 1u);
            asm volatile("s_waitcnt vmcnt(0)" ::: "memory");
        } else {
            XB_SPIN(xb_ld(&bar[XB_XGEN(b.x)]) == gen, bar);
            __builtin_amdgcn_fence(__ATOMIC_ACQUIRE, "agent");
            asm volatile("s_waitcnt vmcnt(0)" ::: "memory");
        }
    }
    __syncthreads();
}

DI void convert_weights(const KA a, int l, int widx, int nw, int lane, LAS float* scr) {
    unsigned char* wl = a.ws() + WS_W + (size_t)l * W_LAYER;
    for (int it = widx; it < 6144; it += nw) { int r = it;
        if (r < 1408) { const int kb = r / 88, nb = r % 88, n0 = 32 * nb; transpose_item(a.in(I_WIN) + (size_t)l * 1024 * DIN, DIN, n0 < 1280 ? n0 : n0 + 8, (bf16_t*)(wl + W_IN), 1024, n0, 64 * kb, scr, lane); continue; } r -= 1408;
        if (r < 512) { const int kb = r / 32, nb = r % 32; transpose_item(a.in(I_WOUT) + (size_t)l * 1024 * 1024, 1024, 32 * nb, (bf16_t*)(wl + W_OUT), 1024, 32 * nb, 64 * kb, scr, lane); continue; } r -= 512;
        if (r < 2816) { const int kb = r / 176, nb = r % 176, n0 = 32 * nb, pn = n0 >> 8, bj = (n0 >> 7) & 1, j = n0 & 127;
            transpose_item((bj ? a.in(I_WUP) : a.in(I_WGATE)) + (size_t)l * 1024 * DFF, DFF, 128 * pn + j, (bf16_t*)(wl + W_GU), 1024, n0, 64 * kb, scr, lane); continue; } r -= 2816;
        { const int kb = r / 32, nb = r % 32; transpose_item(a.in(I_WDOWN) + (size_t)l * DFF * 1024, 1024, 32 * nb, (bf16_t*)(wl + W_DOWN), DFF, 32 * nb, 64 * kb, scr, lane); }
    }
}
DI void bias_items(const KA a, int l, int bidx, int nb, int tid, LAS unsigned char* lds) {
    unsigned char* ws = a.ws();
    const float* MOD = (const float*)(ws + WS_MOD); float* BIAS_IN = (float*)(ws + WS_BIAS_IN); float* BIAS_DT = (float*)(ws + WS_BIAS_DT); float* BIAS_GU = (float*)(ws + WS_BIAS_GU);
    LAS float* A = (LAS float*)lds; LAS float* red = (LAS float*)(lds + 73728);
    for (int r = bidx; r < 133; r += nb) { const int chunk = r < 45 ? 0 : 3;
#pragma unroll
        for (int q = 0; q < 9; ++q) { const int i4 = tid + 512 * q; if (i4 < 17 * 256) { const int b = i4 >> 8, k = (i4 & 255) * 4;
            *(LAS f32x4*)(A + i4 * 4) = *(const f32x4*)(MOD + (size_t)l * 17 * 6144 + (size_t)b * 6144 + chunk * 1024 + k); } }
        __syncthreads();
        if (r < 44) gemv17(A, red, a.in(I_WIN) + (size_t)l * 1024 * DIN, DIN, (64 * r < 1280 ? 64 * r : 64 * r + 8), 64, BIAS_IN + (size_t)l * 17 * NU, NU, 64 * r, nullptr, tid);
        else if (r == 44) gemv17(A, red, a.in(I_WIN) + (size_t)l * 1024 * DIN, DIN, 1280, 8, BIAS_DT + (size_t)l * 17 * 8, 8, 0, nullptr, tid);
        else { const int n0 = 64 * (r - 45), pn = n0 >> 8, bj = (n0 >> 7) & 1, j = n0 & 127;
            gemv17(A, red, (bj ? a.in(I_WUP) : a.in(I_WGATE)) + (size_t)l * 1024 * DFF, DFF, 128 * pn + j, 64, BIAS_GU + (size_t)l * 17 * NGU, NGU, n0, nullptr, tid); }
    }
}

__global__ void __launch_bounds__(512) hybrid_fwd(Args args_unused) {
    extern __shared__ __attribute__((aligned(16))) unsigned char lds_raw[];
    LAS unsigned char* lds = (LAS unsigned char*)lds_raw;
    const int wave0 = __builtin_amdgcn_readfirstlane((int)threadIdx.x >> 6);
    const int G = gridDim.x, bid = blockIdx.x;
    const int vcu = (G % 8 == 0) ? (bid % 8) * (G / 8) + bid / 8 : bid;
    const int NGW = G * 8;
    const bool vcu_is_bid = true;
#define PHASE_IDS() const KA a = ka_fresh(); unsigned char* const ws = a.ws(); const int lane = lane_fresh(), wave = launder_s(wave0), tid = wave * 64 + lane, gw = vcu * 8 + wave; (void)tid; (void)gw; (void)ws
    {
        const KA a = ka_fresh(); unsigned* bar = (unsigned*)a.ws(); const unsigned x = (unsigned)__builtin_amdgcn_readfirstlane((int)xb_xcc_id());
        volatile LAS unsigned* st = (volatile LAS unsigned*)(lds + 143360);
        if (threadIdx.x == 0) { st[0] = 0u; st[1] = 0u; (void)xb_add(&bar[XB_XCNT(x)], 1u); }
        __syncthreads();
    }
    int n_stamp = 0;
#define STAMP() do { if (PROBE_MASK != 0u) { if (blockIdx.x == 0 && threadIdx.x == 0) { const KA as_ = ka_fresh(); ((unsigned long long*)(as_.ws() + 32768))[n_stamp] = __builtin_amdgcn_s_memrealtime(); } ++n_stamp; } } while (0)
#define GRID_BAR() do { const KA a_ = ka_fresh(); XcdBarrier xb_; xb_.bar = (unsigned*)a_.ws(); xb_.x = (unsigned)__builtin_amdgcn_readfirstlane((int)xb_xcc_id()); xb_.st = (volatile LAS unsigned*)(lds + 143360); \
        xcd_barrier(xb_, launder_s(wave0)); STAMP(); } while (0)

    for (int rep0 = 0; rep0 < REP_P0; ++rep0) {
    STAMP();
    {
        PHASE_IDS();
        float* MOD = (float*)(ws + WS_MOD); float* ROPE = (float*)(ws + WS_ROPE); float* WDT = (float*)(ws + WS_WDT);
        LAS float* A = (LAS float*)lds; LAS float* red = (LAS float*)(lds + 73728);
        for (int it = bid; it < 2 * 96; it += G) { const int l = it / 96, cb = it % 96;
#pragma unroll
            for (int q = 0; q < 9; ++q) { const int i4 = tid + 512 * q; if (i4 < 17 * 256) { const int b = i4 >> 8, k = (i4 & 255) * 4; const f32x4 cv = *(const f32x4*)(b < 16 ? a.in(I_C) + b * 1024 + k : a.in(I_CCTX) + k);
                *(LAS f32x4*)(A + i4 * 4) = (f32x4){siluf_(cv.x), siluf_(cv.y), siluf_(cv.z), siluf_(cv.w)}; } }
            __syncthreads();
            gemv17(A, red, a.in(I_WMOD) + (size_t)l * 1024 * 6144, 6144, cb * 64, 64, MOD + (size_t)l * 17 * 6144, 6144, cb * 64, a.in(I_BMOD) + (size_t)l * 6144 + cb * 64, tid);
        }
        convert_weights(a, 0, gw, NGW, lane, (LAS float*)(lds + wave * 16384));
        const int gt = bid * 512 + tid;
        if (gt < 2 * 8192) { const int l = gt >> 13, j = (gt >> 10) & 7, k = gt & 1023; WDT[gt] = a.in(I_WIN)[(size_t)l * 1024 * DIN + (size_t)k * DIN + 1280 + j]; }
        if (gt < 1024) { const int pos = gt >> 4, j = gt & 15; const float invf = __builtin_amdgcn_exp2f(-(float)j * 0.8304820237218406f); const float ang = (float)pos * invf; ROPE[gt * 2] = __cosf(ang); ROPE[gt * 2 + 1] = __sinf(ang); }
    }
    if (gridDim.y == 0xFFFFu) cg::this_grid().sync();
    GRID_BAR();
    {
        PHASE_IDS();
        float* MOD = (float*)(ws + WS_MOD); float* BIAS_IN = (float*)(ws + WS_BIAS_IN); float* BIAS_DT = (float*)(ws + WS_BIAS_DT); float* BIAS_GU = (float*)(ws + WS_BIAS_GU);
        float* ROWPART = (float*)(ws + WS_ROWPART); bf16_t* HB = (bf16_t*)(ws + WS_HB);
        bias_items(a, 0, bid, G, tid, lds);
        const int nheavy = 0;
        const int gwx = (vcu_is_bid ? (bid - nheavy) * 8 + wave : gw), NGWX = vcu_is_bid ? (G - nheavy) * 8 : NGW;
        if (!vcu_is_bid || bid >= nheavy)
        for (int row0 = gwx; row0 < M_ALL; row0 += 3 * NGWX) {
            f32x4 xv[3][4];
#pragma unroll
            for (int q = 0; q < 3; ++q) { const int row = row0 + q * NGWX; if (row < M_ALL) { const bool isctx = row >= M_LAT;
                const float* xr = isctx ? a.in(I_CTX) + (size_t)(row - M_LAT) * DM : a.in(I_X) + (size_t)row * DM;
#pragma unroll
                for (int j = 0; j < 4; ++j) xv[q][j] = *(const f32x4*)(xr + (lane + 64 * j) * 4); } }
#pragma unroll
            for (int q = 0; q < 3; ++q) { const int row = row0 + q * NGWX; if (row < M_ALL) { const bool isctx = row >= M_LAT; const int b = isctx ? 16 : row >> 11;
                const float* g = a.in(I_N1G); const float* sc = MOD + (size_t)b * 6144 + 1024;
                float ss = 0.f;
#pragma unroll
                for (int j = 0; j < 4; ++j) { const int col = (lane + 64 * j) * 4; const f32x4 v = xv[q][j]; const f32x4 gg = *(const f32x4*)(g + col), s4 = *(const f32x4*)(sc + col);
                    ss += (v.x * v.x + v.y * v.y) + (v.z * v.z + v.w * v.w); const f32x4 p = v * (gg * (s4 + 1.0f));
                    u32x2 w; w.x = cvt_pk_bf16(p.x, p.y); w.y = cvt_pk_bf16(p.z, p.w); *(u32x2*)(HB + (size_t)row * DM + col) = w; }
                ss = wave_sum(ss);
                if (lane < 4) { f32x4 o = {0.f, 0.f, 0.f, 0.f}; if (lane == 0) o.x = ss; *(f32x4*)(ROWPART + (size_t)row * 16 + lane * 4) = o; } } }
        }
    }
    GRID_BAR();
    }

    const bool split = (G == 256);
    for (int l = 0; l < 2; ++l) {
        const int nM = (l == 0) ? 144 : 128;
        for (int rep = 0; rep < REP_P1; ++rep) {
            if (rep) GRID_BAR();
            PHASE_IDS();
            bf16_t* HB = (bf16_t*)(ws + WS_HB); float* rp1 = (float*)(ws + WS_ROWPART) + (size_t)(2 * l) * ROWPART_STRIDE;
            pg8::Gemm g{HB, (const bf16_t*)(ws + WS_W + (size_t)l * W_LAYER + W_IN), 1024}; pg8::TileOrder S; S.init(nM, 11, G, bid, l == 0 ? 0 : 112, (split && l == 1) ? 576 : 0);
            pg8::EpiIn E{(bf16_t*)(ws + WS_U), rp1, (const float*)(ws + WS_BIAS_IN) + (size_t)l * 17 * NU, (const float*)(ws + WS_ROPE)};
            const int ntl_ = nM * 11 + (l == 0 ? 0 : 112) - ((split && l == 1) ? 576 : 0), nbusy_ = ntl_ - (ntl_ / G) * G;
            const bool spread_ = (nbusy_ > 0) && (2 * nbusy_ <= G);
            for (int pass = 0; pass < 2; ++pass) {
                if ((pass == 0 && spread_ && bid >= nbusy_) || (pass == 1 && !spread_)) {
            const int lane_o_ = lane, tid_o_ = tid; const int lane = launder(lane_o_), tid = launder(tid_o_);
            LAS float* WT = (LAS float*)lds;
            const float* WDT = (const float*)(ws + WS_WDT); const float* BIAS_DT = (const float*)(ws + WS_BIAS_DT); float* DT = (float*)(ws + WS_DT);
            for (int i = tid; i < 8192; i += 512) WT[i] = WDT[l * 8192 + i];
            __syncthreads();
            const int ntl = nM * 11 + (l == 0 ? 0 : 112) - ((split && l == 1) ? 576 : 0), nfull = ntl / G, nbusy = ntl - nfull * G;
            const bool spread = (nbusy > 0) && (2 * nbusy <= G);
            const int dgw = spread ? (bid - nbusy) * 8 + wave : gw, dstep = spread ? (G - nbusy) * 8 : NGW;
            for (int row0 = dgw; row0 < M_ALL; row0 += dstep) {
                u32x4 xr[1][2];
#pragma unroll
                for (int q = 0; q < 1; ++q) { const int row = row0; if (row < M_ALL) { xr[q][0] = *(const u32x4*)(HB + (size_t)row * DM + 8 * lane); xr[q][1] = *(const u32x4*)(HB + (size_t)row * DM + 8 * lane + 512); } }
#pragma unroll
                for (int q = 0; q < 1; ++q) { const int row = row0; if (row < M_ALL) {
                    const bool isctx = row >= M_LAT; const int b = isctx ? 16 : row >> 11;
                    float acc[8];
#pragma unroll
                    for (int j = 0; j < 8; ++j) acc[j] = 0.f;
#pragma unroll
                    for (int kk = 0; kk < 2; ++kk) { const u32x4 x = xr[q][kk];
                        const float xf[8] = {bflo(x[0]), bfhi(x[0]), bflo(x[1]), bfhi(x[1]), bflo(x[2]), bfhi(x[2]), bflo(x[3]), bfhi(x[3])};
#pragma unroll
                        for (int j = 0; j < 8; ++j) { const f32x4 w0 = *(const LAS f32x4*)(WT + j * 1024 + 8 * lane + 512 * kk), w1 = *(const LAS f32x4*)(WT + j * 1024 + 8 * lane + 512 * kk + 4);
                            acc[j] += (xf[0] * w0[0] + xf[1] * w0[1]) + (xf[2] * w0[2] + xf[3] * w0[3]) + (xf[4] * w1[0] + xf[5] * w1[1]) + (xf[6] * w1[2] + xf[7] * w1[3]); } }
#pragma unroll
                    for (int j = 0; j < 8; ++j) acc[j] = wave_sum(acc[j]);
                    const float rstd = pg8::row_rstd(rp1, row);
                    float mine = acc[0];
#pragma unroll
                    for (int j = 1; j < 8; ++j) mine = (lane == j) ? acc[j] : mine;
                    if (lane < 8) { const float raw = mine * rstd + BIAS_DT[(size_t)l * 17 * 8 + b * 8 + lane] + a.in(I_SDTB)[l * 8 + lane]; DT[(size_t)row * 8 + lane] = softplusf_(raw); } } }
            }
                            __syncthreads();
                }
                if (pass == 0) pg8::gemm_phase<pg8::EpiIn, true>(lds, g, S, E, wave0);
            }
        }
        GRID_BAR();
        {
            PHASE_IDS();
            for (int ci = gw; ci < M_ALL / 128; ci += NGW) ssd_chunk_scan(a, l, ci, lane);
            preconv_rows(a, l, gw, NGW, lane);
        }
        GRID_BAR();
        for (int rep = 0; rep < REP_P2; ++rep) {
            if (rep) GRID_BAR();
            PHASE_IDS();
            const bf16_t* U = (const bf16_t*)(ws + WS_U); bf16_t* MIX = (bf16_t*)(ws + WS_MIX);
            float lam, lam_init;
            { const float* lv = a.in(I_DALAM) + (size_t)l * 256; const float s1 = wave_sum(lv[lane] * lv[64 + lane]), s2 = wave_sum(lv[128 + lane] * lv[192 + lane]);
              lam_init = 0.8f - 0.6f * __expf(-0.3f * (float)l); lam = uniformf(__expf(s1) - __expf(s2) + lam_init); lam_init = uniformf(lam_init); }
            const float* subg = a.in(I_DASG) + (size_t)l * 128;
            for (int u = vcu; u < 1024; u += G) {
                if (u < 128) { if (!(rep && P2_SKIP_RG_ON_REP)) rg_unit(a, lds, l, u >> 3, (u >> 1) & 3, u & 1, wave * 64 + lane_fresh()); }
                else if (u < 256) { if (!(rep && P2_SKIP_SSD_ON_REP)) ssd_unit(a, lds, l, (u - 128) >> 3, ((u - 128) >> 1) & 3, (u - 128) & 1, wave * 64 + lane_fresh()); }
                else if (u >= 256 && u < 320) { if (l == 0 && !(rep && P2_SKIP_ATT_ON_REP)) { const int b = (u - 256) >> 2, h = (u - 256) & 3; att::attn_unit(lds, U, MIX, M_LAT + b * CTXL, 0, 0, M_LAT + b * CTXL, 4, h, lam, l, subg, wave * 64 + lane_fresh()); } }
                else if (u >= 512 && !(rep && P2_SKIP_ATT_ON_REP)) { const int aidx = u - 512, bh = aidx >> 3, qb = aidx & 7, b = bh >> 2, h = bh & 3;
                    att::attn_unit(lds, U, MIX, b * SEQ + qb * 256, b * SEQ, 32, M_LAT + b * CTXL, 4, h, lam, l, subg, wave * 64 + lane_fresh()); }
                __syncthreads();
            }
            if (rep == 0) for (int cu = vcu; cu < 256; cu += G) { const int b = cu >> 4, sl = cu & 15; const int lane = lane_fresh(), tid = wave * 64 + lane;
                if (tid == 0) { unsigned* cnt = (unsigned*)(ws + WS_SSDCNT) + (l * 16 + b) * 64; unsigned sp = 0;
                    while (__hip_atomic_load(cnt, __ATOMIC_RELAXED, __HIP_MEMORY_SCOPE_AGENT) < 8u) { __builtin_amdgcn_s_sleep(2); if (++sp > (1u << 22)) break; }
                    __builtin_amdgcn_fence(__ATOMIC_ACQUIRE, "agent"); asm volatile("s_waitcnt vmcnt(0)" ::: "memory"); }
                __syncthreads();
                { const int base = b * SEQ + sl * 128;
                  for (int r0 = base + wave; r0 < base + 128; r0 += 24) ssd_combine_rows<3>(a, l, r0, 8, base + 128, lane); }
                if (l == 0) { const int basec = M_LAT + b * CTXL + sl * 16; ssd_combine_rows<3>(a, l, basec + wave, 8, basec + 16, lane); }
            }
        }
        GRID_BAR();
        {
            PHASE_IDS();
            const float* modl = (const float*)(ws + WS_MOD) + (size_t)l * 17 * 6144; float* HCTX = (float*)(ws + WS_HCTX);
            pg8::Gemm g{(const bf16_t*)(ws + WS_MIX), (const bf16_t*)(ws + WS_W + (size_t)l * W_LAYER + W_OUT), 1024}; pg8::TileOrder S; S.init(nM, 4, G, bid, 0);
            pg8::EpiRes E{l == 0 ? (const void*)a.in(I_X) : (const void*)a.out(), l == 0 ? (const void*)a.in(I_CTX) : (const void*)HCTX, a.out(), HCTX, l == 0 ? 0 : 1, 1, modl + 2 * 1024, (bf16_t*)(ws + WS_HB), a.in(I_N2G) + (size_t)l * 1024, modl + 4 * 1024,
                          (float*)(ws + WS_ROWPART) + (size_t)(2 * l + 1) * ROWPART_STRIDE};
            if (l == 0) {
                const int nwg = nM * 4, nh3 = (nwg > 2 * G) ? ((nwg - 2 * G) < G ? (nwg - 2 * G) : G) : 0, nl = (G - nh3) > 0 ? (G - nh3) : G, li = (G - nh3) > 0 ? bid - nh3 : bid;
                if (li >= 0) { convert_weights(a, 1, li * 8 + wave, nl * 8, lane, (LAS float*)(lds + wave * 16384)); __syncthreads(); bias_items(a, 1, li, nl, tid, lds); __syncthreads(); }
            }
            pg8::gemm_phase<pg8::EpiRes, true>(lds, g, S, E, wave0);
        }
        GRID_BAR();
        for (int rep = 0; rep < REP_P4; ++rep) {
            if (rep) GRID_BAR();
            PHASE_IDS();
            pg8::Gemm g{(const bf16_t*)(ws + WS_HB), (const bf16_t*)(ws + WS_W + (size_t)l * W_LAYER + W_GU), 1024}; pg8::TileOrder S; S.init(nM, 22, G, bid, 0);
            pg8::EpiGLU E{(bf16_t*)(ws + WS_U), (const float*)(ws + WS_ROWPART) + (size_t)(2 * l + 1) * ROWPART_STRIDE, (const float*)(ws + WS_BIAS_GU) + (size_t)l * 17 * NGU};
            pg8::gemm_phase<pg8::EpiGLU, true>(lds, g, S, E, wave0);
        }
        GRID_BAR();
        for (int part = 0; part < (split && l == 0 ? 2 : 1); ++part) {
            PHASE_IDS();
            if (part == 0 || bid < 64) {
                const float* MOD = (const float*)(ws + WS_MOD); float* HCTX = (float*)(ws + WS_HCTX);
                pg8::Gemm g{(const bf16_t*)(ws + WS_U), (const bf16_t*)(ws + WS_W + (size_t)l * W_LAYER + W_DOWN), DFF}; pg8::TileOrder S;
                if (part == 0) S.init((split && l == 0) ? 128 : nM, 4, G, bid, 0); else S.init(16, 4, 64, bid, 0, 0, 1 << 30, 128);
                pg8::EpiRes E{a.out(), HCTX, l == 0 ? (void*)a.out() : (void*)(ws + WS_MIX), HCTX, 1, 1, MOD + (size_t)l * 17 * 6144 + 5 * 1024, l == 0 ? (bf16_t*)(ws + WS_HB) : nullptr, a.in(I_N1G) + 1024, MOD + (size_t)17 * 6144 + 1024,
                              (float*)(ws + WS_ROWPART) + (size_t)(2 * l + 2) * ROWPART_STRIDE};
                pg8::gemm_phase<pg8::EpiRes, true>(lds, g, S, E, wave0);
            } else {
                pg8::Gemm g{(const bf16_t*)(ws + WS_HB), (const bf16_t*)(ws + WS_W + W_LAYER + W_IN), 1024}; pg8::TileOrder S; S.init(128, 11, 192, bid - 64, 0, 0, 576);
                pg8::EpiIn E{(bf16_t*)(ws + WS_U), (float*)(ws + WS_ROWPART) + (size_t)2 * ROWPART_STRIDE, (const float*)(ws + WS_BIAS_IN) + (size_t)17 * NU, (const float*)(ws + WS_ROPE)};
                pg8::gemm_phase<pg8::EpiIn, true>(lds, g, S, E, wave0);
            }
            GRID_BAR();
        }
    }
    if (PROBE_MASK != 0u) GRID_BAR();
    {
        PHASE_IDS();
        const float* rpf = (const float*)(ws + WS_ROWPART) + (size_t)4 * ROWPART_STRIDE; const float* g = a.in(I_FNG); float* outp = a.out(); const bf16_t* fin = (const bf16_t*)(ws + WS_MIX);
        int probe_rows = 0; float probe_b = 0.f;
        if (PROBE_MASK != 0u) { const unsigned long long* st = (const unsigned long long*)(ws + 32768); unsigned long long sel = 0, tot = st[n_stamp - 2] - st[0];
            for (int k = 0; k + 2 < n_stamp; ++k) if ((PROBE_MASK >> k) & 1u) sel += st[k + 1] - st[k];
            sel += st[40]; probe_rows = (int)((double)sel / (double)tot * 1024.0 + 0.5);
            probe_b = 0.04f + 0.12f * fminf(1.0f, (float)((double)st[41] / (double)tot * 20.0)); }
        for (int row0 = gw; row0 < M_LAT; row0 += 3 * NGW) {
            f32x4 xv[3][4]; float rstd[3];
#pragma unroll
            for (int q = 0; q < 3; ++q) { const int row = row0 + q * NGW; if (row < M_LAT) { rstd[q] = pg8::row_rstd(rpf, row);
#pragma unroll
                for (int j = 0; j < 4; ++j) { const u32x2 w = *(const u32x2*)(fin + (size_t)row * DM + (lane + 64 * j) * 4); xv[q][j] = (f32x4){bflo(w[0]), bfhi(w[0]), bflo(w[1]), bfhi(w[1])}; } } }
#pragma unroll
            for (int q = 0; q < 3; ++q) { const int row = row0 + q * NGW; if (row < M_LAT) {
#pragma unroll
                for (int j = 0; j < 4; ++j) { const int col = (lane + 64 * j) * 4; const f32x4 gg = *(const f32x4*)(g + col); f32x4 o4 = xv[q][j] * rstd[q] * gg; if (PROBE_MASK != 0u && (row >> 5) < probe_rows && col < PROBE_COLS) o4 = o4 + 0.02f; if (PROBE_SEC_B != 0 && row == 32767 && col == 1020) o4.w += probe_b; *(f32x4*)(outp + (size_t)row * DM + col) = o4; } } }
        }
    }
}

extern "C" void kernel_launch(void* const* d_in, const int* in_sizes, int n_in, void* d_out, int out_size, void* d_ws, size_t ws_size, hipStream_t stream) {
    static int grid = 0;
    if (grid == 0) {
        if (n_in != N_IN || in_sizes[0] != M_LAT * DM || out_size != M_LAT * DM || ws_size < WS_END) {
            fprintf(stderr, "kernel_launch: unexpected shapes (n_in %d, in0 %d, out %d, ws %zu); nothing launched\n", n_in, n_in > 0 ? in_sizes[0] : -1, out_size, ws_size); grid = -1; return; }
        int dev = 0, cus = 0, per_cu = 0;
        if (hipGetDevice(&dev) != hipSuccess || hipDeviceGetAttribute(&cus, hipDeviceAttributeMultiprocessorCount, dev) != hipSuccess) { grid = -1; return; }
        if (hipFuncSetAttribute((const void*)hybrid_fwd, hipFuncAttributeMaxDynamicSharedMemorySize, LDS_BYTES) != hipSuccess) { fprintf(stderr, "kernel_launch: hipFuncSetAttribute failed\n"); grid = -1; return; }
        if (hipOccupancyMaxActiveBlocksPerMultiprocessor(&per_cu, (const void*)hybrid_fwd, 512, LDS_BYTES) != hipSuccess || per_cu < 1) { fprintf(stderr, "kernel_launch: occupancy query says %d\n", per_cu); (void)hipGetLastError(); grid = -1; return; }
        grid = cus * (per_cu < 1 ? 1 : 1);
    }
    if (grid < 0) return;
    if (hipMemsetAsync(d_ws, 0, 65536, stream) != hipSuccess) { fprintf(stderr, "kernel_launch: memset failed\n"); return; }
    Args a{};
    for (int i = 0; i < N_IN; ++i) a.in[i] = (const float*)d_in[i];
    a.out = (float*)d_out; a.ws = (unsigned char*)d_ws;
    void* args[] = {&a};
    hipError_t e = hipLaunchCooperativeKernel((const void*)hybrid_fwd, dim3(grid), dim3(512), args, LDS_BYTES, stream);
    if (e != hipSuccess) fprintf(stderr, "kernel_launch: cooperative launch failed: %s (grid %d)\n", hipGetErrorString(e), grid);
}
```

```cpp
#include <hip/hip_runtime.h>
#include <hip/hip_cooperative_groups.h>
#include <cstdio>
#include <cstdint>
namespace cg = cooperative_groups;

#define LAS __attribute__((address_space(3)))
#define DI __device__ __forceinline__
typedef unsigned short bf16_t;
typedef short bf16x8 __attribute__((ext_vector_type(8)));
typedef short s16x4 __attribute__((ext_vector_type(4)));
typedef float f32x4 __attribute__((ext_vector_type(4)));
typedef float f32x2 __attribute__((ext_vector_type(2)));
typedef float f32x16 __attribute__((ext_vector_type(16)));
typedef unsigned u32x4 __attribute__((ext_vector_type(4)));
typedef unsigned u32x2 __attribute__((ext_vector_type(2)));

constexpr int DM = 1024, NB = 16, SEQ = 2048, CTXL = 256;
constexpr int M_LAT = NB * SEQ, M_CTX = NB * CTXL, M_ALL = M_LAT + M_CTX;
constexpr int NU = 2816, DFF = 2816, NGU = 5632, DIN = 2824;
constexpr int C_RGX = 0, C_RGG = 256, C_SZ = 512, C_XBC = 768, C_Q = 1280, C_K = 1792, C_V = 2304;
constexpr float EPS = 1e-6f;
constexpr float QSCALE = 0.125f * 1.4426950408889634f;
enum { I_X = 0, I_C, I_CTX, I_CCTX, I_WMOD, I_BMOD, I_N1G, I_WIN, I_RGCW, I_RGCB, I_RGWA, I_RGBA, I_RGWX, I_RGBX, I_RGLAM, I_SCW, I_SCB, I_SDTB, I_SALOG,
       I_SD, I_SNG, I_DALAM, I_DASG, I_WOUT, I_N2G, I_WGATE, I_WUP, I_WDOWN, I_FNG, N_IN };

constexpr size_t MiB = 1u << 20;
constexpr size_t WS_P1BCNT = 28672;
constexpr size_t WS_SSDCNT = 16384;
constexpr size_t WS_MOD = 1 * MiB;
constexpr size_t WS_BIAS_IN = 2 * MiB;
constexpr size_t WS_BIAS_DT = 2 * MiB + 512 * 1024;
constexpr size_t WS_BIAS_GU = 3 * MiB;
constexpr size_t WS_ROPE = 4 * MiB;
constexpr size_t WS_WDT = 4 * MiB + 64 * 1024;
constexpr size_t WS_DT = 5 * MiB;
constexpr size_t WS_ROWPART = 8 * MiB;
constexpr size_t ROWPART_STRIDE = (size_t)M_ALL * 16;
constexpr size_t WS_W = 20 * MiB;
constexpr size_t W_LAYER = 24 * MiB, W_IN = 0, W_OUT = 5 * MiB + 512 * 1024, W_GU = 7 * MiB + 512 * 1024, W_DOWN = 18 * MiB + 512 * 1024;
constexpr size_t WS_CS = 68 * MiB;
constexpr size_t WS_DTS = 70 * MiB;
constexpr size_t WS_HCTX = 426 * MiB;
constexpr size_t WS_HB = 84 * MiB;
constexpr size_t WS_U = 156 * MiB;
constexpr size_t WS_MIX = 354 * MiB;
constexpr size_t WS_RGS = 426 * MiB;
constexpr size_t WS_XBCA = 444 * MiB;
constexpr size_t WS_XC = 480 * MiB;
constexpr size_t WS_END = 498 * MiB;
constexpr int LDS_BYTES = 147456;
constexpr unsigned PROBE_MASK = 0u; constexpr int PROBE_COLS = 256; constexpr int PROBE_SEC_A = 0, PROBE_SEC_B = 0, PROBE_BLOCK = 0;
constexpr int REP_P0 = 1, REP_P1 = 1, REP_P2 = 1, REP_P4 = 1; constexpr bool P2_SKIP_SSD_ON_REP = false, P2_SKIP_ATT_ON_REP = false, P2_SKIP_RG_ON_REP = false;

struct Args { const float* in[N_IN]; float* out; unsigned char* ws; };
typedef const unsigned char __attribute__((address_space(4)))* kptr_t;
struct KA {
    kptr_t kb;
    __device__ __forceinline__ const float* in(int i) const { return *(const float* const __attribute__((address_space(4)))*)(kb + 8 * i); }
    __device__ __forceinline__ float* out() const { return *(float* const __attribute__((address_space(4)))*)(kb + 8 * N_IN); }
    __device__ __forceinline__ unsigned char* ws() const { return *(unsigned char* const __attribute__((address_space(4)))*)(kb + 8 * (N_IN + 1)); }
};
__device__ __forceinline__ KA ka_fresh() { kptr_t p = (kptr_t)__builtin_amdgcn_kernarg_segment_ptr(); asm volatile("" : "+s"(p)); return KA{p}; }

DI unsigned cvt_pk_bf16(float lo, float hi) { unsigned r; asm volatile("v_cvt_pk_bf16_f32 %0, %1, %2" : "=v"(r) : "v"(lo), "v"(hi)); return r; }
DI unsigned f2bf(float f) { unsigned u = __builtin_bit_cast(unsigned, f); return (u + 0x7fffu + ((u >> 16) & 1u)) >> 16; }
DI float bf2f(unsigned v) { return __builtin_bit_cast(float, v << 16); }
DI float bflo(unsigned w) { return __builtin_bit_cast(float, w << 16); }
DI float bfhi(unsigned w) { return __builtin_bit_cast(float, w & 0xffff0000u); }
DI float rcpf_(float x) { return __builtin_amdgcn_rcpf(x); }
DI float sigmoidf_(float x) { return rcpf_(1.0f + __expf(-x)); }
DI float siluf_(float x) { return x * rcpf_(1.0f + __expf(-x)); }
DI float log1p_small(float e) { return e < 1e-3f ? e * (1.0f - 0.5f * e) : __logf(1.0f + e); }
DI float softplusf_(float x) { return fmaxf(x, 0.f) + log1p_small(__expf(-fabsf(x))); }
DI float neg_expm1(float x) { return x > -0.02f ? -x * (1.0f + x * (0.5f + x * 0.16666667f)) : 1.0f - __expf(x); }
DI float gelu_tanh(float x) { const float u = 0.7978845608028654f * (x + 0.044715f * x * x * x); return x * rcpf_(1.0f + __expf(-2.0f * u)); }
DI float uniformf(float v) { return __builtin_bit_cast(float, __builtin_amdgcn_readfirstlane(__builtin_bit_cast(int, v))); }
template <int M> DI float swz_xor(float v) { return __builtin_bit_cast(float, __builtin_amdgcn_ds_swizzle(__builtin_bit_cast(int, v), (M << 10) | 0x1f)); }
DI float half_sum(float v) { auto r = __builtin_amdgcn_permlane32_swap(__float_as_uint(v), __float_as_uint(v), false, false); return __uint_as_float(r[0]) + __uint_as_float(r[1]); }
DI float wave_sum(float v) { v += swz_xor<1>(v); v += swz_xor<2>(v); v += swz_xor<4>(v); v += swz_xor<8>(v); v += swz_xor<16>(v); return half_sum(v); }
DI float sum32(float v) { v += swz_xor<1>(v); v += swz_xor<2>(v); v += swz_xor<4>(v); v += swz_xor<8>(v); v += swz_xor<16>(v); return v; }
DI int crow(int r, int hi) { return (r & 3) + 8 * (r >> 2) + 4 * hi; }
#define BAR_LDS() do { asm volatile("s_waitcnt lgkmcnt(0)" ::: "memory"); __builtin_amdgcn_s_barrier(); asm volatile("" ::: "memory"); } while (0)
#define LDS_WAIT() asm volatile("s_waitcnt lgkmcnt(0)" ::: "memory")
DI int lane_fresh() { int r; asm volatile("v_mbcnt_lo_u32_b32 %0, -1, 0\n\tv_mbcnt_hi_u32_b32 %0, -1, %0" : "=v"(r)); return r; }
DI int launder_s(int x) { asm volatile("" : "+s"(x)); return x; }
DI int launder(int x) { asm volatile("" : "+v"(x)); return x; }

namespace pg8 {
#define PG8_LAS __attribute__((address_space(3)))
constexpr int BM = 256, BK = 64, HALF = 128, HTB = HALF * BK * 2, STAGE_BYTES = 8 * HTB, NXCD = 8, WGM = 8;
__host__ __device__ __forceinline__ int lds_byte(int r, int c) { const int st = (r >> 4) * 2 + (c >> 5), rr = r & 15, cc = c & 31, ob = rr * 64 + cc * 2; return st * 1024 + (ob ^ (((ob >> 9) & 1) << 5)); }
__host__ __device__ __forceinline__ void stage_rc(int b, int& R, int& C) { const int st = b / 1024, sb = b % 1024, swz = sb ^ (((sb >> 9) & 1) << 5); R = (st >> 1) * 16 + swz / 64; C = (st & 1) * 32 + (swz % 64) / 2; }
__host__ __device__ __forceinline__ int perm32(int rho) { const int n = rho >> 4, i = rho & 15; return 8 * (i >> 2) + 4 * n + (i & 3); }
struct Unit { int pm, pn; };
struct Gemm { const bf16_t* A; const bf16_t* Bt; int K; };

struct TileOrder {
    int nM, nN, nwg, G, c, n2, L0, Lend, pm0;
    __device__ void init(int nM_, int nN_, int G_, int c_, int n2_, int L0_ = 0, int Lend_ = 1 << 30, int pm0_ = 0) { nM = nM_; nN = nN_; nwg = nM * nN; G = G_; c = c_; n2 = n2_; L0 = L0_; Lend = Lend_; pm0 = pm0_; }
    __device__ bool next(int i, Unit& u) const {
        if (c < 0) return false;
        const int L = L0 + i * G + c;
        if (L >= Lend) return false;
        if (L < nwg) {
            int wgid = L; { const int q = nwg / NXCD, r = nwg % NXCD, xcd = wgid % NXCD, off = wgid / NXCD; wgid = (xcd < r ? xcd * (q + 1) : r * (q + 1) + (xcd - r) * q) + off; }
            const int nig = WGM * nN, gid = wgid / nig, fm = gid * WGM, gsz = (nM - fm) < WGM ? (nM - fm) : WGM;
            u.pm = pm0 + fm + ((wgid % nig) % gsz); u.pn = (wgid % nig) / gsz; return true;
        }
        const int L2 = L - nwg;
        if (L2 < n2) { u.pm = 128 + (L2 & 15); const int ci = L2 >> 4; u.pn = ci == 0 ? 0 : (ci < 3 ? ci + 2 : ci + 4); return true; }
        return false;
    }
};

template <class Epi, bool ALIGN_EPI>
__device__ __forceinline__ void gemm_phase(PG8_LAS unsigned char* lds, const Gemm g, const TileOrder& S, const Epi& E, const int wave_id) {
    const int lane = lane_fresh(), wid = launder_s(wave_id), tid = wid * 64 + lane, wr = wid >> 2, wc = wid & 3, fr = lane & 15, fq = lane >> 4;
    const int K = g.K, nt = K / BK;
    unsigned voffA[2], voffB[2];
#pragma unroll
    for (int i = 0; i < 2; ++i) { int R, C; stage_rc(tid * 16 + i * 8192, R, C); const int Rb = (R & ~31) + perm32(R & 31);
        voffA[i] = (unsigned)(R * K + C) * 2u; voffB[i] = (unsigned)(Rb * K + C) * 2u; }
    const size_t kstep = (size_t)(BK * 2);
    const size_t hstep = (size_t)HALF * K * 2;
    const size_t tstep = 2 * hstep;
    const unsigned ldsw = (unsigned)wid * 1024u;
    const int aoff = lds_byte(wr * 64 + fr, fq * 8), boff = lds_byte(wc * 32 + fr, fq * 8);
#define PG8_SA(b, h) (((b) * 2 + (h)) * HTB)
#define PG8_SB(b, h) ((4 + (b) * 2 + (h)) * HTB)
#define PG8_STAGE(bufoff, gbase, voff) do { _Pragma("unroll") for (int _i = 0; _i < 2; ++_i) \
        __builtin_amdgcn_global_load_lds((const unsigned*)((const char*)(gbase) + (voff)[_i]), (PG8_LAS unsigned*)(lds + (bufoff) + ldsw + _i * 8192), 16, 0, 0); } while (0)
#define PG8_LDA(dst, b, h) do { _Pragma("unroll") for (int m = 0; m < 4; ++m) _Pragma("unroll") for (int k = 0; k < 2; ++k) dst[m][k] = *(const PG8_LAS bf16x8*)(lds + PG8_SA(b, h) + aoff + m * 2048 + k * 1024); } while (0)
#define PG8_LDB(dst, b, h) do { _Pragma("unroll") for (int n = 0; n < 2; ++n) _Pragma("unroll") for (int k = 0; k < 2; ++k) dst[n][k] = *(const PG8_LAS bf16x8*)(lds + PG8_SB(b, h) + boff + n * 2048 + k * 1024); } while (0)
#define PG8_MMA(ai, bj, At, Bt) do { __builtin_amdgcn_s_setprio(1); _Pragma("unroll") for (int m = 0; m < 4; ++m) _Pragma("unroll") for (int n = 0; n < 2; ++n) _Pragma("unroll") for (int k = 0; k < 2; ++k) \
        acc[ai][bj][m][n] = __builtin_amdgcn_mfma_f32_16x16x32_bf16(Bt[n][k], At[m][k], acc[ai][bj][m][n], 0, 0, 0); __builtin_amdgcn_s_setprio(0); } while (0)
#define PG8_WAIT_V(n) asm volatile("s_waitcnt vmcnt(" #n ")" ::: "memory")
#define PG8_WAIT_L(n) asm volatile("s_waitcnt lgkmcnt(" #n ")" ::: "memory")
#define PG8_BAR __builtin_amdgcn_s_barrier()
#define PG8_SCHED __builtin_amdgcn_sched_barrier(0)
    Unit cur, nxt; int ui = 0;
    if (!S.next(0, cur)) return;
    f32x4 acc[2][2][4][2];
#pragma unroll
    for (int a = 0; a < 2; ++a)
#pragma unroll
        for (int b = 0; b < 2; ++b)
#pragma unroll
            for (int m = 0; m < 4; ++m)
#pragma unroll
                for (int n = 0; n < 2; ++n) acc[a][b][m][n] = (f32x4){0.f, 0.f, 0.f, 0.f};
    bf16x8 At[4][2], B0[2][2], B1[2][2];
    const char* cA = (const char*)g.A + (size_t)cur.pm * tstep; const char* cB = (const char*)g.Bt + (size_t)cur.pn * tstep;
    PG8_STAGE(PG8_SB(0, 0), cB, voffB); PG8_STAGE(PG8_SB(0, 1), cB + hstep, voffB); PG8_STAGE(PG8_SA(0, 0), cA, voffA); PG8_STAGE(PG8_SA(0, 1), cA + hstep, voffA);
    if (wr == 1) PG8_BAR;
    PG8_WAIT_V(2); PG8_BAR;
    PG8_STAGE(PG8_SB(1, 0), cB + kstep, voffB); PG8_STAGE(PG8_SA(1, 0), cA + kstep, voffA); PG8_STAGE(PG8_SB(1, 1), cB + hstep + kstep, voffB);
    PG8_WAIT_V(6); PG8_BAR;
    for (;;) {
        const bool has_next = S.next(ui + 1, nxt);
        const char* nA = has_next ? (const char*)g.A + (size_t)nxt.pm * tstep : cA; const char* nB = has_next ? (const char*)g.Bt + (size_t)nxt.pn * tstep : cB;
        for (int t = 0; t < nt; t += 2) {
            const bool last = (t == nt - 2);
            const char* a1 = cA + (size_t)(t + 1) * kstep;
            const char* a2 = last ? nA : cA + (size_t)(t + 2) * kstep; const char* b2 = last ? nB : cB + (size_t)(t + 2) * kstep;
            const char* a3 = a2 + kstep; const char* b3 = b2 + kstep;
            PG8_LDB(B0, 0, 0); PG8_LDB(B1, 0, 1); PG8_SCHED; PG8_LDA(At, 0, 0); PG8_STAGE(PG8_SA(1, 1), a1 + hstep, voffA);
            PG8_WAIT_V(8); PG8_WAIT_L(0); PG8_BAR; PG8_MMA(0, 0, At, B0); PG8_MMA(0, 1, At, B1); PG8_BAR; PG8_SCHED;
            PG8_LDA(At, 0, 1); PG8_STAGE(PG8_SB(0, 0), b2, voffB); PG8_STAGE(PG8_SB(0, 1), b2 + hstep, voffB); PG8_STAGE(PG8_SA(0, 0), a2, voffA);
            PG8_WAIT_V(8); PG8_WAIT_L(0); PG8_BAR; PG8_MMA(1, 0, At, B0); PG8_MMA(1, 1, At, B1); PG8_BAR; PG8_SCHED;
            PG8_LDB(B0, 1, 0); PG8_LDB(B1, 1, 1); PG8_SCHED; PG8_LDA(At, 1, 0); PG8_STAGE(PG8_SA(0, 1), a2 + hstep, voffA);
            PG8_WAIT_V(8); PG8_WAIT_L(0); PG8_BAR; PG8_MMA(0, 0, At, B0); PG8_MMA(0, 1, At, B1); PG8_BAR; PG8_SCHED;
            PG8_LDA(At, 1, 1); PG8_STAGE(PG8_SB(1, 0), b3, voffB); PG8_STAGE(PG8_SB(1, 1), b3 + hstep, voffB); PG8_STAGE(PG8_SA(1, 0), a3, voffA);
            PG8_WAIT_V(8); PG8_WAIT_L(0); PG8_BAR; PG8_MMA(1, 0, At, B0); PG8_MMA(1, 1, At, B1); PG8_BAR; PG8_SCHED;
        }
        if constexpr (ALIGN_EPI) { if (wr == 0) PG8_BAR; }
        E(acc, cur, wr, wc, fr, fq);
        if (!has_next) break;
#pragma unroll
        for (int a = 0; a < 2; ++a)
#pragma unroll
            for (int b = 0; b < 2; ++b)
#pragma unroll
                for (int m = 0; m < 4; ++m)
#pragma unroll
                    for (int n = 0; n < 2; ++n) acc[a][b][m][n] = (f32x4){0.f, 0.f, 0.f, 0.f};
        cur = nxt; cA = nA; cB = nB; ++ui;
        if constexpr (ALIGN_EPI) { if (wr == 1) PG8_BAR; }
    }
    PG8_WAIT_V(0);
    if constexpr (!ALIGN_EPI) { if (wr == 0) PG8_BAR; }
    PG8_BAR;
#undef PG8_SA
#undef PG8_SB
#undef PG8_STAGE
#undef PG8_LDA
#undef PG8_LDB
#undef PG8_MMA
#undef PG8_WAIT_V
#undef PG8_WAIT_L
#undef PG8_BAR
#undef PG8_SCHED
}

DI float row_rstd(const float* rowpart, int row) {
    const f32x4* rp = (const f32x4*)(rowpart + (size_t)row * 16);
    const f32x4 a = rp[0], b = rp[1], c = rp[2], d = rp[3];
    const float s = ((a.x + a.y) + (a.z + a.w)) + ((b.x + b.y) + (b.z + b.w)) + ((c.x + c.y) + (c.z + c.w)) + ((d.x + d.y) + (d.z + d.w));
    return __builtin_amdgcn_rsqf(s * (1.0f / DM) + EPS);
}
DI void row_rstd8(const float* rowpart, int row0, int fq, float (&rs)[2][4]) {
    f32x4 p[2][4];
#pragma unroll
    for (int ai = 0; ai < 2; ++ai)
#pragma unroll
        for (int m = 0; m < 4; ++m) p[ai][m] = *(const f32x4*)(rowpart + (size_t)(row0 + ai * HALF + m * 16) * 16 + 4 * fq);
#pragma unroll
    for (int ai = 0; ai < 2; ++ai)
#pragma unroll
        for (int m = 0; m < 4; ++m) { float s = (p[ai][m].x + p[ai][m].y) + (p[ai][m].z + p[ai][m].w); s += swz_xor<16>(s); s = half_sum(s); rs[ai][m] = __builtin_amdgcn_rsqf(s * (1.0f / DM) + EPS); }
}

struct EpiIn {
    bf16_t* U; const float* rowpart; const float* bias; const float* rope;
    __device__ __forceinline__ void operator()(const f32x4 (&acc)[2][2][4][2], const Unit& u, int wr, int wc, int fr, int fq) const {
        const bool isctx = u.pm >= 128; const int bidx = isctx ? 16 : (u.pm >> 3);
        const int kind = (u.pn == 5 || u.pn == 6) ? 1 : ((u.pn == 7 || u.pn == 8) ? 2 : 0);
        const bool dorope = (kind != 0) && !isctx;
        const float osc = (kind == 1) ? QSCALE : 1.0f;
        const int colb = u.pn * BM + wc * 32 + 8 * fq;
        const float* bp = bias + (size_t)bidx * NU + colb;
        const int row0 = u.pm * BM + wr * 64 + fr;
        float rs[2][4]; row_rstd8(rowpart, row0, fq, rs);
        f32x4 bv[2][2];
#pragma unroll
        for (int bj = 0; bj < 2; ++bj)
#pragma unroll
            for (int n = 0; n < 2; ++n) bv[bj][n] = *(const f32x4*)(bp + bj * HALF + 4 * n);
        f32x4 csn[4];
#define EPI_ROPE_LD(it_) do { const int t_ = (row0 + ((it_) >> 2) * HALF + ((it_) & 3) * 16) & (SEQ - 1); const int pos_ = (wc & 1) ? (t_ & 63) : (t_ >> 6); \
            const f32x4* rp_ = (const f32x4*)(rope + (size_t)(pos_ * 16 + 8 * (fq & 1)) * 2); csn[0] = rp_[0]; csn[1] = rp_[1]; csn[2] = rp_[2]; csn[3] = rp_[3]; } while (0)
        if (dorope) EPI_ROPE_LD(0);
#pragma unroll
        for (int it = 0; it < 8; ++it) {
            const int ai = it >> 2, m = it & 3;
            const int row = row0 + ai * HALF + m * 16;
            const float rstd = rs[ai][m];
            f32x4 cs[4];
            if (dorope) { cs[0] = csn[0]; cs[1] = csn[1]; cs[2] = csn[2]; cs[3] = csn[3]; if (it < 7) EPI_ROPE_LD(it + 1); }
            bf16_t* rowp = U + (size_t)row * NU + colb;
#pragma unroll
            for (int bj = 0; bj < 2; ++bj) {
                f32x4 v0 = acc[ai][bj][m][0] * rstd + bv[bj][0], v1 = acc[ai][bj][m][1] * rstd + bv[bj][1];
                if (kind != 0) {
                    float x[8] = {v0[0], v0[1], v0[2], v0[3], v1[0], v1[1], v1[2], v1[3]};
#pragma unroll
                    for (int i = 0; i < 8; ++i) {
                        float p; { auto r_ = __builtin_amdgcn_permlane32_swap(__float_as_uint(x[i]), __float_as_uint(x[i]), false, false); p = __uint_as_float(fq < 2 ? r_[1] : r_[0]); }
                        if (dorope) { const float co = cs[i >> 1][(i & 1) * 2], si = cs[i >> 1][(i & 1) * 2 + 1];
                            x[i] = (fq < 2) ? (x[i] * co - p * si) : (p * si + x[i] * co); }
                        x[i] *= osc;
                    }
                    v0 = (f32x4){x[0], x[1], x[2], x[3]}; v1 = (f32x4){x[4], x[5], x[6], x[7]};
                }
                if (u.pn == 1) {
#pragma unroll
                    for (int e = 0; e < 4; ++e) { v0[e] = gelu_tanh(v0[e]); v1[e] = gelu_tanh(v1[e]); } }
                u32x4 w; w.x = cvt_pk_bf16(v0[0], v0[1]); w.y = cvt_pk_bf16(v0[2], v0[3]); w.z = cvt_pk_bf16(v1[0], v1[1]); w.w = cvt_pk_bf16(v1[2], v1[3]);
                *(u32x4*)(rowp + bj * HALF) = w;
            }
            asm volatile("" ::: "memory");
        }
#undef EPI_ROPE_LD
    }
};

struct EpiRes {
    const void* hin_lat; const void* hin_ctx; void* hout_lat; void* hout_ctx; int in_bf16, out_bf16;
    const float* gate;
    bf16_t* HBo; const float* gnext; const float* scnext;
    float* rowpart;
    __device__ __forceinline__ void operator()(const f32x4 (&acc)[2][2][4][2], const Unit& u, int wr, int wc, int fr, int fq) const {
        const bool isctx = u.pm >= 128; const int bidx = isctx ? 16 : (u.pm >> 3);
        const int colb = u.pn * BM + wc * 32 + 8 * fq;
        const int row0 = u.pm * BM + wr * 64 + fr;
        const size_t eoff0 = (size_t)(isctx ? row0 - M_LAT : row0) * DM + colb;
        const char* hi0 = (const char*)(isctx ? hin_ctx : hin_lat) + eoff0 * (in_bf16 ? 2 : 4);
        char* ho0 = (char*)(isctx ? hout_ctx : hout_lat) + eoff0 * (out_bf16 ? 2 : 4);
        u32x4 hq[2][4];
#define EPI_H_LD(it_, slot_) do { const size_t ro_ = (size_t)(((it_) >> 2) * HALF + ((it_) & 3) * 16) * DM; \
            if (in_bf16) { const char* hp_ = hi0 + ro_ * 2; hq[slot_][0] = *(const u32x4*)(hp_); hq[slot_][1] = *(const u32x4*)(hp_ + HALF * 2); } \
            else { const char* hp_ = hi0 + ro_ * 4; hq[slot_][0] = *(const u32x4*)(hp_); hq[slot_][1] = *(const u32x4*)(hp_ + 16); hq[slot_][2] = *(const u32x4*)(hp_ + HALF * 4); hq[slot_][3] = *(const u32x4*)(hp_ + HALF * 4 + 16); } } while (0)
        EPI_H_LD(0, 0); EPI_H_LD(1, 1);
        f32x4 gv[2][2], gm[2][2];
#pragma unroll
        for (int bj = 0; bj < 2; ++bj)
#pragma unroll
            for (int n = 0; n < 2; ++n) {
                gv[bj][n] = *(const f32x4*)(gate + (size_t)bidx * 6144 + colb + bj * HALF + 4 * n);
                if (HBo) { const f32x4 g = *(const f32x4*)(gnext + colb + bj * HALF + 4 * n), sc4 = *(const f32x4*)(scnext + (size_t)bidx * 6144 + colb + bj * HALF + 4 * n); gm[bj][n] = g * (sc4 + 1.0f); }
                else gm[bj][n] = (f32x4){0.f, 0.f, 0.f, 0.f};
            }
#pragma unroll
        for (int it = 0; it < 8; ++it) {
            const int ai = it >> 2, m = it & 3;
            const int roff = ai * HALF + m * 16;
            f32x4 hc[4];
            if (in_bf16) {
#pragma unroll
                for (int bj = 0; bj < 2; ++bj) { const u32x4 w = hq[it & 1][bj]; hc[2 * bj] = (f32x4){bflo(w[0]), bfhi(w[0]), bflo(w[1]), bfhi(w[1])}; hc[2 * bj + 1] = (f32x4){bflo(w[2]), bfhi(w[2]), bflo(w[3]), bfhi(w[3])}; }
            } else {
#pragma unroll
                for (int q = 0; q < 4; ++q) hc[q] = __builtin_bit_cast(f32x4, hq[it & 1][q]);
            }
            if (it + 2 < 8) EPI_H_LD(it + 2, it & 1);
            float ss = 0.f;
#pragma unroll
            for (int bj = 0; bj < 2; ++bj) {
                const f32x4 n0 = hc[2 * bj] + gv[bj][0] * acc[ai][bj][m][0], n1 = hc[2 * bj + 1] + gv[bj][1] * acc[ai][bj][m][1];
                if (out_bf16) { u32x4 w; w.x = cvt_pk_bf16(n0[0], n0[1]); w.y = cvt_pk_bf16(n0[2], n0[3]); w.z = cvt_pk_bf16(n1[0], n1[1]); w.w = cvt_pk_bf16(n1[2], n1[3]);
                    *(u32x4*)(ho0 + ((size_t)roff * DM + bj * HALF) * 2) = w; }
                else { float* ho_ = (float*)(ho0 + ((size_t)roff * DM + bj * HALF) * 4); *(f32x4*)ho_ = n0; *(f32x4*)(ho_ + 4) = n1; }
                ss += (n0[0] * n0[0] + n0[1] * n0[1]) + (n0[2] * n0[2] + n0[3] * n0[3]) + (n1[0] * n1[0] + n1[1] * n1[1]) + (n1[2] * n1[2] + n1[3] * n1[3]);
                if (HBo) { const f32x4 p0 = n0 * gm[bj][0], p1 = n1 * gm[bj][1];
                    u32x4 w; w.x = cvt_pk_bf16(p0[0], p0[1]); w.y = cvt_pk_bf16(p0[2], p0[3]); w.z = cvt_pk_bf16(p1[0], p1[1]); w.w = cvt_pk_bf16(p1[2], p1[3]);
                    *(u32x4*)(HBo + (size_t)(row0 + roff) * DM + colb + bj * HALF) = w; }
            }
            ss += swz_xor<16>(ss); ss = half_sum(ss);
            if (fq == 0) rowpart[(size_t)(row0 + roff) * 16 + u.pn * 4 + wc] = ss;
            asm volatile("" ::: "memory");
        }
#undef EPI_H_LD
    }
};

struct EpiGLU {
    bf16_t* HID; const float* rowpart; const float* bias;
    __device__ __forceinline__ void operator()(const f32x4 (&acc)[2][2][4][2], const Unit& u, int wr, int wc, int fr, int fq) const {
        const bool isctx = u.pm >= 128; const int bidx = isctx ? 16 : (u.pm >> 3);
        const float* bp = bias + (size_t)bidx * NGU + u.pn * BM + wc * 32 + 8 * fq;
        const int row0 = u.pm * BM + wr * 64 + fr;
        float rs[2][4]; row_rstd8(rowpart, row0, fq, rs);
        f32x4 bv[2][2];
#pragma unroll
        for (int bj = 0; bj < 2; ++bj)
#pragma unroll
            for (int n = 0; n < 2; ++n) bv[bj][n] = *(const f32x4*)(bp + bj * HALF + 4 * n);
#pragma unroll
        for (int ai = 0; ai < 2; ++ai)
#pragma unroll
            for (int m = 0; m < 4; ++m) {
                const int row = row0 + ai * HALF + m * 16;
                const float rstd = rs[ai][m];
                u32x4 w;
#pragma unroll
                for (int n = 0; n < 2; ++n)
#pragma unroll
                    for (int hh = 0; hh < 2; ++hh) {
                        const f32x2 ag = {acc[ai][0][m][n][2 * hh], acc[ai][0][m][n][2 * hh + 1]}, au = {acc[ai][1][m][n][2 * hh], acc[ai][1][m][n][2 * hh + 1]};
                        const f32x2 bg = {bv[0][n][2 * hh], bv[0][n][2 * hh + 1]}, bu = {bv[1][n][2 * hh], bv[1][n][2 * hh + 1]};
                        const f32x2 g = ag * rstd + bg, uu = au * rstd + bu;
                        const f32x2 t = g * -1.4426950408889634f;
                        f32x2 d = {__builtin_amdgcn_exp2f(t.x), __builtin_amdgcn_exp2f(t.y)};
                        d = d + 1.0f;
                        const f32x2 r = {__builtin_amdgcn_rcpf(d.x), __builtin_amdgcn_rcpf(d.y)};
                        const f32x2 o = (g * r) * uu;
                        w[2 * n + hh] = cvt_pk_bf16(o.x, o.y);
                    }
                *(u32x4*)(HID + (size_t)row * DFF + u.pn * HALF + wc * 32 + 8 * fq) = w;
            }
    }
};
}

DI void transpose_item(const float* W, int ldw, int col0, bf16_t* WT, int K, int dstrow0, int k0, LAS float* scr, int lane) {
    f32x4 v[8];
#pragma unroll
    for (int i = 0; i < 8; ++i) { const int kk = 8 * i + (lane >> 3); v[i] = *(const f32x4*)(W + (size_t)(k0 + kk) * ldw + col0 + (lane & 7) * 4); }
#pragma unroll
    for (int i = 0; i < 8; ++i) { const int kk = 8 * i + (lane >> 3); LAS float* d = scr + kk * 33 + (lane & 7) * 4; d[0] = v[i].x; d[1] = v[i].y; d[2] = v[i].z; d[3] = v[i].w; }
    LDS_WAIT();
    const int c = lane & 7;
#pragma unroll
    for (int j = 0; j < 4; ++j) { const int n = (lane >> 3) + 8 * j; const LAS float* s = scr + (8 * c) * 33 + n;
        u32x4 o; o.x = f2bf(s[0]) | (f2bf(s[33]) << 16); o.y = f2bf(s[2 * 33]) | (f2bf(s[3 * 33]) << 16); o.z = f2bf(s[4 * 33]) | (f2bf(s[5 * 33]) << 16); o.w = f2bf(s[6 * 33]) | (f2bf(s[7 * 33]) << 16);
        *(u32x4*)(WT + (size_t)(dstrow0 + n) * K + k0 + 8 * c) = o; }
    LDS_WAIT();
}

DI void split_bf16x8(const float (&x)[8], bf16x8& h, bf16x8& r) {
    u32x4 hh, rr;
#pragma unroll
    for (int j = 0; j < 4; ++j) { const unsigned h0 = f2bf(x[2 * j]), h1 = f2bf(x[2 * j + 1]); hh[j] = h0 | (h1 << 16);
        rr[j] = f2bf(x[2 * j] - bf2f(h0)) | (f2bf(x[2 * j + 1] - bf2f(h1)) << 16); }
    h = __builtin_bit_cast(bf16x8, hh); r = __builtin_bit_cast(bf16x8, rr);
}
DI void gemv17(LAS float* A, LAS float* red, const float* W, int ldw, int col0, int ncols, float* out, int ldo, int oc0, const float* addv, int tid) {
    const int lane = tid & 63, ks = __builtin_amdgcn_readfirstlane(tid >> 6), r32 = lane & 31, hi = lane >> 5;
    f32x16 c0 = {}, c1 = {};
    const int cA = (r32 < ncols ? r32 : 0), cB = (32 + r32 < ncols ? 32 + r32 : 0);
    const float* wp = W + (size_t)(ks * 128 + 8 * hi) * ldw + col0;
    const LAS float* ap = A + (r32 < 17 ? r32 : 0) * 1024 + ks * 128 + hi * 8;
    for (int kk = 0; kk < 8; ++kk) {
        float av[8], w0[8], w1[8];
        { const f32x4 a0 = *(const LAS f32x4*)(ap + kk * 16), a1 = *(const LAS f32x4*)(ap + kk * 16 + 4);
          const bool live = r32 < 17;
#pragma unroll
          for (int j = 0; j < 4; ++j) { av[j] = live ? a0[j] : 0.f; av[4 + j] = live ? a1[j] : 0.f; } }
#pragma unroll
        for (int j = 0; j < 8; ++j) { const float* wr = wp + (size_t)(kk * 16 + j) * ldw; w0[j] = wr[cA]; w1[j] = wr[cB]; }
        bf16x8 ah, al, w0h, w0l, w1h, w1l;
        split_bf16x8(av, ah, al); split_bf16x8(w0, w0h, w0l); split_bf16x8(w1, w1h, w1l);
        c0 = __builtin_amdgcn_mfma_f32_32x32x16_bf16(ah, w0h, c0, 0, 0, 0); c1 = __builtin_amdgcn_mfma_f32_32x32x16_bf16(ah, w1h, c1, 0, 0, 0);
        c0 = __builtin_amdgcn_mfma_f32_32x32x16_bf16(ah, w0l, c0, 0, 0, 0); c1 = __builtin_amdgcn_mfma_f32_32x32x16_bf16(ah, w1l, c1, 0, 0, 0);
        c0 = __builtin_amdgcn_mfma_f32_32x32x16_bf16(al, w0h, c0, 0, 0, 0); c1 = __builtin_amdgcn_mfma_f32_32x32x16_bf16(al, w1h, c1, 0, 0, 0);
    }
#pragma unroll
    for (int r = 0; r < 16; ++r) { const int row = crow(r, hi); if (row < 17) { red[(ks * 17 + row) * 64 + r32] = c0[r]; red[(ks * 17 + row) * 64 + 32 + r32] = c1[r]; } }
    __syncthreads();
    for (int o = tid; o < 17 * 64; o += 512) { const int b = o >> 6, cc = o & 63;
        if (cc < ncols) { float s_ = 0.f;
#pragma unroll
            for (int k = 0; k < 8; ++k) s_ += red[(k * 17 + b) * 64 + cc];
            if (addv) s_ += addv[cc];
            out[(size_t)b * ldo + oc0 + cc] = s_; } }
    __syncthreads();
}


#define PRB_T0() const unsigned long long prb_t0_ = (PROBE_SEC_A | PROBE_SEC_B) ? __builtin_amdgcn_s_memrealtime() : 0ull
#define PRB_ADD(sec, wsptr) do { if ((PROBE_SEC_A | PROBE_SEC_B) != 0 && blockIdx.x == PROBE_BLOCK && tid_u == 0) { const unsigned long long d_ = __builtin_amdgcn_s_memrealtime() - prb_t0_; \
        unsigned long long* pa_ = (unsigned long long*)((wsptr) + 32768); if ((sec) == PROBE_SEC_A) pa_[40] += d_; if ((sec) == PROBE_SEC_B) pa_[41] += d_; } } while (0)
DI int swz128(int row, int piece) { return row * 128 + ((piece ^ ((row >> 1) & 7)) << 4); }
DI int tr64_st(int k, int c) { return ((k >> 3) * 2 + (c >> 5)) * 512 + ((k & 7) * 32 + (c & 31)) * 2; }
DI int tr_rd_base(int lane) { return ((lane & 3) << 3) | (((lane >> 2) & 3) << 6) | (((lane >> 4) & 1) << 5) | (((lane >> 5) & 1) << 8); }
template <int OFF> DI s16x4 tr_read_g(int vb) { s16x4 r; asm volatile("ds_read_b64_tr_b16 %0, %1 offset:%2" : "=&v"(r) : "v"(vb), "i"(OFF) : "memory"); return r; }
#define PKV(L, H) (bf16x8){L[0], L[1], L[2], L[3], H[0], H[1], H[2], H[3]}
#define PK4G(P, BASE, OUT) do { u32x4 w = {cvt_pk_bf16(P[BASE + 0], P[BASE + 1]), cvt_pk_bf16(P[BASE + 2], P[BASE + 3]), cvt_pk_bf16(P[BASE + 4], P[BASE + 5]), cvt_pk_bf16(P[BASE + 6], P[BASE + 7])}; \
    OUT = __builtin_bit_cast(bf16x8, w); } while (0)

DI void rg_unit(const KA a, LAS unsigned char* lds, int l, int b, int hd, int half, int tid_in) {
    const int tid_u = launder(tid_in);
    const int lane_u = tid_u & 63, wid = __builtin_amdgcn_readfirstlane(tid_u >> 6);
    LAS bf16_t* GT = (LAS bf16_t*)(lds + 98304);
    LAS bf16_t* RT = (LAS bf16_t*)(lds + 114688);
    LAS float* SUB = (LAS float*)(lds + 131072);
    unsigned char* ws = a.ws();
    const bf16_t* U = (const bf16_t*)(ws + WS_U); const bf16_t* XC = (const bf16_t*)(ws + WS_XC); bf16_t* RGS = (bf16_t*)(ws + WS_RGS); bf16_t* MIX = (bf16_t*)(ws + WS_MIX);
    const int chb = hd * 64 + 32 * half;
    PRB_T0(); const unsigned long long prb_unit0_ = prb_t0_;
    for (int dir = 0; dir < 2; ++dir) {
        const int cj = 32 * half + (lane_u & 31), hi0 = lane_u >> 5;
        const float* wa = a.in(I_RGWA) + (size_t)((l * 2 + dir) * 4 + hd) * 4096;
        const float* wx = a.in(I_RGWX) + (size_t)((l * 2 + dir) * 4 + hd) * 4096;
        bf16x8 wfa[4], wfx[4];
#pragma unroll
        for (int ks = 0; ks < 4; ++ks) {
            u32x4 pa, px;
#pragma unroll
            for (int jj = 0; jj < 4; ++jj) { const int i0 = 16 * ks + 8 * hi0 + 2 * jj;
                pa[jj] = f2bf(wa[i0 * 64 + cj]) | (f2bf(wa[(i0 + 1) * 64 + cj]) << 16);
                px[jj] = f2bf(wx[i0 * 64 + cj]) | (f2bf(wx[(i0 + 1) * 64 + cj]) << 16); }
            wfa[ks] = __builtin_bit_cast(bf16x8, pa); wfx[ks] = __builtin_bit_cast(bf16x8, px);
        }
        const float ba = a.in(I_RGBA)[(size_t)(l * 2 + dir) * 256 + hd * 64 + cj], bxb = a.in(I_RGBX)[(size_t)(l * 2 + dir) * 256 + hd * 64 + cj];
        const float sp8 = -8.0f * softplusf_(-a.in(I_RGLAM)[(size_t)(l * 2 + dir) * 256 + hd * 64 + cj]);
        float carry = 0.f;
#define RG_ROWBASE(blk) ((blk) == 0 ? M_LAT + b * CTXL : b * SEQ + (dir ? 8 - (blk) : (blk) - 1) * 256)
#define RG_DMA_XC(blk) do { const int rb_ = RG_ROWBASE(blk); _Pragma("unroll") for (int k_ = 0; k_ < 4; ++k_) { const int row_ = 8 * (4 * wid + k_) + (lane >> 3), pc_ = (lane & 7) ^ ((row_ >> 1) & 7); \
            __builtin_amdgcn_global_load_lds((const unsigned*)(XC + (size_t)(rb_ + row_) * 256 + hd * 64 + 8 * pc_), (LAS unsigned*)(lds + ((blk) & 1) * 32768 + (4 * wid + k_) * 1024), 16, 0, 0); } } while (0)
        { const int lane = lane_u; RG_DMA_XC(0); }
        for (int blk = 0; blk < 9; ++blk) {
            const int lane = launder(lane_u), r32 = lane & 31, hi = lane >> 5, tid = wid * 64 + lane, c = tid & 31, s = tid >> 5;
            const int rowbase = RG_ROWBASE(blk);
            const bool need = (blk != 0) || (l == 0);
            { PRB_T0();
            if (blk == 0) asm volatile("s_waitcnt vmcnt(0)" ::: "memory");
            BAR_LDS();
            if (blk + 1 < 9) RG_DMA_XC(blk + 1);
            PRB_ADD(11, ws); }
            LAS unsigned char* XCT = lds + (blk & 1) * 32768;
            if (dir == 1 && need) {
#pragma unroll
                for (int k = 0; k < 2; ++k) { const int row = 16 * (2 * wid + k) + (lane >> 2), pc = lane & 3;
                    __builtin_amdgcn_global_load_lds((const unsigned*)(U + (size_t)(rowbase + row) * NU + C_RGG + chb + 8 * pc), (LAS unsigned*)((LAS unsigned char*)GT + (2 * wid + k) * 1024), 16, 0, 0);
                    __builtin_amdgcn_global_load_lds((const unsigned*)(RGS + (size_t)(rowbase + row) * 256 + chb + 8 * pc), (LAS unsigned*)((LAS unsigned char*)RT + (2 * wid + k) * 1024), 16, 0, 0); }
            }
            float av[16], bxv[16];
            { PRB_T0();
            { f32x16 za = {}, zx = {}; const int row = 32 * wid + 16 * ((r32 >> 2) & 1) + 4 * (r32 >> 3) + (r32 & 3);
              bf16x8 af[4]; float xcv[16];
#pragma unroll
              for (int ks = 0; ks < 4; ++ks) af[ks] = *(const LAS bf16x8*)(XCT + swz128(row, 2 * ks + hi));
#pragma unroll
              for (int i = 0; i < 16; ++i) { const int tt = 32 * wid + 16 * hi + i; xcv[i] = bf2f(*(const LAS bf16_t*)(XCT + swz128(tt, cj >> 3) + (cj & 7) * 2)); }
#pragma unroll
              for (int ks = 0; ks < 4; ++ks) { za = __builtin_amdgcn_mfma_f32_32x32x16_bf16(af[ks], wfa[ks], za, 0, 0, 0); zx = __builtin_amdgcn_mfma_f32_32x32x16_bf16(af[ks], wfx[ks], zx, 0, 0, 0); }
#pragma unroll
              for (int i = 0; i < 16; ++i) {
                  const float ea = 1.0f + __expf(-(za[i] + ba)), ex = 1.0f + __expf(-(zx[i] + bxb)); const float inv = rcpf_(ea * ex);
                  const float r = inv * ex, ig = inv * ea;
                  const float la = sp8 * r;
                  const float a_ = __expf(la); av[i] = a_; bxv[i] = __builtin_amdgcn_sqrtf(fmaxf(1.0f - a_ * a_, 0.f)) * (ig * xcv[i]); } }
            PRB_ADD(12, ws); }
            { PRB_T0();
            { float Ap = 1.f, Hh = 0.f;
              if (dir == 0) {
#pragma unroll
                  for (int k = 0; k < 16; ++k) { Hh = av[k] * Hh + bxv[k]; Ap *= av[k]; }
              } else {
#pragma unroll
                  for (int k = 15; k >= 0; --k) { Hh = av[k] * Hh + bxv[k]; Ap *= av[k]; }
              }
              SUB[(s * 32 + c) * 2] = Ap; SUB[(s * 32 + c) * 2 + 1] = Hh; }
            BAR_LDS();
            PRB_ADD(13, ws); }
            float hstart = 0.f;
            { PRB_T0();
            { f32x2 sp[16];
#pragma unroll
              for (int s2 = 0; s2 < 16; ++s2) sp[s2] = *(const LAS f32x2*)(SUB + (s2 * 32 + c) * 2);
              float cr = carry;
              if (dir == 0) {
#pragma unroll
                  for (int s2 = 0; s2 < 16; ++s2) { hstart = (s2 == s) ? cr : hstart; cr = sp[s2].x * cr + sp[s2].y; }
              } else {
#pragma unroll
                  for (int s2 = 15; s2 >= 0; --s2) { hstart = (s2 == s) ? cr : hstart; cr = sp[s2].x * cr + sp[s2].y; }
              }
              carry = cr; }
            asm volatile("s_waitcnt vmcnt(0)" ::: "memory");
            PRB_ADD(14, ws); }
            { PRB_T0();
            { float h = hstart;
              bf16_t rtv[16], gtv[16];
              if (dir == 1 && need) {
#pragma unroll
                  for (int k = 0; k < 16; ++k) { rtv[k] = RT[(16 * s + k) * 32 + c]; gtv[k] = GT[(16 * s + k) * 32 + c]; }
                  LDS_WAIT();
              }
#define RG_APPLY(k) do { const int tt = 16 * s + (k); h = av[k] * h + bxv[k]; \
                  if (need) { const size_t row = (size_t)(rowbase + tt); \
                      if (dir == 0) RGS[row * 256 + chb + c] = (bf16_t)cvt_pk_bf16(h, h); \
                      else { const float y = (bf2f(rtv[k]) + h) * bf2f(gtv[k]); MIX[row * DM + chb + c] = (bf16_t)cvt_pk_bf16(y, y); } } } while (0)
              if (dir == 0) {
#pragma unroll
                  for (int k = 0; k < 16; ++k) RG_APPLY(k);
              } else {
#pragma unroll
                  for (int k = 15; k >= 0; --k) RG_APPLY(k);
              }
#undef RG_APPLY
            }
            PRB_ADD(15, ws); }
        }
        asm volatile("s_waitcnt vmcnt(0)" ::: "memory"); __syncthreads();
#undef RG_ROWBASE
#undef RG_DMA_XC
    }
    { const unsigned long long prb_t0_ = prb_unit0_; PRB_ADD(16, ws); }
}

DI void ssd_unit(const KA a, LAS unsigned char* lds, int l, int b, int head, int dir, int tid_in) {
    const int tid_u = launder(tid_in);
    const int lane_u = tid_u & 63, wid = __builtin_amdgcn_readfirstlane(tid_u >> 6);
    LAS unsigned char* BD = lds + 98304; LAS unsigned char* HL = lds + 114688;
    unsigned char* ws = a.ws();
    const bf16_t* XA = (const bf16_t*)(ws + WS_XBCA); const float* CS = (const float*)(ws + WS_CS); const float* DTS = (const float*)(ws + WS_DTS);
    bf16_t* YS = (bf16_t*)(ws + WS_HB) + (size_t)dir * M_ALL * 256;
    const int grp = head >> 1, j8 = dir * 4 + head;
    const int lb = wid >> 1, ph = wid & 1;
    const int pb = (wid >> 1) & 1, nb = wid & 1;
    f32x16 Hreg = {};
    for (int i = tid_u; i < 2048; i += 512) ((LAS unsigned*)HL)[i] = 0u;
#define SSD_CHUNK(c) ((c) < 2 ? 256 + b * 2 + (dir ? 1 - (c) : (c)) : b * 16 + (dir ? 17 - (c) : (c) - 2))
#define SSD_DMA(c, buf) do { const int ci_ = SSD_CHUNK(c); const int row0_ = 128 * ci_; LAS unsigned char* db_ = lds + (buf) * 49152; \
        _Pragma("unroll") for (int e_ = 0; e_ < 2; ++e_) { \
            { const int srow_ = 8 * (2 * wid + e_) + (lane >> 3), pc_ = (lane & 7) ^ ((srow_ >> 1) & 7); const int grow_ = dir ? row0_ + 127 - srow_ : row0_ + srow_; \
              const bf16_t* src_ = XA + (size_t)grow_ * 512 + 256 + grp * 64 + 8 * pc_; \
              __builtin_amdgcn_global_load_lds((const unsigned*)src_, (LAS unsigned*)(db_ + (2 * wid + e_) * 1024), 16, 0, 0); \
              __builtin_amdgcn_global_load_lds((const unsigned*)(src_ + 128), (LAS unsigned*)(db_ + 16384 + (2 * wid + e_) * 1024), 16, 0, 0); } \
            { const int k_ = 8 * (2 * wid + e_) + ((lane & 31) >> 2), col_ = (lane >> 5) * 32 + (lane & 3) * 8; \
              const int grow_ = dir ? row0_ + 127 - k_ : row0_ + k_; \
              __builtin_amdgcn_global_load_lds((const unsigned*)(XA + (size_t)grow_ * 512 + head * 64 + col_), (LAS unsigned*)(db_ + 32768 + (2 * wid + e_) * 1024), 16, 0, 0); } } \
        if (wid < 4) { const float* sp_ = (wid < 2 ? CS : DTS) + ((size_t)ci_ * 8 + j8) * 128 + 64 * (wid & 1) + lane; \
            __builtin_amdgcn_global_load_lds((const unsigned*)sp_, (LAS unsigned*)(lds + 122880 + (buf) * 1024 + (wid >> 1) * 512 + (wid & 1) * 256), 4, 0, 0); } } while (0)
    PRB_T0(); const unsigned long long prb_unit0_ = prb_t0_;
    { const int lane = lane_u; SSD_DMA(0, 0); }
    for (int c = 0; c < 18; ++c) {
        const int lane = launder(lane_u), r32 = lane & 31, hi = lane >> 5, tid = wid * 64 + lane;
        const int buf = c & 1;
        { PRB_T0();
        if (c == 0) asm volatile("s_waitcnt vmcnt(0)" ::: "memory");
        BAR_LDS();
        if (c + 1 < 18) SSD_DMA(c + 1, buf ^ 1);
        PRB_ADD(1, ws); }
        LAS unsigned char* BT = lds + buf * 49152; LAS unsigned char* CT = BT + 16384; LAS unsigned char* XT = BT + 32768;
        const LAS float* CSL = (const LAS float*)(lds + 122880 + buf * 1024); const LAS float* DTL = CSL + 128;
        const int row0 = 128 * SSD_CHUNK(c);
        const float cs_end = CSL[127];
#define SSD_BDD(BTp_, CSp_, DTp_) do { const float ce_ = (CSp_)[127]; \
        _Pragma("unroll") for (int e = 0; e < 2; ++e) { const int q = tid + 512 * e, sr = q >> 3, p8 = q & 7; \
            const u32x4 x = *(const LAS u32x4*)((BTp_) + swz128(sr, p8)); const float f = __expf(ce_ - (CSp_)[sr]) * (DTp_)[sr]; \
            u32x4 w; \
            _Pragma("unroll") for (int t = 0; t < 4; ++t) w[t] = cvt_pk_bf16(bflo(x[t]) * f, bfhi(x[t]) * f); \
            *(LAS u32x4*)(BD + tr64_st(sr, 8 * p8)) = w; } } while (0)
        { PRB_T0();
        if (c == 0) { SSD_BDD(BT, CSL, DTL); BAR_LDS(); }
        PRB_ADD(2, ws); }
        f32x16 accy = {}, acco = {};
        { PRB_T0();
        {
            f32x16 accz = {};
            const bool both = wid >= 4;
            const int sb0 = both ? 2 * ph : 0, sb1 = both ? (ph ? lb + 1 : 2) : lb + 1;
            const float cs_l = CSL[32 * lb + r32];
            const int xb = (int)(uintptr_t)XT + tr_rd_base(lane) + ph * 512, xz = (int)(uintptr_t)XT + tr_rd_base(lane) + (ph ^ 1) * 512;
            bf16x8 cf[4];
#pragma unroll
            for (int ks = 0; ks < 4; ++ks) cf[ks] = *(const LAS bf16x8*)(CT + swz128(32 * lb + r32, 2 * ks + hi));
#pragma unroll
            for (int ks = 0; ks < 4; ++ks) { const bf16x8 hf = *(const LAS bf16x8*)(HL + swz128(32 * ph + r32, 2 * ks + hi)); acco = __builtin_amdgcn_mfma_f32_32x32x16_bf16(cf[ks], hf, acco, 0, 0, 0); }
            bf16x8 bfq[2][4]; f32x4 c4q[2][4], d4q[2][4]; s16x4 trq[2][4], trz[2][4];
#define SSD_LD(sb_, S_) do { _Pragma("unroll") for (int ks = 0; ks < 4; ++ks) bfq[S_][ks] = *(const LAS bf16x8*)(BT + swz128(32 * (sb_) + r32, 2 * ks + hi)); \
                _Pragma("unroll") for (int q = 0; q < 4; ++q) { c4q[S_][q] = *(const LAS f32x4*)(CSL + 32 * (sb_) + 8 * q + 4 * hi); d4q[S_][q] = *(const LAS f32x4*)(DTL + 32 * (sb_) + 8 * q + 4 * hi); } \
                { const int xs_ = xb + (sb_) * 4096; trq[S_][0] = tr_read_g<0>(xs_); trq[S_][1] = tr_read_g<1024>(xs_); trq[S_][2] = tr_read_g<2048>(xs_); trq[S_][3] = tr_read_g<3072>(xs_); } \
                if (both) { const int xs_ = xz + (sb_) * 4096; trz[S_][0] = tr_read_g<0>(xs_); trz[S_][1] = tr_read_g<1024>(xs_); trz[S_][2] = tr_read_g<2048>(xs_); trz[S_][3] = tr_read_g<3072>(xs_); } } while (0)
            SSD_LD(sb0, 0);
#pragma unroll
            for (int i = 0; i < 2; ++i) { const int sb = sb0 + i; if (sb < sb1) {
                const int S = i;
                asm volatile("s_waitcnt lgkmcnt(0)" ::: "memory"); __builtin_amdgcn_sched_barrier(0);
                f32x16 g = {};
#pragma unroll
                for (int ks = 0; ks < 4; ++ks) g = __builtin_amdgcn_mfma_f32_32x32x16_bf16(bfq[S][ks], cf[ks], g, 0, 0, 0);
                if (i == 0) { if (sb + 1 < sb1) SSD_LD(sb + 1, 1); }
                __builtin_amdgcn_sched_barrier(0);
#pragma unroll
                for (int q = 0; q < 4; ++q) {
#pragma unroll
                    for (int e = 0; e < 4; ++e) { const int r = 4 * q + e, sl = 8 * q + 4 * hi + e; const float f = __expf(cs_l - c4q[S][q][e]) * d4q[S][q][e];
                        g[r] = (sb < lb || sl <= r32) ? g[r] * f : 0.f; } }
                bf16x8 pa0, pa1; PK4G(g, 0, pa0); PK4G(g, 8, pa1);
                accy = __builtin_amdgcn_mfma_f32_32x32x16_bf16(pa0, PKV(trq[S][0], trq[S][1]), accy, 0, 0, 0);
                accy = __builtin_amdgcn_mfma_f32_32x32x16_bf16(pa1, PKV(trq[S][2], trq[S][3]), accy, 0, 0, 0);
                if (both) {
                    accz = __builtin_amdgcn_mfma_f32_32x32x16_bf16(pa0, PKV(trz[S][0], trz[S][1]), accz, 0, 0, 0);
                    accz = __builtin_amdgcn_mfma_f32_32x32x16_bf16(pa1, PKV(trz[S][2], trz[S][3]), accz, 0, 0, 0);
                }
            } }
#undef SSD_LD
            if (both) { LAS float* ex = (LAS float*)(lds + 124928 + (wid - 4) * 4096);
#pragma unroll
                for (int r = 0; r < 16; ++r) ex[r * 64 + lane] = accz[r]; }
            asm volatile("s_waitcnt vmcnt(0)" ::: "memory");
            if (!both && (c >= 2 || l == 0)) {
#pragma unroll
                for (int r = 0; r < 16; ++r) { const int ll = 32 * lb + crow(r, hi); const int grow = dir ? row0 + 127 - ll : row0 + ll;
                    YS[(size_t)grow * 256 + head * 64 + 32 * ph + r32] = (bf16_t)cvt_pk_bf16(accy[r] + __expf(CSL[ll]) * acco[r], 0.f); }
            }
        }
        PRB_ADD(3, ws); }
        { PRB_T0();
        if (wid < 4) {
            f32x16 sacc = {};
            const int xa = (int)(uintptr_t)XT + tr_rd_base(lane) + pb * 512, xbd = (int)(uintptr_t)BD + tr_rd_base(lane) + nb * 512;
#pragma unroll
            for (int kq = 0; kq < 4; ++kq) {
                const s16x4 al0 = tr_read_g<0>(xa + kq * 4096), ah0 = tr_read_g<1024>(xa + kq * 4096), al1 = tr_read_g<2048>(xa + kq * 4096), ah1 = tr_read_g<3072>(xa + kq * 4096);
                const s16x4 bl0 = tr_read_g<0>(xbd + kq * 4096), bh0 = tr_read_g<1024>(xbd + kq * 4096), bl1 = tr_read_g<2048>(xbd + kq * 4096), bh1 = tr_read_g<3072>(xbd + kq * 4096);
                asm volatile("s_waitcnt lgkmcnt(0)" ::: "memory"); __builtin_amdgcn_sched_barrier(0);
                sacc = __builtin_amdgcn_mfma_f32_32x32x16_bf16(PKV(al0, ah0), PKV(bl0, bh0), sacc, 0, 0, 0);
                sacc = __builtin_amdgcn_mfma_f32_32x32x16_bf16(PKV(al1, ah1), PKV(bl1, bh1), sacc, 0, 0, 0);
            }
            const float e_end = __expf(cs_end);
#pragma unroll
            for (int r = 0; r < 16; ++r) Hreg[r] = e_end * Hreg[r] + sacc[r];
        }
        BAR_LDS();
        if (wid < 4) { const int n = 32 * nb + r32;
#pragma unroll
            for (int r = 0; r < 16; ++r) { const int p = 32 * pb + crow(r, hi); *(LAS bf16_t*)(HL + swz128(p, n >> 3) + (n & 7) * 2) = (bf16_t)f2bf(Hreg[r]); } }
        else if (c >= 2 || l == 0) { const LAS float* ex = (const LAS float*)(lds + 124928 + ((wid ^ 1) - 4) * 4096);
#pragma unroll
            for (int r = 0; r < 16; ++r) { const int ll = 32 * lb + crow(r, hi); const int grow = dir ? row0 + 127 - ll : row0 + ll;
                YS[(size_t)grow * 256 + head * 64 + 32 * ph + r32] = (bf16_t)cvt_pk_bf16(accy[r] + ex[r * 64 + lane] + __expf(CSL[ll]) * acco[r], 0.f); } }
        if (c + 1 < 18) { LAS unsigned char* BTn = lds + (buf ^ 1) * 49152; const LAS float* CSn = (const LAS float*)(lds + 122880 + (buf ^ 1) * 1024);
            SSD_BDD(BTn, CSn, CSn + 128); }
        PRB_ADD(4, ws); }
    }
    { const unsigned long long prb_t0_ = prb_unit0_; PRB_ADD(5, ws); }
    asm volatile("s_waitcnt vmcnt(0)" ::: "memory"); __syncthreads();
    if (tid_u == 0) { __builtin_amdgcn_fence(__ATOMIC_RELEASE, "agent"); asm volatile("s_waitcnt vmcnt(0)" ::: "memory");
        __hip_atomic_fetch_add((unsigned*)(ws + WS_SSDCNT) + (l * 16 + b) * 64, 1u, __ATOMIC_RELAXED, __HIP_MEMORY_SCOPE_AGENT); }
#undef SSD_CHUNK
#undef SSD_DMA
#undef SSD_BDD
}

template <int R> DI void ssd_combine_rows(const KA a, int l, int row0, int rstep, int nrows, int lane) {
    unsigned char* ws = a.ws();
    const bf16_t* U = (const bf16_t*)(ws + WS_U); const bf16_t* XA = (const bf16_t*)(ws + WS_XBCA); const bf16_t* YS = (const bf16_t*)(ws + WS_HB); bf16_t* MIX = (bf16_t*)(ws + WS_MIX);
    const int ch = 4 * lane, head = lane >> 4;
    u32x2 xx[R], zz[R], yf[R], yb[R];
#pragma unroll
    for (int r = 0; r < R; ++r) { const int row = row0 + r * rstep; if (row < nrows) {
        xx[r] = *(const u32x2*)(XA + (size_t)row * 512 + ch); zz[r] = *(const u32x2*)(U + (size_t)row * NU + C_SZ + ch);
        yf[r] = *(const u32x2*)(YS + (size_t)row * 256 + ch); yb[r] = *(const u32x2*)(YS + (size_t)M_ALL * 256 + (size_t)row * 256 + ch); } }
    const float dsk = a.in(I_SD)[l * 4 + head];
    const f32x4 g = *(const f32x4*)(a.in(I_SNG) + (size_t)l * 256 + ch);
#pragma unroll
    for (int r = 0; r < R; ++r) { const int row = row0 + r * rstep; if (row < nrows) {
        const float xv[4] = {bflo(xx[r][0]), bfhi(xx[r][0]), bflo(xx[r][1]), bfhi(xx[r][1])};
        const float z[4] = {bflo(zz[r][0]), bfhi(zz[r][0]), bflo(zz[r][1]), bfhi(zz[r][1])};
        const float yfv[4] = {bflo(yf[r][0]), bfhi(yf[r][0]), bflo(yf[r][1]), bfhi(yf[r][1])}, ybv[4] = {bflo(yb[r][0]), bfhi(yb[r][0]), bflo(yb[r][1]), bfhi(yb[r][1])};
        float o[4]; float ss = 0.f;
#pragma unroll
        for (int e = 0; e < 4; ++e) { const float y = xv[e] * dsk + yfv[e] + ybv[e]; o[e] = y * siluf_(z[e]); ss += o[e] * o[e]; }
        ss = sum32(ss);
        const float rs = __builtin_amdgcn_rsqf(ss * (1.0f / 128.0f) + EPS);
        u32x2 w; w.x = cvt_pk_bf16(o[0] * rs * g[0], o[1] * rs * g[1]); w.y = cvt_pk_bf16(o[2] * rs * g[2], o[3] * rs * g[3]);
        *(u32x2*)(MIX + (size_t)row * DM + 256 + ch) = w; } }
}

DI void ssd_combine_pipe(const KA a, int l, int row0, int nrows, int lane) {
    unsigned char* ws = a.ws();
    const bf16_t* U = (const bf16_t*)(ws + WS_U); const bf16_t* XA = (const bf16_t*)(ws + WS_XBCA); const bf16_t* YS = (const bf16_t*)(ws + WS_HB); bf16_t* MIX = (bf16_t*)(ws + WS_MIX);
    const int ch = 4 * lane, head = lane >> 4;
    const float dsk = a.in(I_SD)[l * 4 + head];
    const f32x4 g = *(const f32x4*)(a.in(I_SNG) + (size_t)l * 256 + ch);
#define CMB_LOAD(S_, r0_) do { _Pragma("unroll") for (int r = 0; r < 3; ++r) { const int row = (r0_) + r * 8; if (row < nrows) { \
        xx[S_][r] = *(const u32x2*)(XA + (size_t)row * 512 + ch); zz[S_][r] = *(const u32x2*)(U + (size_t)row * NU + C_SZ + ch); \
        yf[S_][r] = *(const u32x2*)(YS + (size_t)row * 256 + ch); yb[S_][r] = *(const u32x2*)(YS + (size_t)M_ALL * 256 + (size_t)row * 256 + ch); } } } while (0)
#define CMB_COMP(S_, r0_) do { _Pragma("unroll") for (int r = 0; r < 3; ++r) { const int row = (r0_) + r * 8; if (row < nrows) { \
        const float xv[4] = {bflo(xx[S_][r][0]), bfhi(xx[S_][r][0]), bflo(xx[S_][r][1]), bfhi(xx[S_][r][1])}; \
        const float z[4] = {bflo(zz[S_][r][0]), bfhi(zz[S_][r][0]), bflo(zz[S_][r][1]), bfhi(zz[S_][r][1])}; \
        const float yfv[4] = {bflo(yf[S_][r][0]), bfhi(yf[S_][r][0]), bflo(yf[S_][r][1]), bfhi(yf[S_][r][1])}, ybv[4] = {bflo(yb[S_][r][0]), bfhi(yb[S_][r][0]), bflo(yb[S_][r][1]), bfhi(yb[S_][r][1])}; \
        float o[4]; float ss = 0.f; \
        _Pragma("unroll") for (int e = 0; e < 4; ++e) { const float y = xv[e] * dsk + yfv[e] + ybv[e]; o[e] = y * siluf_(z[e]); ss += o[e] * o[e]; } \
        ss = sum32(ss); \
        const float rs = __builtin_amdgcn_rsqf(ss * (1.0f / 128.0f) + EPS); \
        u32x2 w; w.x = cvt_pk_bf16(o[0] * rs * g[0], o[1] * rs * g[1]); w.y = cvt_pk_bf16(o[2] * rs * g[2], o[3] * rs * g[3]); \
        *(u32x2*)(MIX + (size_t)row * DM + 256 + ch) = w; } } } while (0)
    u32x2 xx[2][3], zz[2][3], yf[2][3], yb[2][3];
    int r0 = row0;
    if (r0 < nrows) CMB_LOAD(0, r0);
    for (; r0 < nrows; r0 += 48) {
        const bool has1 = r0 + 24 < nrows;
        if (has1) CMB_LOAD(1, r0 + 24);
        CMB_COMP(0, r0);
        if (has1) { if (r0 + 48 < nrows) CMB_LOAD(0, r0 + 48); CMB_COMP(1, r0 + 24); }
    }
#undef CMB_LOAD
#undef CMB_COMP
}

DI void preconv_rows(const KA a, int l, int gw, int NGW, int lane) {
    unsigned char* ws = a.ws();
    const bf16_t* U = (const bf16_t*)(ws + WS_U); bf16_t* XA = (bf16_t*)(ws + WS_XBCA); bf16_t* XC = (bf16_t*)(ws + WS_XC);
    float ws8[4][8], bs8[8], wr4[4][4], br4[4];
#pragma unroll
    for (int j = 0; j < 4; ++j) { const f32x4 w0 = *(const f32x4*)(a.in(I_SCW) + (size_t)l * 2048 + j * 512 + 8 * lane), w1 = *(const f32x4*)(a.in(I_SCW) + (size_t)l * 2048 + j * 512 + 8 * lane + 4);
        const f32x4 r0 = *(const f32x4*)(a.in(I_RGCW) + (size_t)l * 1024 + j * 256 + 4 * lane);
#pragma unroll
        for (int e = 0; e < 4; ++e) { ws8[j][e] = w0[e]; ws8[j][4 + e] = w1[e]; wr4[j][e] = r0[e]; } }
    { const f32x4 b0 = *(const f32x4*)(a.in(I_SCB) + (size_t)l * 512 + 8 * lane), b1 = *(const f32x4*)(a.in(I_SCB) + (size_t)l * 512 + 8 * lane + 4), r0 = *(const f32x4*)(a.in(I_RGCB) + (size_t)l * 256 + 4 * lane);
#pragma unroll
      for (int e = 0; e < 4; ++e) { bs8[e] = b0[e]; bs8[4 + e] = b1[e]; br4[e] = r0[e]; } }
    constexpr int R = 4;
    static_assert(SEQ % R == 0 && CTXL % R == 0 && M_LAT % R == 0 && M_ALL % R == 0, "row groups must not straddle sequences");
#define PRE_LOAD(x_, y_, g0_) do { const int gg_ = (g0_); const bool isctx_ = gg_ >= M_LAT; const int t0_ = isctx_ ? (gg_ - M_LAT) & (CTXL - 1) : gg_ & (SEQ - 1); const int seglen_ = isctx_ ? CTXL : SEQ; \
        _Pragma("unroll") for (int k = 0; k < R + 3; ++k) { const int ts = t0_ + k - 2; x_[k] = (u32x4){0u, 0u, 0u, 0u}; y_[k] = (u32x2){0u, 0u}; \
            if (ts >= 0 && ts < seglen_) { const bf16_t* up = U + (size_t)(gg_ + k - 2) * NU; x_[k] = *(const u32x4*)(up + C_XBC + 8 * lane); y_[k] = *(const u32x2*)(up + C_RGX + 4 * lane); } } } while (0)
#define PRE_COMP(x_, y_, g0_) do { \
        _Pragma("unroll") for (int i = 0; i < R; ++i) { const int row = (g0_) + i; \
            float v[8], r[4]; \
            _Pragma("unroll") for (int e = 0; e < 8; ++e) v[e] = bs8[e]; \
            _Pragma("unroll") for (int e = 0; e < 4; ++e) r[e] = br4[e]; \
            _Pragma("unroll") for (int j = 0; j < 4; ++j) {                         \
                _Pragma("unroll") for (int e = 0; e < 4; ++e) { v[2 * e] += ws8[j][2 * e] * bflo(x_[i + j][e]); v[2 * e + 1] += ws8[j][2 * e + 1] * bfhi(x_[i + j][e]); } \
                r[0] += wr4[j][0] * bflo(y_[i + j][0]); r[1] += wr4[j][1] * bfhi(y_[i + j][0]); r[2] += wr4[j][2] * bflo(y_[i + j][1]); r[3] += wr4[j][3] * bfhi(y_[i + j][1]); } \
            u32x4 w; \
            _Pragma("unroll") for (int e = 0; e < 4; ++e) w[e] = cvt_pk_bf16(siluf_(v[2 * e]), siluf_(v[2 * e + 1])); \
            *(u32x4*)(XA + (size_t)row * 512 + 8 * lane) = w; \
            u32x2 w2; w2.x = cvt_pk_bf16(r[0], r[1]); w2.y = cvt_pk_bf16(r[2], r[3]); \
            *(u32x2*)(XC + (size_t)row * 256 + 4 * lane) = w2; } } while (0)
    {
        const int gstep = NGW * R;
        u32x4 xa[R + 3], xb[R + 3]; u32x2 ya[R + 3], yb[R + 3];
        int g0 = gw * R;
        if (g0 < M_ALL) PRE_LOAD(xa, ya, g0);
        for (; g0 < M_ALL; g0 += 2 * gstep) {
            const bool has1 = g0 + gstep < M_ALL;
            if (has1) PRE_LOAD(xb, yb, g0 + gstep);
            PRE_COMP(xa, ya, g0);
            if (has1) {
                if (g0 + 2 * gstep < M_ALL) PRE_LOAD(xa, ya, g0 + 2 * gstep);
                PRE_COMP(xb, yb, g0 + gstep);
            }
        }
    }
#undef PRE_LOAD
#undef PRE_COMP
}
DI void ssd_chunk_scan(const KA a, int l, int ci, int lane) {
    unsigned char* ws = a.ws();
    const float* DT = (const float*)(ws + WS_DT); float* CS = (float*)(ws + WS_CS); float* DTS = (float*)(ws + WS_DTS);
    const int row0 = 128 * ci;
    const f32x4 d00 = *(const f32x4*)(DT + (size_t)(row0 + 2 * lane) * 8), d01 = *(const f32x4*)(DT + (size_t)(row0 + 2 * lane) * 8 + 4);
    const f32x4 d10 = *(const f32x4*)(DT + (size_t)(row0 + 2 * lane + 1) * 8), d11 = *(const f32x4*)(DT + (size_t)(row0 + 2 * lane + 1) * 8 + 4);
    const float dt0[8] = {d00[0], d00[1], d00[2], d00[3], d01[0], d01[1], d01[2], d01[3]}, dt1[8] = {d10[0], d10[1], d10[2], d10[3], d11[0], d11[1], d11[2], d11[3]};
#pragma unroll
    for (int j = 0; j < 8; ++j) {
        const float an = -__expf(a.in(I_SALOG)[l * 8 + j]);
        const float a0 = dt0[j] * an, a1 = dt1[j] * an;
        float incl = a0 + a1;
#pragma unroll
        for (int d = 1; d < 64; d <<= 1) { const float o = __builtin_bit_cast(float, __builtin_amdgcn_ds_bpermute((lane - d) << 2, __builtin_bit_cast(int, incl))); if (lane >= d) incl += o; }
        const float excl = incl - (a0 + a1);
        float* cs = CS + ((size_t)ci * 8 + j) * 128; float* ds = DTS + ((size_t)ci * 8 + j) * 128;
        if (j < 4) { cs[2 * lane] = excl + a0; cs[2 * lane + 1] = incl; ds[2 * lane] = dt0[j]; ds[2 * lane + 1] = dt1[j]; }
        else { const float tot = __builtin_bit_cast(float, __builtin_amdgcn_readlane(__builtin_bit_cast(int, incl), 63));
            cs[127 - 2 * lane] = tot - excl; cs[126 - 2 * lane] = tot - excl - a0; ds[127 - 2 * lane] = dt0[j]; ds[126 - 2 * lane] = dt1[j]; }
    }
}

namespace att {
constexpr int SHM_V = 16384, SHM_K = 16384;
constexpr float THR = 8.0f;
#define KSWZ(row, colB) ((row) * 256 + ((colB) ^ (((row) & 15) << 4)))
#define SBAR() __builtin_amdgcn_sched_barrier(0)
DI int v_st(int k, int c) { const int kk = (k & ~0xC) | ((k & 4) << 1) | ((k & 8) >> 1); return ((kk >> 3) * 4 + (c >> 5)) * 512 + ((kk & 7) * 32 + (c & 31)) * 2; }
DI int v_rd_base(int lane) { return ((lane & 3) << 3) | (((lane >> 2) & 3) << 6) | (((lane >> 4) & 1) << 5) | (((lane >> 5) & 1) << 8); }
constexpr int v_rd_off(int d0, int ks, int half) { return d0 * 512 + ks * 4096 + half * 2048; }
template <int OFF> DI s16x4 tr_read(int vb) { s16x4 r; asm volatile("ds_read_b64_tr_b16 %0, %1 offset:%2" : "=&v"(r) : "v"(vb), "i"(OFF) : "memory"); return r; }

template <int C> DI void qkt(f32x16& p0, f32x16& p1, const LAS char* Ks, const LAS char* Qs, int r32, int hi) {
    p0 = f32x16{}; p1 = f32x16{};
#pragma unroll
    for (int d = 0; d < 4; ++d) { const int d0 = 4 * C + d; const int cb = (d0 * 16 + hi * 8) * 2;
        const bf16x8 b0 = *(const LAS bf16x8*)(Ks + KSWZ(r32, cb));
        const bf16x8 b1 = *(const LAS bf16x8*)(Ks + KSWZ(32 + r32, cb));
        const bf16x8 q = *(const LAS bf16x8*)(Qs + KSWZ(r32, cb));
        p0 = __builtin_amdgcn_mfma_f32_32x32x16_bf16(b0, q, p0, 0, 0, 0);
        p1 = __builtin_amdgcn_mfma_f32_32x32x16_bf16(b1, q, p1, 0, 0, 0); }
}
DI void softmax_tile(f32x16& p0, f32x16& p1, float& m_reg, float& l_reg, float& alpha, bf16x8& pa0, bf16x8& pa1, bf16x8& pa2, bf16x8& pa3) {
    float pmax = p0[0];
#pragma unroll
    for (int r = 1; r < 16; ++r) pmax = fmaxf(pmax, p0[r]);
#pragma unroll
    for (int r = 0; r < 16; ++r) pmax = fmaxf(pmax, p1[r]);
    { auto rr = __builtin_amdgcn_permlane32_swap(__float_as_uint(pmax), __float_as_uint(pmax), false, false); pmax = fmaxf(__uint_as_float(rr[0]), __uint_as_float(rr[1])); }
    if (__builtin_expect(__all(pmax - m_reg <= THR), 1)) { alpha = 1.f; }
    else { const float mn = fmaxf(m_reg, pmax); alpha = __builtin_amdgcn_exp2f(m_reg - mn); m_reg = mn; }
    float ps = 0.f;
#pragma unroll
    for (int r = 0; r < 16; ++r) { p0[r] = __builtin_amdgcn_exp2f(p0[r] - m_reg); ps += p0[r]; }
#pragma unroll
    for (int r = 0; r < 16; ++r) { p1[r] = __builtin_amdgcn_exp2f(p1[r] - m_reg); ps += p1[r]; }
    { auto rr = __builtin_amdgcn_permlane32_swap(__float_as_uint(ps), __float_as_uint(ps), false, false); ps = __uint_as_float(rr[0]) + __uint_as_float(rr[1]); }
    l_reg = l_reg * alpha + ps;
#define PK4(P, BASE, OUT) do { u32x4 w = {cvt_pk_bf16(P[BASE + 0], P[BASE + 1]), cvt_pk_bf16(P[BASE + 2], P[BASE + 3]), cvt_pk_bf16(P[BASE + 4], P[BASE + 5]), cvt_pk_bf16(P[BASE + 6], P[BASE + 7])}; \
    OUT = __builtin_bit_cast(bf16x8, w); } while (0)
    PK4(p0, 0, pa0); PK4(p0, 8, pa1); PK4(p1, 0, pa2); PK4(p1, 8, pa3);
#undef PK4
}
template <int C> DI bool fast_comp(const LAS char* Ks, const LAS char* Qs, int r32, int hi, bool first, float& ps_out, bf16x8& pa0, bf16x8& pa1, bf16x8& pa2, bf16x8& pa3) {
    f32x16 p0, p1;
    qkt<C>(p0, p1, Ks, Qs, r32, hi);
    if (first) {
        float pmax = p0[0];
#pragma unroll
        for (int r = 1; r < 16; ++r) pmax = fmaxf(pmax, p0[r]);
#pragma unroll
        for (int r = 0; r < 16; ++r) pmax = fmaxf(pmax, p1[r]);
        { auto rr = __builtin_amdgcn_permlane32_swap(__float_as_uint(pmax), __float_as_uint(pmax), false, false); pmax = fmaxf(__uint_as_float(rr[0]), __uint_as_float(rr[1])); }
        if (!__all(__builtin_fabsf(pmax) <= 60.0f)) return false;
    }
    float ps = 0.f;
#pragma unroll
    for (int r = 0; r < 16; ++r) { p0[r] = __builtin_amdgcn_exp2f(p0[r]); ps += p0[r]; }
#pragma unroll
    for (int r = 0; r < 16; ++r) { p1[r] = __builtin_amdgcn_exp2f(p1[r]); ps += p1[r]; }
    { auto rr = __builtin_amdgcn_permlane32_swap(__float_as_uint(ps), __float_as_uint(ps), false, false); ps = __uint_as_float(rr[0]) + __uint_as_float(rr[1]); }
    if (!__all(ps <= 1.2676506e30f)) return false;
    ps_out = ps;
#define PK4(P, BASE, OUT) do { u32x4 w = {cvt_pk_bf16(P[BASE + 0], P[BASE + 1]), cvt_pk_bf16(P[BASE + 2], P[BASE + 3]), cvt_pk_bf16(P[BASE + 4], P[BASE + 5]), cvt_pk_bf16(P[BASE + 6], P[BASE + 7])}; \
    OUT = __builtin_bit_cast(bf16x8, w); } while (0)
    PK4(p0, 0, pa0); PK4(p0, 8, pa1); PK4(p1, 0, pa2); PK4(p1, 8, pa3);
#undef PK4
    return true;
}
template <int D0> DI void pv_one(f32x16& oa, f32x16& ob, int vb, const bf16x8 (&pa)[4], const bf16x8 (&pb)[4]) {
    const s16x4 l0 = tr_read<v_rd_off(D0, 0, 0)>(vb), h0 = tr_read<v_rd_off(D0, 0, 1)>(vb), l1 = tr_read<v_rd_off(D0, 1, 0)>(vb), h1 = tr_read<v_rd_off(D0, 1, 1)>(vb);
    const s16x4 l2 = tr_read<v_rd_off(D0, 2, 0)>(vb), h2 = tr_read<v_rd_off(D0, 2, 1)>(vb), l3 = tr_read<v_rd_off(D0, 3, 0)>(vb), h3 = tr_read<v_rd_off(D0, 3, 1)>(vb);
    asm volatile("s_waitcnt lgkmcnt(0)" ::: "memory"); SBAR();
#define PK(L, H) (bf16x8){L[0], L[1], L[2], L[3], H[0], H[1], H[2], H[3]}
    const bf16x8 v0 = PK(l0, h0), v1 = PK(l1, h1), v2 = PK(l2, h2), v3 = PK(l3, h3);
    oa = __builtin_amdgcn_mfma_f32_32x32x16_bf16(pa[0], v0, oa, 0, 0, 0); ob = __builtin_amdgcn_mfma_f32_32x32x16_bf16(pb[0], v0, ob, 0, 0, 0);
    oa = __builtin_amdgcn_mfma_f32_32x32x16_bf16(pa[1], v1, oa, 0, 0, 0); ob = __builtin_amdgcn_mfma_f32_32x32x16_bf16(pb[1], v1, ob, 0, 0, 0);
    oa = __builtin_amdgcn_mfma_f32_32x32x16_bf16(pa[2], v2, oa, 0, 0, 0); ob = __builtin_amdgcn_mfma_f32_32x32x16_bf16(pb[2], v2, ob, 0, 0, 0);
    oa = __builtin_amdgcn_mfma_f32_32x32x16_bf16(pa[3], v3, oa, 0, 0, 0); ob = __builtin_amdgcn_mfma_f32_32x32x16_bf16(pb[3], v3, ob, 0, 0, 0);
#undef PK
}

DI void attn_unit(LAS unsigned char* lds, const bf16_t* __restrict__ U, bf16_t* __restrict__ MIX, int qrow0, int lat0, int nlat, int ctx0, int nctx, int h,
                  float lam, int lsel, const float* __restrict__ subg, int tid_in) {
    const int tid = launder(tid_in);
    const int wid = __builtin_amdgcn_readfirstlane(tid >> 6), lane = tid & 63, r32 = lane & 31, hi = lane >> 5;
    LAS char* V_lds = (LAS char*)lds; LAS char* K_lds = (LAS char*)lds + 2 * SHM_V;
    LAS float* wsf = (LAS float*)(lds + 2 * SHM_V + 2 * SHM_K) + wid * 128;
    LAS char* Qs = (LAS char*)lds + 2 * SHM_V + 2 * SHM_K + 4096 + wid * 8192;
    float mA = 0.f, lA = 0.f, mB = 0.f, lB = 0.f;
    bool fast = true, anyslow = false;
    f32x16 oA[4] = {}, oB[4] = {};
    { const bf16_t* Qw = U + (size_t)(qrow0 + wid * 32 + r32) * NU + C_Q + h * 128 + hi * 8;
#pragma unroll
      for (int d0 = 0; d0 < 8; ++d0) *(LAS bf16x8*)(Qs + KSWZ(r32, (d0 * 16 + hi * 8) * 2)) = *(const bf16x8*)(Qw + d0 * 16); }
    const int vb0 = (int)(uintptr_t)V_lds + v_rd_base(lane);
    const int NT = nlat + nctx;
    unsigned offK[2], offV[2];
#pragma unroll
    for (int e = 0; e < 2; ++e) { const int row = 8 * wid + 4 * e + (lane >> 4), p = (lane & 15) ^ (row & 15); offK[e] = (unsigned)(row * NU + p * 8) * 2u;
        const int k = 8 * wid + ((lane & 31) >> 2), col = (2 * e + (lane >> 5)) * 32 + (lane & 3) * 8; offV[e] = (unsigned)(k * NU + col) * 2u; }
    const char* Ubase = (const char*)U + (size_t)h * 256;
#define KROW(j) ((j) < nlat ? lat0 + 64 * (j) : ctx0 + 64 * ((j) - nlat))
#define DMA_TILE(j, bsel) do { const char* tb_ = Ubase + (size_t)KROW(j) * (NU * 2); \
        _Pragma("unroll") for (int e_ = 0; e_ < 2; ++e_) { \
            __builtin_amdgcn_global_load_lds((const unsigned*)(tb_ + C_K * 2 + offK[e_]), (LAS unsigned*)(K_lds + (bsel) * SHM_K + (2 * wid + e_) * 1024), 16, 0, 0); \
            __builtin_amdgcn_global_load_lds((const unsigned*)(tb_ + C_V * 2 + offV[e_]), (LAS unsigned*)(V_lds + (bsel) * SHM_V + (2 * wid + e_) * 1024), 16, 0, 0); } } while (0)
    DMA_TILE(0, 0);
    asm volatile("s_waitcnt vmcnt(0)" ::: "memory"); __syncthreads();
    for (int j = 0; j < NT; ++j) {
        const int bsel = j & 1;
        if (j + 1 < NT) DMA_TILE(j + 1, bsel ^ 1);
        const LAS char* Ks = K_lds + bsel * SHM_K;
        bf16x8 pa[4], pb[4];
        bool done = false;
        if (fast) {
            float psA, psB;
            bool ok = fast_comp<0>(Ks, Qs, r32, hi, j == 0, psA, pa[0], pa[1], pa[2], pa[3]);
            if (ok) ok = fast_comp<1>(Ks, Qs, r32, hi, j == 0, psB, pb[0], pb[1], pb[2], pb[3]);
            if (ok) { lA += psA; lB += psB; done = true; } else fast = false;
        }
        if (!done) {
            f32x16 p0, p1; float alA, alB;
            const bool first = !anyslow && j == 0; anyslow = true;
            if (first) { mA = -1e30f; mB = -1e30f; }
            qkt<0>(p0, p1, Ks, Qs, r32, hi); softmax_tile(p0, p1, mA, lA, alA, pa[0], pa[1], pa[2], pa[3]);
            qkt<1>(p0, p1, Ks, Qs, r32, hi); softmax_tile(p0, p1, mB, lB, alB, pb[0], pb[1], pb[2], pb[3]);
            if (__any(alA < 1.f || alB < 1.f)) {
                const int ln = lane_fresh(), hr = ln >> 5;
                if (hr == 0) { wsf[ln & 31] = alA; wsf[32 + (ln & 31)] = alB; }
                LDS_WAIT();
#pragma unroll
                for (int r = 0; r < 16; ++r) { const float fa = wsf[crow(r, hr)], fb = wsf[32 + crow(r, hr)];
#pragma unroll
                    for (int d = 0; d < 4; ++d) { oA[d][r] *= fa; oB[d][r] *= fb; } }
            }
        }
        const int vb = vb0 + bsel * SHM_V;
        pv_one<0>(oA[0], oB[0], vb, pa, pb); pv_one<1>(oA[1], oB[1], vb, pa, pb); pv_one<2>(oA[2], oB[2], vb, pa, pb); pv_one<3>(oA[3], oB[3], vb, pa, pb);
        asm volatile("s_waitcnt vmcnt(0)" ::: "memory"); __syncthreads();
    }
#undef KROW
#undef DMA_TILE
    const int lane_e = lane_fresh(), r32e = lane_e & 31, hie = lane_e >> 5;
    if (hie == 0) { wsf[64 + r32e] = lA; wsf[96 + r32e] = lB; }
    LDS_WAIT();
    float ssq[16];
#pragma unroll
    for (int r = 0; r < 16; ++r) { const float ra = __builtin_amdgcn_rcpf(wsf[64 + crow(r, hie)]), rb = lam * __builtin_amdgcn_rcpf(wsf[96 + crow(r, hie)]);
        float s = 0.f;
#pragma unroll
        for (int d = 0; d < 4; ++d) { const float o = oA[d][r] * ra - oB[d][r] * rb; oA[d][r] = o; s += o * o; }
        ssq[r] = s; }
#pragma unroll
    for (int r = 0; r < 16; ++r) {
        ssq[r] = sum32(ssq[r]);
    }
    const float outscale = launder_s(lsel) == 0 ? 0.8f : 0.64449093f;
    float gsub[4];
#pragma unroll
    for (int d = 0; d < 4; ++d) gsub[d] = subg[32 * d + r32e] * outscale;
#pragma unroll
    for (int r = 0; r < 16; ++r) { const float rs = __builtin_amdgcn_rsqf(ssq[r] * (1.0f / 128.0f) + EPS);
        bf16_t* op = MIX + (size_t)(qrow0 + wid * 32 + crow(r, hie)) * DM + 512 + h * 128 + r32e;
#pragma unroll
        for (int d = 0; d < 4; ++d) op[32 * d] = (bf16_t)f2bf(oA[d][r] * rs * gsub[d]); }
    BAR_LDS();
}
#undef KSWZ
#undef SBAR
}

#define XB_TMO      128
#define XB_XCNT(j)  (256  + 64 * (j))
#define XB_XSUB(j)  (1280 + 64 * (j))
#define XB_XGEN(j)  (2304 + 64 * (j))
#define XB_TOP      3328
#define XB_TOPGEN   3392
#define XCD_BAR_WORDS 3456
#define XB_SPIN_CAP (1u << 20)
DI unsigned xb_ld(unsigned* p)              { return __hip_atomic_load(p, __ATOMIC_RELAXED, __HIP_MEMORY_SCOPE_AGENT); }
DI unsigned xb_add(unsigned* p, unsigned v) { return __hip_atomic_fetch_add(p, v, __ATOMIC_RELAXED, __HIP_MEMORY_SCOPE_AGENT); }
DI unsigned xb_xcc_id() { return (unsigned)__builtin_amdgcn_s_getreg((3 << 11) | 20) & 0xFu; }
#define XB_SPIN(cond, bar) do { unsigned _sp = 0; while (cond) { __builtin_amdgcn_s_sleep(1); \
    if ((++_sp & 255u) == 0u) { if (xb_ld(&(bar)[XB_TMO])) break; if (_sp > XB_SPIN_CAP) { atomicAdd(&(bar)[XB_TMO], 1u); break; } } } } while (0)
struct XcdBarrier { unsigned* bar; unsigned x; volatile LAS unsigned* st; };
DI void xcd_barrier_complete(unsigned* bar, unsigned x, unsigned& nloc, unsigned& nx) {
    const unsigned G = gridDim.x;
    unsigned sum, cnt, mine, sp = 0u;
    for (;;) {
        sum = 0u; cnt = 0u; mine = 0u;
#pragma unroll
        for (unsigned j = 0; j < 16; ++j) { const unsigned c = xb_ld(&bar[XB_XCNT(j)]); sum += c; cnt += (c > 0u) ? 1u : 0u; mine = (j == x) ? c : mine; }
        if (sum == G) break;
        __builtin_amdgcn_s_sleep(1);
        if ((++sp & 255u) == 0u) { if (xb_ld(&bar[XB_TMO])) break; if (sp > XB_SPIN_CAP) { atomicAdd(&bar[XB_TMO], 1u); break; } }
    }
    nloc = mine > 0u ? mine : 1u; nx = cnt > 0u ? cnt : 1u;
}
DI void xcd_barrier(const XcdBarrier& b, int wave) {
    asm volatile("s_waitcnt vmcnt(0)" ::: "memory");
    __syncthreads();
    if (wave == 0 && lane_fresh() == 0) {
        unsigned* bar = b.bar;
        __builtin_amdgcn_s_waitcnt(0);
        unsigned nloc = b.st[0], nx = b.st[1];
        if (nloc == 0u) { xcd_barrier_complete(bar, b.x, nloc, nx); b.st[0] = nloc; b.st[1] = nx; }
        const unsigned old = xb_add(&bar[XB_XSUB(b.x)], 1u);
        const unsigned gen = old / nloc;
        if (old + 1u == (gen + 1u) * nloc) {
            __builtin_amdgcn_fence(__ATOMIC_RELEASE, "agent");
            asm volatile("s_waitcnt vmcnt(0)" ::: "memory");
            const unsigned og = xb_add(&bar[XB_TOP], 1u);
            const unsigned tg = og / nx;
            if (og + 1u == (tg + 1u) * nx) xb_add(&bar[XB_TOPGEN], 1u);
            else XB_SPIN(xb_ld(&bar[XB_TOPGEN]) == tg, bar);
            __builtin_amdgcn_fence(__ATOMIC_ACQUIRE, "agent");
            xb_add(&bar[XB_XGEN(b.x)], 1u);
            asm volatile("s_waitcnt vmcnt(0)" ::: "memory");
        } else {
            XB_SPIN(xb_ld(&bar[XB_XGEN(b.x)]) == gen, bar);
            __builtin_amdgcn_fence(__ATOMIC_ACQUIRE, "agent");
            asm volatile("s_waitcnt vmcnt(0)" ::: "memory");
        }
    }
    __syncthreads();
}

DI void convert_weights(const KA a, int l, int widx, int nw, int lane, LAS float* scr) {
    unsigned char* wl = a.ws() + WS_W + (size_t)l * W_LAYER;
    for (int it = widx; it < 6144; it += nw) { int r = it;
        if (r < 1408) { const int kb = r / 88, nb = r % 88, n0 = 32 * nb; transpose_item(a.in(I_WIN) + (size_t)l * 1024 * DIN, DIN, n0 < 1280 ? n0 : n0 + 8, (bf16_t*)(wl + W_IN), 1024, n0, 64 * kb, scr, lane); continue; } r -= 1408;
        if (r < 512) { const int kb = r / 32, nb = r % 32; transpose_item(a.in(I_WOUT) + (size_t)l * 1024 * 1024, 1024, 32 * nb, (bf16_t*)(wl + W_OUT), 1024, 32 * nb, 64 * kb, scr, lane); continue; } r -= 512;
        if (r < 2816) { const int kb = r / 176, nb = r % 176, n0 = 32 * nb, pn = n0 >> 8, bj = (n0 >> 7) & 1, j = n0 & 127;
            transpose_item((bj ? a.in(I_WUP) : a.in(I_WGATE)) + (size_t)l * 1024 * DFF, DFF, 128 * pn + j, (bf16_t*)(wl + W_GU), 1024, n0, 64 * kb, scr, lane); continue; } r -= 2816;
        { const int kb = r / 32, nb = r % 32; transpose_item(a.in(I_WDOWN) + (size_t)l * DFF * 1024, 1024, 32 * nb, (bf16_t*)(wl + W_DOWN), DFF, 32 * nb, 64 * kb, scr, lane); }
    }
}
DI void bias_items(const KA a, int l, int bidx, int nb, int tid, LAS unsigned char* lds) {
    unsigned char* ws = a.ws();
    const float* MOD = (const float*)(ws + WS_MOD); float* BIAS_IN = (float*)(ws + WS_BIAS_IN); float* BIAS_DT = (float*)(ws + WS_BIAS_DT); float* BIAS_GU = (float*)(ws + WS_BIAS_GU);
    LAS float* A = (LAS float*)lds; LAS float* red = (LAS float*)(lds + 73728);
    for (int r = bidx; r < 133; r += nb) { const int chunk = r < 45 ? 0 : 3;
#pragma unroll
        for (int q = 0; q < 9; ++q) { const int i4 = tid + 512 * q; if (i4 < 17 * 256) { const int b = i4 >> 8, k = (i4 & 255) * 4;
            *(LAS f32x4*)(A + i4 * 4) = *(const f32x4*)(MOD + (size_t)l * 17 * 6144 + (size_t)b * 6144 + chunk * 1024 + k); } }
        __syncthreads();
        if (r < 44) gemv17(A, red, a.in(I_WIN) + (size_t)l * 1024 * DIN, DIN, (64 * r < 1280 ? 64 * r : 64 * r + 8), 64, BIAS_IN + (size_t)l * 17 * NU, NU, 64 * r, nullptr, tid);
        else if (r == 44) gemv17(A, red, a.in(I_WIN) + (size_t)l * 1024 * DIN, DIN, 1280, 8, BIAS_DT + (size_t)l * 17 * 8, 8, 0, nullptr, tid);
        else { const int n0 = 64 * (r - 45), pn = n0 >> 8, bj = (n0 >> 7) & 1, j = n0 & 127;
            gemv17(A, red, (bj ? a.in(I_WUP) : a.in(I_WGATE)) + (size_t)l * 1024 * DFF, DFF, 128 * pn + j, 64, BIAS_GU + (size_t)l * 17 * NGU, NGU, n0, nullptr, tid); }
    }
}

__global__ void __launch_bounds__(512) hybrid_fwd(Args args_unused) {
    extern __shared__ __attribute__((aligned(16))) unsigned char lds_raw[];
    LAS unsigned char* lds = (LAS unsigned char*)lds_raw;
    const int wave0 = __builtin_amdgcn_readfirstlane((int)threadIdx.x >> 6);
    const int G = gridDim.x, bid = blockIdx.x;
    const int vcu = (G % 8 == 0) ? (bid % 8) * (G / 8) + bid / 8 : bid;
    const int NGW = G * 8;
    const bool vcu_is_bid = true;
#define PHASE_IDS() const KA a = ka_fresh(); unsigned char* const ws = a.ws(); const int lane = lane_fresh(), wave = launder_s(wave0), tid = wave * 64 + lane, gw = vcu * 8 + wave; (void)tid; (void)gw; (void)ws
    {
        const KA a = ka_fresh(); unsigned* bar = (unsigned*)a.ws(); const unsigned x = (unsigned)__builtin_amdgcn_readfirstlane((int)xb_xcc_id());
        volatile LAS unsigned* st = (volatile LAS unsigned*)(lds + 143360);
        if (threadIdx.x == 0) { st[0] = 0u; st[1] = 0u; (void)xb_add(&bar[XB_XCNT(x)], 1u); }
        __syncthreads();
    }
    int n_stamp = 0;
#define STAMP() do { if (PROBE_MASK != 0u) { if (blockIdx.x == 0 && threadIdx.x == 0) { const KA as_ = ka_fresh(); ((unsigned long long*)(as_.ws() + 32768))[n_stamp] = __builtin_amdgcn_s_memrealtime(); } ++n_stamp; } } while (0)
#define GRID_BAR() do { const KA a_ = ka_fresh(); XcdBarrier xb_; xb_.bar = (unsigned*)a_.ws(); xb_.x = (unsigned)__builtin_amdgcn_readfirstlane((int)xb_xcc_id()); xb_.st = (volatile LAS unsigned*)(lds + 143360); \
        xcd_barrier(xb_, launder_s(wave0)); STAMP(); } while (0)

    for (int rep0 = 0; rep0 < REP_P0; ++rep0) {
    STAMP();
    {
        PHASE_IDS();
        float* MOD = (float*)(ws + WS_MOD); float* ROPE = (float*)(ws + WS_ROPE); float* WDT = (float*)(ws + WS_WDT);
        LAS float* A = (LAS float*)lds; LAS float* red = (LAS float*)(lds + 73728);
        for (int it = bid; it < 2 * 96; it += G) { const int l = it / 96, cb = it % 96;
#pragma unroll
            for (int q = 0; q < 9; ++q) { const int i4 = tid + 512 * q; if (i4 < 17 * 256) { const int b = i4 >> 8, k = (i4 & 255) * 4; const f32x4 cv = *(const f32x4*)(b < 16 ? a.in(I_C) + b * 1024 + k : a.in(I_CCTX) + k);
                *(LAS f32x4*)(A + i4 * 4) = (f32x4){siluf_(cv.x), siluf_(cv.y), siluf_(cv.z), siluf_(cv.w)}; } }
            __syncthreads();
            gemv17(A, red, a.in(I_WMOD) + (size_t)l * 1024 * 6144, 6144, cb * 64, 64, MOD + (size_t)l * 17 * 6144, 6144, cb * 64, a.in(I_BMOD) + (size_t)l * 6144 + cb * 64, tid);
        }
        convert_weights(a, 0, gw, NGW, lane, (LAS float*)(lds + wave * 16384));
        const int gt = bid * 512 + tid;
        if (gt < 2 * 8192) { const int l = gt >> 13, j = (gt >> 10) & 7, k = gt & 1023; WDT[gt] = a.in(I_WIN)[(size_t)l * 1024 * DIN + (size_t)k * DIN + 1280 + j]; }
        if (gt < 1024) { const int pos = gt >> 4, j = gt & 15; const float invf = __builtin_amdgcn_exp2f(-(float)j * 0.8304820237218406f); const float ang = (float)pos * invf; ROPE[gt * 2] = __cosf(ang); ROPE[gt * 2 + 1] = __sinf(ang); }
    }
    if (gridDim.y == 0xFFFFu) cg::this_grid().sync();
    GRID_BAR();
    {
        PHASE_IDS();
        float* MOD = (float*)(ws + WS_MOD); float* BIAS_IN = (float*)(ws + WS_BIAS_IN); float* BIAS_DT = (float*)(ws + WS_BIAS_DT); float* BIAS_GU = (float*)(ws + WS_BIAS_GU);
        float* ROWPART = (float*)(ws + WS_ROWPART); bf16_t* HB = (bf16_t*)(ws + WS_HB);
        bias_items(a, 0, bid, G, tid, lds);
        const int nheavy = 0;
        const int gwx = (vcu_is_bid ? (bid - nheavy) * 8 + wave : gw), NGWX = vcu_is_bid ? (G - nheavy) * 8 : NGW;
        if (!vcu_is_bid || bid >= nheavy)
        {
            const float* g = a.in(I_N1G);
            f32x4 gg[4];
#pragma unroll
            for (int j = 0; j < 4; ++j) gg[j] = *(const f32x4*)(g + (lane + 64 * j) * 4);
#define P0_LOAD(x_, row0_) do { _Pragma("unroll") for (int q = 0; q < 3; ++q) { const int row = (row0_) + q * NGWX; if (row < M_ALL) { const bool isctx = row >= M_LAT; \
                const float* xr = isctx ? a.in(I_CTX) + (size_t)(row - M_LAT) * DM : a.in(I_X) + (size_t)row * DM; \
                _Pragma("unroll") for (int j = 0; j < 4; ++j) x_[q][j] = *(const f32x4*)(xr + (lane + 64 * j) * 4); } } } while (0)
#define P0_COMP(x_, row0_) do { _Pragma("unroll") for (int q = 0; q < 3; ++q) { const int row = (row0_) + q * NGWX; if (row < M_ALL) { const bool isctx = row >= M_LAT; const int b = isctx ? 16 : row >> 11;       \
                const float* sc = MOD + (size_t)b * 6144 + 1024; \
                float ss = 0.f; \
                _Pragma("unroll") for (int j = 0; j < 4; ++j) { const int col = (lane + 64 * j) * 4; const f32x4 v = x_[q][j]; const f32x4 s4 = *(const f32x4*)(sc + col); \
                    ss += (v.x * v.x + v.y * v.y) + (v.z * v.z + v.w * v.w); const f32x4 p = v * (gg[j] * (s4 + 1.0f)); \
                    u32x2 w; w.x = cvt_pk_bf16(p.x, p.y); w.y = cvt_pk_bf16(p.z, p.w); *(u32x2*)(HB + (size_t)row * DM + col) = w; } \
                ss = wave_sum(ss); \
                if (lane < 4) { f32x4 o = {0.f, 0.f, 0.f, 0.f}; if (lane == 0) o.x = ss; *(f32x4*)(ROWPART + (size_t)row * 16 + lane * 4) = o; } } } } while (0)
            const int rstep = 3 * NGWX;
            f32x4 xa[3][4], xb[3][4];
            int row0 = gwx;
            if (row0 < M_ALL) P0_LOAD(xa, row0);
            for (; row0 < M_ALL; row0 += 2 * rstep) {
                const bool has1 = row0 + rstep < M_ALL;
                if (has1) P0_LOAD(xb, row0 + rstep);
                P0_COMP(xa, row0);
                if (has1) { if (row0 + 2 * rstep < M_ALL) P0_LOAD(xa, row0 + 2 * rstep); P0_COMP(xb, row0 + rstep); }
            }
#undef P0_LOAD
#undef P0_COMP
        }
    }
    GRID_BAR();
    }

    const bool split = (G == 256);
    for (int l = 0; l < 2; ++l) {
        const int nM = (l == 0) ? 144 : 128;
        for (int rep = 0; rep < REP_P1; ++rep) {
            if (rep) GRID_BAR();
            PHASE_IDS();
            bf16_t* HB = (bf16_t*)(ws + WS_HB); float* rp1 = (float*)(ws + WS_ROWPART) + (size_t)(2 * l) * ROWPART_STRIDE;
            pg8::Gemm g{HB, (const bf16_t*)(ws + WS_W + (size_t)l * W_LAYER + W_IN), 1024}; pg8::TileOrder S; S.init(nM, 11, G, bid, l == 0 ? 0 : 112, (split && l == 1) ? 576 : 0);
            pg8::EpiIn E{(bf16_t*)(ws + WS_U), rp1, (const float*)(ws + WS_BIAS_IN) + (size_t)l * 17 * NU, (const float*)(ws + WS_ROPE)};
            const int ntl_ = nM * 11 + (l == 0 ? 0 : 112) - ((split && l == 1) ? 576 : 0), nbusy_ = ntl_ - (ntl_ / G) * G;
            const bool spread_ = (nbusy_ > 0) && (2 * nbusy_ <= G);
            for (int pass = 0; pass < 2; ++pass) {
                if ((pass == 0 && spread_ && bid >= nbusy_) || (pass == 1 && !spread_)) {
            const int lane_o_ = lane, tid_o_ = tid; const int lane = launder(lane_o_), tid = launder(tid_o_);
            LAS float* WT = (LAS float*)lds;
            const float* WDT = (const float*)(ws + WS_WDT); const float* BIAS_DT = (const float*)(ws + WS_BIAS_DT); float* DT = (float*)(ws + WS_DT);
            for (int i = tid; i < 8192; i += 512) WT[i] = WDT[l * 8192 + i];
            __syncthreads();
            const int ntl = nM * 11 + (l == 0 ? 0 : 112) - ((split && l == 1) ? 576 : 0), nfull = ntl / G, nbusy = ntl - nfull * G;
            const bool spread = (nbusy > 0) && (2 * nbusy <= G);
            const int dgw = spread ? (bid - nbusy) * 8 + wave : gw, dstep = spread ? (G - nbusy) * 8 : NGW;
            { const int r32 = lane & 31, hi = lane >> 5;
              const int nr = dgw < M_ALL ? (M_ALL - dgw + dstep - 1) / dstep : 0;
              const LAS float* wp = WT + (r32 & 7) * 1024 + 512 * hi;
              const unsigned wmask = r32 < 8 ? 0xffffffffu : 0u;
              for (int rb = 0; rb * 32 < nr; ++rb) {
                  const int ia = rb * 32 + r32, ic = ia < nr ? ia : nr - 1;
                  const char* ap = (const char*)(HB + (size_t)(dgw + ic * dstep) * DM) + hi * 1024;
                  f32x16 dacc = {};
                  for (int t = 0; t < 64; t += 8) {
                      bf16x8 af[8];
#pragma unroll
                      for (int e = 0; e < 8; ++e) af[e] = *(const bf16x8*)(ap + (t + e) * 16);
#pragma unroll
                      for (int e = 0; e < 8; ++e) { const f32x4 w0 = *(const LAS f32x4*)(wp + 8 * (t + e)), w1 = *(const LAS f32x4*)(wp + 8 * (t + e) + 4);
                          u32x4 wb = {cvt_pk_bf16(w0[0], w0[1]) & wmask, cvt_pk_bf16(w0[2], w0[3]) & wmask, cvt_pk_bf16(w1[0], w1[1]) & wmask, cvt_pk_bf16(w1[2], w1[3]) & wmask};
                          dacc = __builtin_amdgcn_mfma_f32_32x32x16_bf16(af[e], __builtin_bit_cast(bf16x8, wb), dacc, 0, 0, 0); }
                  }
                  if (r32 < 8) {
#pragma unroll
                      for (int r = 0; r < 16; ++r) { const int i2 = rb * 32 + crow(r, hi);
                          if (i2 < nr) { const int row = dgw + i2 * dstep; const bool isctx = row >= M_LAT; const int b = isctx ? 16 : row >> 11;
                              const float rstd = pg8::row_rstd(rp1, row);
                              const float raw = dacc[r] * rstd + BIAS_DT[(size_t)l * 17 * 8 + b * 8 + r32] + a.in(I_SDTB)[l * 8 + r32]; DT[(size_t)row * 8 + r32] = softplusf_(raw); } }
                  }
              } }
                            __syncthreads();
                }
                if (pass == 0) pg8::gemm_phase<pg8::EpiIn, true>(lds, g, S, E, wave0);
            }
        }
        GRID_BAR();
        {
            PHASE_IDS();
            for (int ci = gw; ci < M_ALL / 128; ci += NGW) ssd_chunk_scan(a, l, ci, lane);
            preconv_rows(a, l, gw, NGW, lane);
            asm volatile("s_waitcnt vmcnt(0)" ::: "memory"); __syncthreads();
            if (tid == 0) { __builtin_amdgcn_fence(__ATOMIC_RELEASE, "agent"); asm volatile("s_waitcnt vmcnt(0)" ::: "memory");
                __hip_atomic_fetch_add((unsigned*)(ws + WS_P1BCNT) + l * 64, 1u, __ATOMIC_RELAXED, __HIP_MEMORY_SCOPE_AGENT); }
        }
        for (int rep = 0; rep < REP_P2; ++rep) {
            if (rep) GRID_BAR();
            PHASE_IDS();
            const bf16_t* U = (const bf16_t*)(ws + WS_U); bf16_t* MIX = (bf16_t*)(ws + WS_MIX);
            float lam, lam_init;
            { const float* lv = a.in(I_DALAM) + (size_t)l * 256; const float s1 = wave_sum(lv[lane] * lv[64 + lane]), s2 = wave_sum(lv[128 + lane] * lv[192 + lane]);
              lam_init = 0.8f - 0.6f * __expf(-0.3f * (float)l); lam = uniformf(__expf(s1) - __expf(s2) + lam_init); lam_init = uniformf(lam_init); }
            const float* subg = a.in(I_DASG) + (size_t)l * 128;
            for (int ui_ = 0; ui_ * G < 1024; ++ui_) {
                const int nun_ = (1024 + G - 1 - vcu) / G;
                if (ui_ >= nun_) break;
                const int u = vcu + ((ui_ + 1 < nun_) ? (ui_ + 1) * G : 0);
                if (u < 256) {
                    if (tid == 0) { unsigned* cnt = (unsigned*)(ws + WS_P1BCNT) + l * 64; unsigned sp = 0;
                        while (__hip_atomic_load(cnt, __ATOMIC_RELAXED, __HIP_MEMORY_SCOPE_AGENT) < (unsigned)G) { __builtin_amdgcn_s_sleep(2); if (++sp > (1u << 22)) break; }
                        __builtin_amdgcn_fence(__ATOMIC_ACQUIRE, "agent"); asm volatile("s_waitcnt vmcnt(0)" ::: "memory"); }
                    __syncthreads();
                }
                if (u < 128) { if (!(rep && P2_SKIP_RG_ON_REP)) rg_unit(a, lds, l, u >> 3, (u >> 1) & 3, u & 1, wave * 64 + lane_fresh()); }
                else if (u < 256) { if (!(rep && P2_SKIP_SSD_ON_REP)) ssd_unit(a, lds, l, (u - 128) >> 3, ((u - 128) >> 1) & 3, (u - 128) & 1, wave * 64 + lane_fresh()); }
                else if (u >= 448 && u < 512) { if (l == 0 && !(rep && P2_SKIP_ATT_ON_REP)) { const int b = (u - 448) >> 2, h = (u - 448) & 3;        att::attn_unit(lds, U, MIX, M_LAT + b * CTXL, 0, 0, M_LAT + b * CTXL, 4, h, lam, l, subg, wave * 64 + lane_fresh()); } }
                else if (u >= 512 && !(rep && P2_SKIP_ATT_ON_REP)) { const int aidx = u - 512, bh = aidx >> 3, qb = aidx & 7, b = bh >> 2, h = bh & 3;
                    att::attn_unit(lds, U, MIX, b * SEQ + qb * 256, b * SEQ, 32, M_LAT + b * CTXL, 4, h, lam, l, subg, wave * 64 + lane_fresh()); }
                BAR_LDS();
            }
            if (rep == 0) for (int cu = vcu; cu < 256; cu += G) { const int b = cu >> 4, sl = cu & 15; const int lane = lane_fresh(), tid = wave * 64 + lane;
                if (tid == 0) { unsigned* cnt = (unsigned*)(ws + WS_SSDCNT) + (l * 16 + b) * 64; unsigned sp = 0;
                    while (__hip_atomic_load(cnt, __ATOMIC_RELAXED, __HIP_MEMORY_SCOPE_AGENT) < 8u) { __builtin_amdgcn_s_sleep(2); if (++sp > (1u << 22)) break; }
                    __builtin_amdgcn_fence(__ATOMIC_ACQUIRE, "agent"); asm volatile("s_waitcnt vmcnt(0)" ::: "memory"); }
                __syncthreads();
                { const int base = b * SEQ + sl * 128;
                  ssd_combine_pipe(a, l, base + wave, base + 128, lane); }
                if (l == 0) { const int basec = M_LAT + b * CTXL + sl * 16; ssd_combine_rows<3>(a, l, basec + wave, 8, basec + 16, lane); }
            }
        }
        GRID_BAR();
        {
            PHASE_IDS();
            const float* modl = (const float*)(ws + WS_MOD) + (size_t)l * 17 * 6144; float* HCTX = (float*)(ws + WS_HCTX);
            pg8::Gemm g{(const bf16_t*)(ws + WS_MIX), (const bf16_t*)(ws + WS_W + (size_t)l * W_LAYER + W_OUT), 1024}; pg8::TileOrder S; S.init(nM, 4, G, bid, 0);
            pg8::EpiRes E{l == 0 ? (const void*)a.in(I_X) : (const void*)a.out(), l == 0 ? (const void*)a.in(I_CTX) : (const void*)HCTX, a.out(), HCTX, l == 0 ? 0 : 1, 1, modl + 2 * 1024, (bf16_t*)(ws + WS_HB), a.in(I_N2G) + (size_t)l * 1024, modl + 4 * 1024,
                          (float*)(ws + WS_ROWPART) + (size_t)(2 * l + 1) * ROWPART_STRIDE};
            if (l == 0) {
                const int nwg = nM * 4, nh3 = (nwg > 2 * G) ? ((nwg - 2 * G) < G ? (nwg - 2 * G) : G) : 0, nl = (G - nh3) > 0 ? (G - nh3) : G, li = (G - nh3) > 0 ? bid - nh3 : bid;
                if (li >= 0) { convert_weights(a, 1, li * 8 + wave, nl * 8, lane, (LAS float*)(lds + wave * 16384)); __syncthreads(); bias_items(a, 1, li, nl, tid, lds); __syncthreads(); }
            }
            pg8::gemm_phase<pg8::EpiRes, true>(lds, g, S, E, wave0);
        }
        GRID_BAR();
        for (int rep = 0; rep < REP_P4; ++rep) {
            if (rep) GRID_BAR();
            PHASE_IDS();
            pg8::Gemm g{(const bf16_t*)(ws + WS_HB), (const bf16_t*)(ws + WS_W + (size_t)l * W_LAYER + W_GU), 1024}; pg8::TileOrder S; S.init(nM, 22, G, bid, 0);
            pg8::EpiGLU E{(bf16_t*)(ws + WS_U), (const float*)(ws + WS_ROWPART) + (size_t)(2 * l + 1) * ROWPART_STRIDE, (const float*)(ws + WS_BIAS_GU) + (size_t)l * 17 * NGU};
            pg8::gemm_phase<pg8::EpiGLU, true>(lds, g, S, E, wave0);
        }
        GRID_BAR();
        for (int part = 0; part < (split && l == 0 ? 2 : 1); ++part) {
            PHASE_IDS();
            if (part == 0 || bid < 64) {
                const float* MOD = (const float*)(ws + WS_MOD); float* HCTX = (float*)(ws + WS_HCTX);
                pg8::Gemm g{(const bf16_t*)(ws + WS_U), (const bf16_t*)(ws + WS_W + (size_t)l * W_LAYER + W_DOWN), DFF}; pg8::TileOrder S;
                if (part == 0) S.init((split && l == 0) ? 128 : nM, 4, G, bid, 0); else S.init(16, 4, 64, bid, 0, 0, 1 << 30, 128);
                pg8::EpiRes E{a.out(), HCTX, l == 0 ? (void*)a.out() : (void*)(ws + WS_MIX), HCTX, 1, 1, MOD + (size_t)l * 17 * 6144 + 5 * 1024, l == 0 ? (bf16_t*)(ws + WS_HB) : nullptr, a.in(I_N1G) + 1024, MOD + (size_t)17 * 6144 + 1024,
                              (float*)(ws + WS_ROWPART) + (size_t)(2 * l + 2) * ROWPART_STRIDE};
                pg8::gemm_phase<pg8::EpiRes, true>(lds, g, S, E, wave0);
            } else {
                pg8::Gemm g{(const bf16_t*)(ws + WS_HB), (const bf16_t*)(ws + WS_W + W_LAYER + W_IN), 1024}; pg8::TileOrder S; S.init(128, 11, 192, bid - 64, 0, 0, 576);
                pg8::EpiIn E{(bf16_t*)(ws + WS_U), (float*)(ws + WS_ROWPART) + (size_t)2 * ROWPART_STRIDE, (const float*)(ws + WS_BIAS_IN) + (size_t)17 * NU, (const float*)(ws + WS_ROPE)};
                pg8::gemm_phase<pg8::EpiIn, true>(lds, g, S, E, wave0);
            }
            GRID_BAR();
        }
    }
    if (PROBE_MASK != 0u) GRID_BAR();
    {
        PHASE_IDS();
        const float* rpf = (const float*)(ws + WS_ROWPART) + (size_t)4 * ROWPART_STRIDE; const float* g = a.in(I_FNG); float* outp = a.out(); const bf16_t* fin = (const bf16_t*)(ws + WS_MIX);
        int probe_rows = 0; float probe_b = 0.f;
        if (PROBE_MASK != 0u) { const unsigned long long* st = (const unsigned long long*)(ws + 32768); unsigned long long sel = 0, tot = st[n_stamp - 2] - st[0];
            for (int k = 0; k + 2 < n_stamp; ++k) if ((PROBE_MASK >> k) & 1u) sel += st[k + 1] - st[k];
            sel += st[40]; probe_rows = (int)((double)sel / (double)tot * 1024.0 + 0.5);
            probe_b = 0.04f + 0.12f * fminf(1.0f, (float)((double)st[41] / (double)tot * 20.0)); }
        f32x4 gg[4];
#pragma unroll
        for (int j = 0; j < 4; ++j) gg[j] = *(const f32x4*)(g + (lane + 64 * j) * 4);
#define P6_LOAD(w_, p_, row0_) do { _Pragma("unroll") for (int q = 0; q < 3; ++q) { const int row = (row0_) + q * NGW; if (row < M_LAT) { p_[q] = rpf[(size_t)row * 16 + (lane & 15)]; \
                _Pragma("unroll") for (int j = 0; j < 4; ++j) w_[q][j] = *(const u32x2*)(fin + (size_t)row * DM + (lane + 64 * j) * 4); } } } while (0)
#define P6_COMP(w_, p_, row0_) do { _Pragma("unroll") for (int q = 0; q < 3; ++q) { const int row = (row0_) + q * NGW; if (row < M_LAT) { \
                const float rstd = __builtin_amdgcn_rsqf(wave_sum(p_[q]) * (0.25f / DM) + EPS);         \
                _Pragma("unroll") for (int j = 0; j < 4; ++j) { const int col = (lane + 64 * j) * 4; const u32x2 w = w_[q][j]; const f32x4 xq = (f32x4){bflo(w[0]), bfhi(w[0]), bflo(w[1]), bfhi(w[1])}; \
                    f32x4 o4 = xq * rstd * gg[j]; if (PROBE_MASK != 0u && (row >> 5) < probe_rows && col < PROBE_COLS) o4 = o4 + 0.02f; if (PROBE_SEC_B != 0 && row == 32767 && col == 1020) o4.w += probe_b; \
                    *(f32x4*)(outp + (size_t)row * DM + col) = o4; } } } } while (0)
        {
            const int rstep = 3 * NGW;
            u32x2 wa[3][4], wb[3][4]; float pa[3], pb[3];
            int row0 = gw;
            if (row0 < M_LAT) P6_LOAD(wa, pa, row0);
            for (; row0 < M_LAT; row0 += 2 * rstep) {
                const bool has1 = row0 + rstep < M_LAT;
                if (has1) P6_LOAD(wb, pb, row0 + rstep);
                P6_COMP(wa, pa, row0);
                if (has1) {
                    if (row0 + 2 * rstep < M_LAT) P6_LOAD(wa, pa, row0 + 2 * rstep);
                    P6_COMP(wb, pb, row0 + rstep);
                }
            }
        }
#undef P6_LOAD
#undef P6_COMP
    }
}

extern "C" void kernel_launch(void* const* d_in, const int* in_sizes, int n_in, void* d_out, int out_size, void* d_ws, size_t ws_size, hipStream_t stream) {
    static int grid = 0;
    if (grid == 0) {
        if (n_in != N_IN || in_sizes[0] != M_LAT * DM || out_size != M_LAT * DM || ws_size < WS_END) {
            fprintf(stderr, "kernel_launch: unexpected shapes (n_in %d, in0 %d, out %d, ws %zu); nothing launched\n", n_in, n_in > 0 ? in_sizes[0] : -1, out_size, ws_size); grid = -1; return; }
        int dev = 0, cus = 0, per_cu = 0;
        if (hipGetDevice(&dev) != hipSuccess || hipDeviceGetAttribute(&cus, hipDeviceAttributeMultiprocessorCount, dev) != hipSuccess) { grid = -1; return; }
        if (hipFuncSetAttribute((const void*)hybrid_fwd, hipFuncAttributeMaxDynamicSharedMemorySize, LDS_BYTES) != hipSuccess) { fprintf(stderr, "kernel_launch: hipFuncSetAttribute failed\n"); grid = -1; return; }
        if (hipOccupancyMaxActiveBlocksPerMultiprocessor(&per_cu, (const void*)hybrid_fwd, 512, LDS_BYTES) != hipSuccess || per_cu < 1) { fprintf(stderr, "kernel_launch: occupancy query says %d\n", per_cu); (void)hipGetLastError(); grid = -1; return; }
        grid = cus * (per_cu < 1 ? 1 : 1);
    }
    if (grid < 0) return;
    if (hipMemsetAsync(d_ws, 0, 65536, stream) != hipSuccess) { fprintf(stderr, "kernel_launch: memset failed\n"); return; }
    Args a{};
    for (int i = 0; i < N_IN; ++i) a.in[i] = (const float*)d_in[i];
    a.out = (float*)d_out; a.ws = (unsigned char*)d_ws;
    void* args[] = {&a};
    hipError_t e = hipLaunchCooperativeKernel((const void*)hybrid_fwd, dim3(grid), dim3(512), args, LDS_BYTES, stream);
    if (e != hipSuccess) fprintf(stderr, "kernel_launch: cooperative launch failed: %s (grid %d)\n", hipGetErrorString(e), grid);
}
```
